# Optimizing an MI355X kernel written in HIP

```python
import math
import jax
import jax.numpy as jnp
from jax import lax
import numpy as np

D_MODEL = 1024
BATCH = 8
SEQ = 2048
DEPTH = 2

N_MIXERS = 2
N_MLA_LAYERS = (DEPTH + 1) // 2
N_DIL_LAYERS = DEPTH // 2

MLA_HEADS = 16
MLA_NOPE = 64
MLA_ROPE = 32
MLA_QK = MLA_NOPE + MLA_ROPE
MLA_V = 64
Q_LORA = 3 * D_MODEL // 8
KV_LORA = D_MODEL // 4
MLA_IN = Q_LORA + KV_LORA + MLA_ROPE
ROPE_THETA = 10000.0
Q_BLOCK = 128

DIL_GROUPS = ((128, 1), (512, 4), (2048, 16))
N_DIL_GROUPS = len(DIL_GROUPS)
DIL_HEADS = 16
DIL_HEAD_DIM = 64
DIL_IN = N_DIL_GROUPS * 3 * DIL_HEADS * DIL_HEAD_DIM

N_BUCKETS = 32
MAX_DISTANCE = 1024

D_FF = 4 * D_MODEL
N_MOD = 6
EPS = 1e-6

kernel_name = "hybrid_mla_dilated_encoder"


def rms_norm(x, g):
    xf = x.astype(jnp.float32)
    y = xf * lax.rsqrt(jnp.mean(xf * xf, axis=-1, keepdims=True) + EPS)
    return (y * g.astype(jnp.float32)).astype(x.dtype)


def rope(x, pos):
    half = x.shape[-1] // 2
    inv = 1.0 / (ROPE_THETA ** (jnp.arange(half, dtype=jnp.float32) / half))
    ang = pos.astype(jnp.float32)[..., None] * inv
    ang = ang.reshape(ang.shape[:2] + (1,) * (x.ndim - 3) + (half,))
    cos, sin = jnp.cos(ang), jnp.sin(ang)
    x1 = x[..., :half].astype(jnp.float32)
    x2 = x[..., half:].astype(jnp.float32)
    out = jnp.concatenate([x1 * cos - x2 * sin, x2 * cos + x1 * sin], axis=-1)
    return out.astype(x.dtype)


def t5_bucket(rel):
    nb = N_BUCKETS // 2
    max_exact = nb // 2
    ret = jnp.where(rel > 0, nb, 0)
    n = jnp.abs(rel)
    nf = jnp.maximum(n, 1).astype(jnp.float32)
    large = max_exact + (jnp.log(nf / max_exact) / math.log(MAX_DISTANCE / max_exact)
                         * (nb - max_exact)).astype(jnp.int32)
    large = jnp.minimum(large, nb - 1)
    return ret + jnp.where(n < max_exact, n, large)


def dense_attention(q, k, v, scale):
    B, S, H, Dk = q.shape
    nq = S // Q_BLOCK
    qb = jnp.moveaxis(q.reshape(B, nq, Q_BLOCK, H, Dk), 1, 0)

    def block(qi):
        s = jnp.einsum('bqhd,bkhd->bhqk', qi, k, preferred_element_type=jnp.float32) * scale
        p = jax.nn.softmax(s, axis=-1).astype(v.dtype)
        return jnp.einsum('bhqk,bkhd->bqhd', p, v)

    o = lax.map(block, qb)
    return jnp.moveaxis(o, 0, 1).reshape(B, S, H, v.shape[-1])


def mla_mixer(h, pos, w_in, g_qa, w_qb, g_kva, w_kvb, g_q, g_k, w_o):
    B, S, _ = h.shape
    proj = h @ w_in
    q_lat = proj[..., :Q_LORA]
    kv_lat = proj[..., Q_LORA:Q_LORA + KV_LORA]
    k_rope = rope(proj[..., Q_LORA + KV_LORA:], pos)
    q = (rms_norm(q_lat, g_qa) @ w_qb).reshape(B, S, MLA_HEADS, MLA_QK)
    kv = (rms_norm(kv_lat, g_kva) @ w_kvb).reshape(B, S, MLA_HEADS, MLA_NOPE + MLA_V)
    q = jnp.concatenate([q[..., :MLA_NOPE], rope(q[..., MLA_NOPE:], pos)], axis=-1)
    k = jnp.concatenate([kv[..., :MLA_NOPE],
                         jnp.broadcast_to(k_rope[:, :, None, :], (B, S, MLA_HEADS, MLA_ROPE))],
                        axis=-1)
    v = kv[..., MLA_NOPE:]
    q = rms_norm(q, g_q)
    k = rms_norm(k, g_k)
    o = dense_attention(q, k, v, MLA_QK ** -0.5)
    return o.reshape(B, S, MLA_HEADS * MLA_V) @ w_o


def _to_residues(t, dilation):
    B, S = t.shape[:2]
    L = S // dilation
    t = t.reshape((B, L, dilation) + t.shape[2:])
    t = jnp.moveaxis(t, 2, 1)
    return t.reshape((B * dilation, L) + t.shape[3:])


def _from_residues(t, batch, dilation):
    L = t.shape[1]
    t = t.reshape((batch, dilation, L) + t.shape[2:])
    t = jnp.moveaxis(t, 1, 2)
    return t.reshape((batch, L * dilation) + t.shape[3:])


def dilated_group(q, k, v, pos, bias_table, window, dilation):
    B, S, H, Dh = q.shape
    half = window // (2 * dilation)
    blk = half
    L = S // dilation
    nb = -(-L // blk)
    Lp = nb * blk
    padq = Lp - L
    N = B * dilation
    qr, kr, vr, pr = (_to_residues(t, dilation) for t in (q, k, v, pos))
    qb = jnp.pad(qr, ((0, 0), (0, padq), (0, 0), (0, 0))).reshape(N, nb, blk, H, Dh)

    def key_blocks(t):
        pad = [(0, 0), (blk, padq + blk)] + [(0, 0)] * (t.ndim - 2)
        t = jnp.pad(t, pad).reshape((N, nb + 2, blk) + t.shape[2:])
        return jnp.concatenate([t[:, :-2], t[:, 1:-1], t[:, 2:]], axis=2)

    kb, vb, pk = key_blocks(kr), key_blocks(vr), key_blocks(pr)
    pq = jnp.pad(pr, ((0, 0), (0, padq))).reshape(N, nb, blk)
    qi = jnp.arange(nb)[:, None] * blk + jnp.arange(blk)[None, :]
    ki = jnp.arange(nb)[:, None] * blk - blk + jnp.arange(3 * blk)[None, :]
    valid = ((ki[:, None, :] >= 0) & (ki[:, None, :] < L)
             & (jnp.abs(qi[:, :, None] - ki[:, None, :]) <= half))
    bucket = t5_bucket(pk[:, :, None, :] - pq[:, :, :, None])
    bias = jnp.moveaxis(bias_table[bucket], -1, 2).astype(jnp.float32)
    s = jnp.einsum('nbqhd,nbkhd->nbhqk', qb, kb,
                   preferred_element_type=jnp.float32) * (DIL_HEAD_DIM ** -0.5) + bias
    s = jnp.where(valid[None, :, None], s, -jnp.inf)
    lse = jax.nn.logsumexp(s, axis=-1)
    p = jnp.exp(s - lse[..., None]).astype(v.dtype)
    o = jnp.einsum('nbhqk,nbkhd->nbqhd', p, vb).reshape(N, Lp, H, Dh)[:, :L]
    lse = jnp.moveaxis(lse, 2, 3).reshape(N, Lp, H)[:, :L]
    return _from_residues(o, B, dilation), _from_residues(lse, B, dilation)


def dilated_mixer(h, pos, w_in, g_q, g_k, rel_bias, w_o):
    B, S, _ = h.shape
    proj = (h @ w_in).reshape(B, S, N_DIL_GROUPS, 3, DIL_HEADS, DIL_HEAD_DIM)
    outs, lses = [], []
    for gi, (window, dilation) in enumerate(DIL_GROUPS):
        q = rms_norm(proj[:, :, gi, 0], g_q[gi])
        k = rms_norm(proj[:, :, gi, 1], g_k[gi])
        v = proj[:, :, gi, 2]
        table = rel_bias[:, gi * DIL_HEADS:(gi + 1) * DIL_HEADS]
        o, lse = dilated_group(q, k, v, pos, table, window, dilation)
        outs.append(o)
        lses.append(lse)
    o_all = jnp.stack(outs, axis=0)
    wts = jax.nn.softmax(jnp.stack(lses, axis=0), axis=0)
    o = jnp.einsum('gbsh,gbshd->bshd', wts.astype(o_all.dtype), o_all)
    return o.reshape(B, S, DIL_HEADS * DIL_HEAD_DIM) @ w_o


def setup_inputs(seed: int = 0) -> dict:
    key = jax.random.key(seed)
    ks = jax.random.split(key, 24)
    f32 = jnp.float32
    nrm = lambda k, shape, s: jax.random.normal(k, shape, f32) * s
    gain = lambda k, shape: 1.0 + 0.05 * jax.random.normal(k, shape, f32)
    D = D_MODEL
    return {
        "x": nrm(ks[0], (BATCH, SEQ, D), 1.0),
        "c": nrm(ks[1], (BATCH, D), 1.0),
        "positions": jnp.broadcast_to(jnp.arange(SEQ, dtype=jnp.int32), (BATCH, SEQ)),
        "ada_w": nrm(ks[2], (DEPTH, D, N_MOD * D), 0.5 * D ** -0.5),
        "ada_b": nrm(ks[3], (DEPTH, N_MOD * D), 0.02),
        "norm_mix": gain(ks[4], (DEPTH, D)),
        "norm_mlp": gain(ks[5], (DEPTH, D)),
        "mlp_w1": nrm(ks[6], (DEPTH, D, D_FF), D ** -0.5),
        "mlp_w2": nrm(ks[7], (DEPTH, D_FF, D), D_FF ** -0.5),
        "mla_w_in": nrm(ks[8], (N_MLA_LAYERS, D, MLA_IN), D ** -0.5),
        "mla_g_qa": gain(ks[9], (N_MLA_LAYERS, Q_LORA)),
        "mla_w_qb": nrm(ks[10], (N_MLA_LAYERS, Q_LORA, MLA_HEADS * MLA_QK), Q_LORA ** -0.5),
        "mla_g_kva": gain(ks[11], (N_MLA_LAYERS, KV_LORA)),
        "mla_w_kvb": nrm(ks[12], (N_MLA_LAYERS, KV_LORA, MLA_HEADS * (MLA_NOPE + MLA_V)), KV_LORA ** -0.5),
        "mla_g_q": gain(ks[13], (N_MLA_LAYERS, MLA_QK)),
        "mla_g_k": gain(ks[14], (N_MLA_LAYERS, MLA_QK)),
        "mla_w_o": nrm(ks[15], (N_MLA_LAYERS, MLA_HEADS * MLA_V, D), (MLA_HEADS * MLA_V) ** -0.5),
        "dil_w_in": nrm(ks[16], (N_DIL_LAYERS, D, DIL_IN), D ** -0.5),
        "dil_g_q": gain(ks[17], (N_DIL_LAYERS, N_DIL_GROUPS, DIL_HEAD_DIM)),
        "dil_g_k": gain(ks[18], (N_DIL_LAYERS, N_DIL_GROUPS, DIL_HEAD_DIM)),
        "dil_w_o": nrm(ks[19], (N_DIL_LAYERS, DIL_HEADS * DIL_HEAD_DIM, D), (DIL_HEADS * DIL_HEAD_DIM) ** -0.5),
        "rel_bias": nrm(ks[20], (N_BUCKETS, N_DIL_GROUPS * DIL_HEADS), 0.3),
    }


def reference(x, c, positions, ada_w, ada_b, norm_mix, norm_mlp, mlp_w1, mlp_w2,
              mla_w_in, mla_g_qa, mla_w_qb, mla_g_kva, mla_w_kvb, mla_g_q, mla_g_k, mla_w_o,
              dil_w_in, dil_g_q, dil_g_k, dil_w_o, rel_bias):
    B, S, D = x.shape
    cond = jax.nn.silu(c)
    for i in range(DEPTH):
        mod = (cond @ ada_w[i] + ada_b[i]).reshape(B, N_MOD, D)
        shift1, scale1, gate1 = mod[:, 0, None, :], mod[:, 1, None, :], mod[:, 2, None, :]
        shift2, scale2, gate2 = mod[:, 3, None, :], mod[:, 4, None, :], mod[:, 5, None, :]
        h = rms_norm(x, norm_mix[i]) * (1 + scale1) + shift1
        j = i // N_MIXERS
        if i % N_MIXERS == 0:
            y = mla_mixer(h, positions, mla_w_in[j], mla_g_qa[j], mla_w_qb[j], mla_g_kva[j],
                          mla_w_kvb[j], mla_g_q[j], mla_g_k[j], mla_w_o[j])
        else:
            y = dilated_mixer(h, positions, dil_w_in[j], dil_g_q[j], dil_g_k[j], rel_bias, dil_w_o[j])
        x = x + gate1 * y
        h = rms_norm(x, norm_mlp[i]) * (1 + scale2) + shift2
        x = x + gate2 * (jnp.square(jax.nn.relu(h @ mlp_w1[i])) @ mlp_w2[i])
    return x
```

```cpp
#include <hip/hip_runtime.h>
#include <cstdint>
#include <cstdio>

#define LAS __attribute__((address_space(3)))
typedef unsigned short bf16_t;
typedef float f32x4 __attribute__((ext_vector_type(4)));
typedef float f32x2 __attribute__((ext_vector_type(2)));
typedef unsigned u32x4 __attribute__((ext_vector_type(4)));
typedef unsigned u32x2 __attribute__((ext_vector_type(2)));
typedef __bf16 bf16x2_t __attribute__((ext_vector_type(2)));

constexpr int DM = 1024, NBATCH = 8, SEQ = 2048, MTOK = NBATCH * SEQ;
constexpr int DFF = 4096, MODW = 6 * DM;
constexpr int QLORA = 384, KVLORA = 256, ROPE = 32, MLA_IN = 672, MLA_INP = 768;
constexpr int NH = 16, QKD = 96, NOPE = 64, VD = 64;
constexpr int DIL_IN = 9216, GCOLS = 3072, NBKT = 32;
constexpr float EPS = 1e-6f;
constexpr float LOG2E = 1.4426950408889634f;
constexpr float MLA_C2 = 0.10206207261596575f * LOG2E;
constexpr float DIL_C2 = 0.125f * LOG2E;

constexpr size_t MiB = 1u << 20;
constexpr size_t WS_CTL = 0, WS_MOD = 1 * MiB, WS_CS = 2 * MiB;
constexpr size_t WS_WIN0 = 4 * MiB, WS_WQB = 5 * MiB + 512 * 1024, WS_WKVB = 7 * MiB, WS_WO0 = 8 * MiB, WS_W1_0 = 10 * MiB, WS_W2_0 = 18 * MiB;
constexpr size_t WS_WIN1 = 26 * MiB, WS_WO1 = 44 * MiB, WS_W1_1 = 46 * MiB, WS_W2_1 = 54 * MiB;
constexpr size_t WS_H = 64 * MiB;
constexpr size_t WS_R = 96 * MiB;
constexpr size_t WS_PROJ = WS_R;
constexpr size_t WS_Q = WS_R;
constexpr size_t WS_KV = WS_R + 48 * MiB;
constexpr size_t WS_KROPE = WS_R + 112 * MiB;
constexpr size_t WS_QA = WS_R + 128 * MiB;
constexpr size_t WS_KVA = WS_R + 140 * MiB;
constexpr size_t WS_KR = WS_R + 148 * MiB;
constexpr size_t WS_U = WS_R;
constexpr size_t WS_QKVG = WS_R;
constexpr size_t WS_O2 = WS_R + 96 * MiB;
constexpr size_t WS_LSE = WS_R + 128 * MiB;
constexpr size_t WS_END = 256 * MiB;

__device__ __forceinline__ float bf2f(unsigned h) { return __uint_as_float(h << 16); }
__device__ __forceinline__ unsigned pk2(float lo, float hi) { f32x2 v = {lo, hi}; bf16x2_t b = __builtin_convertvector(v, bf16x2_t); return __builtin_bit_cast(unsigned, b); }
__device__ __forceinline__ float wave_sum(float v) {
#pragma unroll
    for (int o = 1; o < 64; o <<= 1) v += __shfl_xor(v, o);
    return v;
}
__device__ __forceinline__ void unpack8(u32x4 w, float (&f)[8]) {
    f[0] = bf2f(w.x & 0xffffu); f[1] = bf2f(w.x >> 16); f[2] = bf2f(w.y & 0xffffu); f[3] = bf2f(w.y >> 16);
    f[4] = bf2f(w.z & 0xffffu); f[5] = bf2f(w.z >> 16); f[6] = bf2f(w.w & 0xffffu); f[7] = bf2f(w.w >> 16);
}
__device__ __forceinline__ u32x4 pack8(const float (&f)[8]) { u32x4 w; w.x = pk2(f[0], f[1]); w.y = pk2(f[2], f[3]); w.z = pk2(f[4], f[5]); w.w = pk2(f[6], f[7]); return w; }
#define LDS_WAIT() asm volatile("s_waitcnt lgkmcnt(0)" ::: "memory")

__device__ __forceinline__ int t5_bucket(int rel) {
    const int n = rel < 0 ? -rel : rel;
    int b = n;
    if (n >= 8) b = 8 + (n >= 15) + (n >= 27) + (n >= 50) + (n >= 91) + (n >= 166) + (n >= 305) + (n >= 559);
    return b + (rel > 0 ? 16 : 0);
}

__device__ __forceinline__ void transpose_item(const float* W, int K, int ldn, int N, bf16_t* WT, int row_off, LAS float* scr, int item, int lane) {
    const int nblk = N / 32, kb = item / nblk, nb = item % nblk, k0 = 64 * kb, n0 = 32 * nb;
#pragma unroll 8
    for (int i = 0; i < 32; ++i) { const int kk = 2 * i + (lane >> 5); scr[kk * 33 + (lane & 31)] = W[(size_t)(k0 + kk) * ldn + n0 + (lane & 31)]; }
    LDS_WAIT();
    const int c = lane & 7;
#pragma unroll
    for (int j = 0; j < 4; ++j) { const int n = (lane >> 3) + 8 * j; const LAS float* s = scr + (8 * c) * 33 + n;
        u32x4 o; o.x = pk2(s[0 * 33], s[1 * 33]); o.y = pk2(s[2 * 33], s[3 * 33]); o.z = pk2(s[4 * 33], s[5 * 33]); o.w = pk2(s[6 * 33], s[7 * 33]);
        *(u32x4*)(WT + (size_t)(row_off + n0 + n) * K + k0 + 8 * c) = o; }
    LDS_WAIT();
}

struct Ptrs {
    const float *x, *c; const int* pos; const float *ada_w, *ada_b, *norm_mix, *norm_mlp, *mlp_w1, *mlp_w2;
    const float *mla_w_in, *mla_g_qa, *mla_w_qb, *mla_g_kva, *mla_w_kvb, *mla_g_q, *mla_g_k, *mla_w_o;
    const float *dil_w_in, *dil_g_q, *dil_g_k, *dil_w_o, *rel_bias;
    float* out; unsigned char* ws;
};

__device__ __forceinline__ void p0_weights(const Ptrs& P, LAS float* scr, int gw, int ngw, int lane) {
    unsigned char* ws = P.ws;
    constexpr int I_IN0 = (DM / 64) * (MLA_IN / 32), I_QB = (QLORA / 64) * (1536 / 32), I_KVB = (KVLORA / 64) * (2048 / 32), I_O = (DM / 64) * (DM / 32);
    constexpr int I_1 = (DM / 64) * (DFF / 32), I_2 = (DFF / 64) * (DM / 32), I_IN1 = (DM / 64) * (DIL_IN / 32);
    constexpr int NITEMS = I_IN0 + I_QB + I_KVB + I_O + 2 * I_1 + 2 * I_2 + I_IN1 + I_O;
    for (int it = gw; it < NITEMS; it += ngw) {
        int r = it;
        if (r < I_IN0) { transpose_item(P.mla_w_in, DM, MLA_IN, MLA_IN, (bf16_t*)(ws + WS_WIN0), 0, scr, r, lane); continue; } r -= I_IN0;
        if (r < I_QB) { transpose_item(P.mla_w_qb, QLORA, 1536, 1536, (bf16_t*)(ws + WS_WQB), 0, scr, r, lane); continue; } r -= I_QB;
        if (r < I_KVB) { transpose_item(P.mla_w_kvb, KVLORA, 2048, 2048, (bf16_t*)(ws + WS_WKVB), 0, scr, r, lane); continue; } r -= I_KVB;
        if (r < I_O) { transpose_item(P.mla_w_o, DM, DM, DM, (bf16_t*)(ws + WS_WO0), 0, scr, r, lane); continue; } r -= I_O;
        if (r < I_1) { transpose_item(P.mlp_w1, DM, DFF, DFF, (bf16_t*)(ws + WS_W1_0), 0, scr, r, lane); continue; } r -= I_1;
        if (r < I_1) { transpose_item(P.mlp_w1 + (size_t)DM * DFF, DM, DFF, DFF, (bf16_t*)(ws + WS_W1_1), 0, scr, r, lane); continue; } r -= I_1;
        if (r < I_2) { transpose_item(P.mlp_w2, DFF, DM, DM, (bf16_t*)(ws + WS_W2_0), 0, scr, r, lane); continue; } r -= I_2;
        if (r < I_2) { transpose_item(P.mlp_w2 + (size_t)DFF * DM, DFF, DM, DM, (bf16_t*)(ws + WS_W2_1), 0, scr, r, lane); continue; } r -= I_2;
        if (r < I_IN1) { transpose_item(P.dil_w_in, DM, DIL_IN, DIL_IN, (bf16_t*)(ws + WS_WIN1), 0, scr, r, lane); continue; } r -= I_IN1;
        transpose_item(P.dil_w_o, DM, DM, DM, (bf16_t*)(ws + WS_WO1), 0, scr, r, lane);
    }
    u32x4* z = (u32x4*)(ws + WS_WIN0 + (size_t)MLA_IN * DM * 2);
    for (int i = gw * 64 + lane; i < 12288; i += ngw * 64) z[i] = (u32x4){0u, 0u, 0u, 0u};
}
__device__ __forceinline__ void p0_cs(const Ptrs& P, int gtid, int nthr) {
    float* cs = (float*)(P.ws + WS_CS);
    for (int i = gtid; i < MTOK * 16; i += nthr) { const int m = i >> 4, f = i & 15;
        const float inv = 1.0f / powf(10000.0f, (float)f * 0.0625f); const float ang = (float)P.pos[m] * inv;
        cs[m * 32 + f] = cosf(ang); cs[m * 32 + 16 + f] = sinf(ang); }
}
__device__ __forceinline__ void p0_mod(const Ptrs& P, LAS float* lds, int bid, int nblk, int tid, int nwaves) {
    LAS float* cond = lds; LAS float* red = lds + 8 * DM;
    float* mod = (float*)(P.ws + WS_MOD);
    for (int i = tid; i < 8 * DM; i += nwaves * 64) { const float v = P.c[i]; cond[i] = v / (1.0f + expf(-v)); }
    __syncthreads();
    const int w = tid >> 6, lane = tid & 63, col = lane & 31, kp = lane >> 5, kper = DM / nwaves;
    for (int item = bid; item < 2 * (MODW / 32); item += nblk) {
        const int l = item / (MODW / 32), n0 = (item % (MODW / 32)) * 32;
        float acc[8];
#pragma unroll
        for (int b = 0; b < 8; ++b) acc[b] = 0.f;
        const float* wp = P.ada_w + (size_t)l * DM * MODW + n0 + col;
#pragma unroll 8
        for (int kk = 0; kk < kper / 2; ++kk) { const int k = w * kper + 2 * kk + kp; const float wv = wp[(size_t)k * MODW];
#pragma unroll
            for (int b = 0; b < 8; ++b) acc[b] += cond[b * DM + k] * wv; }
#pragma unroll
        for (int b = 0; b < 8; ++b) { acc[b] += __shfl_xor(acc[b], 32); if (lane < 32) red[(w * 8 + b) * 32 + col] = acc[b]; }
        __syncthreads();
        if (tid < 256) { const int b = tid >> 5, cc = tid & 31; float s = P.ada_b[l * MODW + n0 + cc];
            for (int ww = 0; ww < nwaves; ++ww) s += red[(ww * 8 + b) * 32 + cc];
            mod[(size_t)(l * 8 + b) * MODW + n0 + cc] = s; }
        __syncthreads();
    }
}
__device__ __forceinline__ void lnmod_rows(const float* X, const float* g, const float* modl  , int shift_idx, int scale_idx, bf16_t* H, int gw, int ngw, int lane) {
    for (int m = gw; m < MTOK; m += ngw) {
        const f32x4* xr = (const f32x4*)(X + (size_t)m * DM) + lane;
        f32x4 v[4]; float ss = 0.f;
#pragma unroll
        for (int j = 0; j < 4; ++j) { v[j] = xr[64 * j]; ss += (v[j].x * v[j].x + v[j].y * v[j].y) + (v[j].z * v[j].z + v[j].w * v[j].w); }
        const float rstd = 1.0f / sqrtf(wave_sum(ss) * (1.0f / DM) + EPS);
        const float* mb = modl + (size_t)(m / SEQ) * MODW;
        u32x2* o = (u32x2*)(H + (size_t)m * DM) + lane;
#pragma unroll
        for (int j = 0; j < 4; ++j) { const int col = 4 * (lane + 64 * j);
            const f32x4 gg = *(const f32x4*)(g + col), sc = *(const f32x4*)(mb + scale_idx * DM + col), sh = *(const f32x4*)(mb + shift_idx * DM + col);
            const f32x4 y = v[j] * rstd * gg * (sc + 1.0f) + sh;
            u32x2 w; w.x = pk2(y.x, y.y); w.y = pk2(y.z, y.w); o[64 * j] = w; }
    }
}
__device__ __forceinline__ void mla_prep_rows(const Ptrs& P, int gw, int ngw, int lane) {
    const float* PROJ = (const float*)(P.ws + WS_PROJ); const float* cs = (const float*)(P.ws + WS_CS);
    bf16_t* QA = (bf16_t*)(P.ws + WS_QA); bf16_t* KVA = (bf16_t*)(P.ws + WS_KVA); float* KR = (float*)(P.ws + WS_KR);
    for (int m = gw; m < MTOK; m += ngw) {
        const float* p = PROJ + (size_t)m * MLA_INP;
        float q[8]; float ss = 0.f;
        if (lane < 48) { const f32x4 a = *(const f32x4*)(p + 8 * lane), b = *(const f32x4*)(p + 8 * lane + 4);
            q[0] = a.x; q[1] = a.y; q[2] = a.z; q[3] = a.w; q[4] = b.x; q[5] = b.y; q[6] = b.z; q[7] = b.w;
#pragma unroll
            for (int i = 0; i < 8; ++i) ss += q[i] * q[i]; }
        else {
#pragma unroll
            for (int i = 0; i < 8; ++i) q[i] = 0.f; }
        const float rq = 1.0f / sqrtf(wave_sum(ss) * (1.0f / QLORA) + EPS);
        if (lane < 48) { float o[8];
#pragma unroll
            for (int i = 0; i < 8; ++i) o[i] = q[i] * rq * P.mla_g_qa[8 * lane + i];
            *(u32x4*)(QA + (size_t)m * QLORA + 8 * lane) = pack8(o); }
        float kv[8]; float s2 = 0.f;
        if (lane < 32) { const f32x4 a = *(const f32x4*)(p + QLORA + 8 * lane), b = *(const f32x4*)(p + QLORA + 8 * lane + 4);
            kv[0] = a.x; kv[1] = a.y; kv[2] = a.z; kv[3] = a.w; kv[4] = b.x; kv[5] = b.y; kv[6] = b.z; kv[7] = b.w;
#pragma unroll
            for (int i = 0; i < 8; ++i) s2 += kv[i] * kv[i]; }
        else {
#pragma unroll
            for (int i = 0; i < 8; ++i) kv[i] = 0.f; }
        const float rk = 1.0f / sqrtf(wave_sum(s2) * (1.0f / KVLORA) + EPS);
        if (lane < 32) { float o[8];
#pragma unroll
            for (int i = 0; i < 8; ++i) o[i] = kv[i] * rk * P.mla_g_kva[8 * lane + i];
            *(u32x4*)(KVA + (size_t)m * KVLORA + 8 * lane) = pack8(o); }
        if (lane < 16) { const float x1 = p[QLORA + KVLORA + lane], x2 = p[QLORA + KVLORA + 16 + lane]; const float c = cs[m * 32 + lane], s = cs[m * 32 + 16 + lane];
            KR[m * 32 + lane] = x1 * c - x2 * s; KR[m * 32 + 16 + lane] = x2 * c + x1 * s; }
    }
}
__device__ __forceinline__ void mla_final_rows(const Ptrs& P, int gw, int ngw, int lane) {
    const float* cs = (const float*)(P.ws + WS_CS); const float* KR = (const float*)(P.ws + WS_KR);
    bf16_t* Q = (bf16_t*)(P.ws + WS_Q); bf16_t* KV = (bf16_t*)(P.ws + WS_KV); bf16_t* KROPE = (bf16_t*)(P.ws + WS_KROPE);
    const int h = lane >> 2, sub = lane & 3;
    for (int m = gw; m < MTOK; m += ngw) {
        float c4[4], s4[4];
#pragma unroll
        for (int t = 0; t < 4; ++t) { c4[t] = cs[m * 32 + 4 * sub + t]; s4[t] = cs[m * 32 + 16 + 4 * sub + t]; }
        {
            bf16_t* qb = Q + (size_t)m * 1536 + h * QKD;
            float a[8], b[8]; unpack8(*(const u32x4*)(qb + 16 * sub), a); unpack8(*(const u32x4*)(qb + 16 * sub + 8), b);
            const u32x2 w1 = *(const u32x2*)(qb + NOPE + 4 * sub), w2 = *(const u32x2*)(qb + NOPE + 16 + 4 * sub);
            const float r1[4] = {bf2f(w1.x & 0xffffu), bf2f(w1.x >> 16), bf2f(w1.y & 0xffffu), bf2f(w1.y >> 16)};
            const float r2[4] = {bf2f(w2.x & 0xffffu), bf2f(w2.x >> 16), bf2f(w2.y & 0xffffu), bf2f(w2.y >> 16)};
            float y1[4], y2[4]; float ss = 0.f;
#pragma unroll
            for (int t = 0; t < 4; ++t) { y1[t] = r1[t] * c4[t] - r2[t] * s4[t]; y2[t] = r2[t] * c4[t] + r1[t] * s4[t]; ss += y1[t] * y1[t] + y2[t] * y2[t]; }
#pragma unroll
            for (int i = 0; i < 8; ++i) ss += a[i] * a[i] + b[i] * b[i];
            ss += __shfl_xor(ss, 1); ss += __shfl_xor(ss, 2);
            const float rs = MLA_C2 / sqrtf(ss * (1.0f / QKD) + EPS);
#pragma unroll
            for (int i = 0; i < 8; ++i) { a[i] *= rs * P.mla_g_q[16 * sub + i]; b[i] *= rs * P.mla_g_q[16 * sub + 8 + i]; }
#pragma unroll
            for (int t = 0; t < 4; ++t) { y1[t] *= rs * P.mla_g_q[NOPE + 4 * sub + t]; y2[t] *= rs * P.mla_g_q[NOPE + 16 + 4 * sub + t]; }
            *(u32x4*)(qb + 16 * sub) = pack8(a); *(u32x4*)(qb + 16 * sub + 8) = pack8(b);
            u32x2 o1, o2; o1.x = pk2(y1[0], y1[1]); o1.y = pk2(y1[2], y1[3]); o2.x = pk2(y2[0], y2[1]); o2.y = pk2(y2[2], y2[3]);
            *(u32x2*)(qb + NOPE + 4 * sub) = o1; *(u32x2*)(qb + NOPE + 16 + 4 * sub) = o2;
        }
        {
            bf16_t* kb = KV + (size_t)m * 2048 + h * 128;
            float a[8], b[8]; unpack8(*(const u32x4*)(kb + 16 * sub), a); unpack8(*(const u32x4*)(kb + 16 * sub + 8), b);
            const f32x4 k1 = *(const f32x4*)(KR + m * 32 + 4 * sub), k2 = *(const f32x4*)(KR + m * 32 + 16 + 4 * sub);
            float ss = (k1.x * k1.x + k1.y * k1.y) + (k1.z * k1.z + k1.w * k1.w) + (k2.x * k2.x + k2.y * k2.y) + (k2.z * k2.z + k2.w * k2.w);
#pragma unroll
            for (int i = 0; i < 8; ++i) ss += a[i] * a[i] + b[i] * b[i];
            ss += __shfl_xor(ss, 1); ss += __shfl_xor(ss, 2);
            const float rs = 1.0f / sqrtf(ss * (1.0f / QKD) + EPS);
#pragma unroll
            for (int i = 0; i < 8; ++i) { a[i] *= rs * P.mla_g_k[16 * sub + i]; b[i] *= rs * P.mla_g_k[16 * sub + 8 + i]; }
            *(u32x4*)(kb + 16 * sub) = pack8(a); *(u32x4*)(kb + 16 * sub + 8) = pack8(b);
            const f32x4 g1 = *(const f32x4*)(P.mla_g_k + NOPE + 4 * sub), g2 = *(const f32x4*)(P.mla_g_k + NOPE + 16 + 4 * sub);
            u32x2 o1, o2; o1.x = pk2(k1.x * rs * g1.x, k1.y * rs * g1.y); o1.y = pk2(k1.z * rs * g1.z, k1.w * rs * g1.w);
            o2.x = pk2(k2.x * rs * g2.x, k2.y * rs * g2.y); o2.y = pk2(k2.z * rs * g2.z, k2.w * rs * g2.w);
            bf16_t* kr = KROPE + (size_t)m * 512 + h * 32;
            *(u32x2*)(kr + 4 * sub) = o1; *(u32x2*)(kr + 16 + 4 * sub) = o2;
        }
    }
}

struct EpiF32 { static constexpr int NV = 4; float* C; int ldc, pad;
    __device__ __forceinline__ void store(int row, int col, const float* v) const { *(f32x4*)(C + (size_t)row * ldc + col) = (f32x4){v[0], v[1], v[2], v[3]}; } };
struct EpiBf16 { static constexpr int NV = 8; bf16_t* C; int ldc, pad;
    __device__ __forceinline__ void store(int row, int col, const float* v) const { u32x4 w; w.x = pk2(v[0], v[1]); w.y = pk2(v[2], v[3]); w.z = pk2(v[4], v[5]); w.w = pk2(v[6], v[7]);
        *(u32x4*)(C + (size_t)row * ldc + col) = w; } };
struct EpiSqRelu { static constexpr int NV = 8; bf16_t* C; int ldc, pad;
    __device__ __forceinline__ void store(int row, int col, const float* v) const { float r[8];
#pragma unroll
        for (int i = 0; i < 8; ++i) { const float t = fmaxf(v[i], 0.f); r[i] = t * t; }
        u32x4 w; w.x = pk2(r[0], r[1]); w.y = pk2(r[2], r[3]); w.z = pk2(r[4], r[5]); w.w = pk2(r[6], r[7]);
        *(u32x4*)(C + (size_t)row * ldc + col) = w; } };
struct EpiResGate { static constexpr int NV = 4; const float* base; float* out; const float* gate  ;
    __device__ __forceinline__ void store(int row, int col, const float* v) const {
        const f32x4 b = *(const f32x4*)(base + (size_t)row * DM + col), g = *(const f32x4*)(gate + (size_t)(row / SEQ) * MODW + col);
        *(f32x4*)(out + (size_t)row * DM + col) = b + g * (f32x4){v[0], v[1], v[2], v[3]}; } };

template <class Epi> __global__ void __launch_bounds__(256) naive_gemm(const bf16_t* A, const bf16_t* Bt, int Mr, int N, int K, int pad_, Epi E) {
    __shared__ float As[16][68]; __shared__ float Bs[16][132];
    const int tid = threadIdx.x, tx = tid & 15, ty = tid >> 4;
    const int nb = N / 128, bm = blockIdx.x / nb, bn = blockIdx.x % nb;
    float acc[4][8];
#pragma unroll
    for (int i = 0; i < 4; ++i)
#pragma unroll
        for (int j = 0; j < 8; ++j) acc[i][j] = 0.f;
    const int ar = tid >> 2, ac = (tid & 3) * 4;
    const int br = tid >> 1, bc = (tid & 1) * 8;
    for (int k0 = 0; k0 < K; k0 += 16) {
        const u32x2 av = *(const u32x2*)(A + (size_t)(bm * 64 + ar) * K + k0 + ac);
        const u32x4 bv = *(const u32x4*)(Bt + (size_t)(bn * 128 + br) * K + k0 + bc);
        __syncthreads();
        As[ac + 0][ar] = bf2f(av.x & 0xffffu); As[ac + 1][ar] = bf2f(av.x >> 16); As[ac + 2][ar] = bf2f(av.y & 0xffffu); As[ac + 3][ar] = bf2f(av.y >> 16);
        float bf[8]; unpack8(bv, bf);
#pragma unroll
        for (int i = 0; i < 8; ++i) Bs[bc + i][br] = bf[i];
        __syncthreads();
#pragma unroll
        for (int k = 0; k < 16; ++k) {
            const f32x4 a = *(const f32x4*)&As[k][ty * 4]; const f32x4 b0 = *(const f32x4*)&Bs[k][tx * 8], b1 = *(const f32x4*)&Bs[k][tx * 8 + 4];
            const float aa[4] = {a.x, a.y, a.z, a.w}; const float bb[8] = {b0.x, b0.y, b0.z, b0.w, b1.x, b1.y, b1.z, b1.w};
#pragma unroll
            for (int i = 0; i < 4; ++i)
#pragma unroll
                for (int j = 0; j < 8; ++j) acc[i][j] += aa[i] * bb[j];
        }
    }
#pragma unroll
    for (int i = 0; i < 4; ++i) { const int row = bm * 64 + ty * 4 + i, col = bn * 128 + tx * 8;
        if (Epi::NV == 8) E.store(row, col, acc[i]); else { E.store(row, col, acc[i]); E.store(row, col + 4, acc[i] + 4); } }
}

__global__ void __launch_bounds__(256) naive_mla_attn(const bf16_t* Q, const bf16_t* KV, const bf16_t* KROPE, bf16_t* O) {
    __shared__ float Ks[32][QKD]; __shared__ float Vs[32][VD];
    const int tid = threadIdx.x, qb = blockIdx.x & 7, h = (blockIdx.x >> 3) & 15, b = blockIdx.x >> 7;
    const size_t m = (size_t)b * SEQ + qb * 256 + tid;
    float q[QKD];
#pragma unroll
    for (int c = 0; c < 12; ++c) { float f[8]; unpack8(*(const u32x4*)(Q + m * 1536 + h * QKD + 8 * c), f);
#pragma unroll
        for (int i = 0; i < 8; ++i) q[8 * c + i] = f[i]; }
    float o[VD];
#pragma unroll
    for (int i = 0; i < VD; ++i) o[i] = 0.f;
    float mx = -INFINITY, l = 0.f;
    for (int t = 0; t < SEQ / 32; ++t) {
        __syncthreads();
        {
            for (int c = tid; c < 640; c += 256) { const int key = c / 20, ch = c % 20; const size_t km = (size_t)b * SEQ + t * 32 + key; float f[8];
                if (ch < 8) { unpack8(*(const u32x4*)(KV + km * 2048 + h * 128 + 8 * ch), f);
#pragma unroll
                    for (int i = 0; i < 8; ++i) Ks[key][8 * ch + i] = f[i]; }
                else if (ch < 12) { unpack8(*(const u32x4*)(KROPE + km * 512 + h * 32 + 8 * (ch - 8)), f);
#pragma unroll
                    for (int i = 0; i < 8; ++i) Ks[key][NOPE + 8 * (ch - 8) + i] = f[i]; }
                else { unpack8(*(const u32x4*)(KV + km * 2048 + h * 128 + 64 + 8 * (ch - 12)), f);
#pragma unroll
                    for (int i = 0; i < 8; ++i) Vs[key][8 * (ch - 12) + i] = f[i]; } }
        }
        __syncthreads();
        for (int key = 0; key < 32; ++key) {
            float s = 0.f;
#pragma unroll
            for (int d = 0; d < QKD; d += 4) { const f32x4 kk = *(const f32x4*)&Ks[key][d]; s += q[d] * kk.x + q[d + 1] * kk.y + q[d + 2] * kk.z + q[d + 3] * kk.w; }
            if (s > mx) { const float al = exp2f(mx - s); l *= al;
#pragma unroll
                for (int i = 0; i < VD; ++i) o[i] *= al;
                mx = s; }
            const float p = exp2f(s - mx); l += p;
#pragma unroll
            for (int d = 0; d < VD; d += 4) { const f32x4 vv = *(const f32x4*)&Vs[key][d]; o[d] += p * vv.x; o[d + 1] += p * vv.y; o[d + 2] += p * vv.z; o[d + 3] += p * vv.w; }
        }
    }
    const float rl = 1.0f / l;
#pragma unroll
    for (int c = 0; c < 8; ++c) { float f[8];
#pragma unroll
        for (int i = 0; i < 8; ++i) f[i] = o[8 * c + i] * rl;
        *(u32x4*)(O + m * DM + h * VD + 8 * c) = pack8(f); }
}

__global__ void __launch_bounds__(256) naive_dil_attn(const bf16_t* QKVG, const int* pos, const float* g_q, const float* g_k, const float* rel_bias, int g, int dil, bf16_t* O2, float* LSE) {
    const int tid = threadIdx.x, sb = blockIdx.x & 7, h = (blockIdx.x >> 3) & 15, b = blockIdx.x >> 7;
    const int s = sb * 256 + tid; const size_t m = (size_t)b * SEQ + s;
    float q[64]; float ss = 0.f;
#pragma unroll
    for (int c = 0; c < 8; ++c) { float f[8]; unpack8(*(const u32x4*)(QKVG + m * GCOLS + h * 64 + 8 * c), f);
#pragma unroll
        for (int i = 0; i < 8; ++i) { q[8 * c + i] = f[i]; ss += f[i] * f[i]; } }
    const float rq = DIL_C2 / sqrtf(ss * (1.0f / 64) + EPS);
#pragma unroll
    for (int i = 0; i < 64; ++i) q[i] *= rq * g_q[g * 64 + i] * g_k[g * 64 + i];
    float o[64];
#pragma unroll
    for (int i = 0; i < 64; ++i) o[i] = 0.f;
    float mx = -INFINITY, l = 0.f; const int pq = pos[m];
    for (int j = -64; j <= 64; ++j) {
        const int sk = s + j * dil; if (sk < 0 || sk >= SEQ) continue;
        const size_t km = (size_t)b * SEQ + sk;
        float dot = 0.f, sk2 = 0.f;
#pragma unroll
        for (int c = 0; c < 8; ++c) { float f[8]; unpack8(*(const u32x4*)(QKVG + km * GCOLS + 1024 + h * 64 + 8 * c), f);
#pragma unroll
            for (int i = 0; i < 8; ++i) { dot += q[8 * c + i] * f[i]; sk2 += f[i] * f[i]; } }
        const float bias = rel_bias[t5_bucket(pos[km] - pq) * 48 + g * 16 + h] * LOG2E;
        const float sc = dot / sqrtf(sk2 * (1.0f / 64) + EPS) + bias;
        if (sc > mx) { const float al = exp2f(mx - sc); l *= al;
#pragma unroll
            for (int i = 0; i < 64; ++i) o[i] *= al;
            mx = sc; }
        const float p = exp2f(sc - mx); l += p;
#pragma unroll
        for (int c = 0; c < 8; ++c) { float f[8]; unpack8(*(const u32x4*)(QKVG + km * GCOLS + 2048 + h * 64 + 8 * c), f);
#pragma unroll
            for (int i = 0; i < 8; ++i) o[8 * c + i] += p * f[i]; }
    }
    float lse = mx + log2f(l); float wn = 1.0f / l, wo = 0.f;
    if (g > 0) { const float lo = LSE[m * 16 + h]; const float mm = fmaxf(lo, lse); const float ea = exp2f(lo - mm), eb = exp2f(lse - mm); const float nl = mm + log2f(ea + eb);
        wo = exp2f(lo - nl); wn = exp2f(lse - nl) / l; lse = nl; }
    LSE[m * 16 + h] = lse;
#pragma unroll
    for (int c = 0; c < 8; ++c) { float f[8], old[8];
        if (g > 0) unpack8(*(const u32x4*)(O2 + m * DM + h * 64 + 8 * c), old);
#pragma unroll
        for (int i = 0; i < 8; ++i) f[i] = o[8 * c + i] * wn + (g > 0 ? old[i] * wo : 0.f);
        *(u32x4*)(O2 + m * DM + h * 64 + 8 * c) = pack8(f); }
}

__global__ void __launch_bounds__(512) k_prep(Ptrs P) {
    extern __shared__ __attribute__((aligned(16))) unsigned char lds[];
    const int tid = threadIdx.x, lane = tid & 63, wave = tid >> 6, gw = blockIdx.x * 8 + wave, ngw = gridDim.x * 8;
    p0_weights(P, (LAS float*)lds + wave * (64 * 33), gw, ngw, lane);
    p0_cs(P, blockIdx.x * 512 + tid, gridDim.x * 512);
    __syncthreads();
    p0_mod(P, (LAS float*)lds, blockIdx.x, gridDim.x, tid, 8);
}
__global__ void __launch_bounds__(512) k_lnmod(Ptrs P, const float* X, const float* g, int layer, int shift_idx, int scale_idx, int pad_) {
    const int tid = threadIdx.x;
    lnmod_rows(X, g, (const float*)(P.ws + WS_MOD) + (size_t)layer * 8 * MODW, shift_idx, scale_idx, (bf16_t*)(P.ws + WS_H), blockIdx.x * 8 + (tid >> 6), gridDim.x * 8, tid & 63);
}
__global__ void __launch_bounds__(512) k_mla_prep(Ptrs P) { const int tid = threadIdx.x; mla_prep_rows(P, blockIdx.x * 8 + (tid >> 6), gridDim.x * 8, tid & 63); }
__global__ void __launch_bounds__(512) k_mla_final(Ptrs P) { const int tid = threadIdx.x; mla_final_rows(P, blockIdx.x * 8 + (tid >> 6), gridDim.x * 8, tid & 63); }

template <class Epi> static void gemm(hipStream_t st, const void* A, const void* Bt, int N, int K, Epi E) {
    naive_gemm<Epi><<<(MTOK / 64) * (N / 128), 256, 0, st>>>((const bf16_t*)A, (const bf16_t*)Bt, MTOK, N, K, 0, E);
}

extern "C" void kernel_launch(void* const* d_in, const int* in_sizes, int n_in, void* d_out, int out_size, void* d_ws, size_t ws_size, hipStream_t stream) {
    if (n_in != 22 || ws_size < WS_END) { fprintf(stderr, "kernel_launch: unexpected n_in %d / ws %zu\n", n_in, ws_size); return; }
    Ptrs P{};
    P.x = (const float*)d_in[0]; P.c = (const float*)d_in[1]; P.pos = (const int*)d_in[2]; P.ada_w = (const float*)d_in[3]; P.ada_b = (const float*)d_in[4];
    P.norm_mix = (const float*)d_in[5]; P.norm_mlp = (const float*)d_in[6]; P.mlp_w1 = (const float*)d_in[7]; P.mlp_w2 = (const float*)d_in[8];
    P.mla_w_in = (const float*)d_in[9]; P.mla_g_qa = (const float*)d_in[10]; P.mla_w_qb = (const float*)d_in[11]; P.mla_g_kva = (const float*)d_in[12];
    P.mla_w_kvb = (const float*)d_in[13]; P.mla_g_q = (const float*)d_in[14]; P.mla_g_k = (const float*)d_in[15]; P.mla_w_o = (const float*)d_in[16];
    P.dil_w_in = (const float*)d_in[17]; P.dil_g_q = (const float*)d_in[18]; P.dil_g_k = (const float*)d_in[19]; P.dil_w_o = (const float*)d_in[20]; P.rel_bias = (const float*)d_in[21];
    P.out = (float*)d_out; P.ws = (unsigned char*)d_ws;
    unsigned char* ws = P.ws; float* out = P.out;
    const float* mod0 = (const float*)(ws + WS_MOD); const float* mod1 = mod0 + 8 * MODW;
    static bool attr = false;
    if (!attr) { (void)hipFuncSetAttribute((const void*)k_prep, hipFuncAttributeMaxDynamicSharedMemorySize, 8 * 64 * 33 * 4); attr = true; }

    k_prep<<<256, 512, 8 * 64 * 33 * 4, stream>>>(P);
    k_lnmod<<<512, 512, 0, stream>>>(P, P.x, P.norm_mix, 0, 0, 1, 0);
    gemm(stream, ws + WS_H, ws + WS_WIN0, MLA_INP, DM, EpiF32{(float*)(ws + WS_PROJ), MLA_INP, 0});
    k_mla_prep<<<512, 512, 0, stream>>>(P);
    gemm(stream, ws + WS_QA, ws + WS_WQB, 1536, QLORA, EpiBf16{(bf16_t*)(ws + WS_Q), 1536, 0});
    gemm(stream, ws + WS_KVA, ws + WS_WKVB, 2048, KVLORA, EpiBf16{(bf16_t*)(ws + WS_KV), 2048, 0});
    k_mla_final<<<512, 512, 0, stream>>>(P);
    naive_mla_attn<<<NBATCH * NH * 8, 256, 0, stream>>>((const bf16_t*)(ws + WS_Q), (const bf16_t*)(ws + WS_KV), (const bf16_t*)(ws + WS_KROPE), (bf16_t*)(ws + WS_H));
    gemm(stream, ws + WS_H, ws + WS_WO0, DM, DM, EpiResGate{P.x, out, mod0 + 2 * DM});
    k_lnmod<<<512, 512, 0, stream>>>(P, out, P.norm_mlp, 0, 3, 4, 0);
    gemm(stream, ws + WS_H, ws + WS_W1_0, DFF, DM, EpiSqRelu{(bf16_t*)(ws + WS_U), DFF, 0});
    gemm(stream, ws + WS_U, ws + WS_W2_0, DM, DFF, EpiResGate{out, out, mod0 + 5 * DM});
    k_lnmod<<<512, 512, 0, stream>>>(P, out, P.norm_mix + DM, 1, 0, 1, 0);
    const int dils[3] = {1, 4, 16};
    for (int g = 0; g < 3; ++g) {
        gemm(stream, ws + WS_H, ws + WS_WIN1 + (size_t)g * GCOLS * DM * 2, GCOLS, DM, EpiBf16{(bf16_t*)(ws + WS_QKVG), GCOLS, 0});
        naive_dil_attn<<<NBATCH * NH * 8, 256, 0, stream>>>((const bf16_t*)(ws + WS_QKVG), P.pos, P.dil_g_q, P.dil_g_k, P.rel_bias, g, dils[g], (bf16_t*)(ws + WS_O2), (float*)(ws + WS_LSE));
    }
    gemm(stream, ws + WS_O2, ws + WS_WO1, DM, DM, EpiResGate{out, out, mod1 + 2 * DM});
    k_lnmod<<<512, 512, 0, stream>>>(P, out, P.norm_mlp + DM, 1, 3, 4, 0);
    gemm(stream, ws + WS_H, ws + WS_W1_1, DFF, DM, EpiSqRelu{(bf16_t*)(ws + WS_U), DFF, 0});
    gemm(stream, ws + WS_U, ws + WS_W2_1, DM, DFF, EpiResGate{out, out, mod1 + 5 * DM});
}
```

```cpp
#include <hip/hip_runtime.h>
#include <cstdint>
#include <cstdio>

#define LAS __attribute__((address_space(3)))
typedef unsigned short bf16_t;
typedef float f32x4 __attribute__((ext_vector_type(4)));
typedef float f32x2 __attribute__((ext_vector_type(2)));
typedef unsigned u32x4 __attribute__((ext_vector_type(4)));
typedef unsigned u32x2 __attribute__((ext_vector_type(2)));
typedef __bf16 bf16x2_t __attribute__((ext_vector_type(2)));

constexpr int DM = 1024, NBATCH = 8, SEQ = 2048, MTOK = NBATCH * SEQ;
constexpr int DFF = 4096, MODW = 6 * DM;
constexpr int QLORA = 384, KVLORA = 256, ROPE = 32, MLA_IN = 672, MLA_INP = 768;
constexpr int NH = 16, QKD = 96, NOPE = 64, VD = 64;
constexpr int DIL_IN = 9216, GCOLS = 3072, NBKT = 32;
constexpr float EPS = 1e-6f;
constexpr float LOG2E = 1.4426950408889634f;
constexpr float MLA_C2 = 0.10206207261596575f * LOG2E;
constexpr float DIL_C2 = 0.125f * LOG2E;

constexpr size_t MiB = 1u << 20;
constexpr size_t WS_CTL = 0, WS_MOD = 1 * MiB, WS_CS = 2 * MiB;
constexpr size_t WS_WIN0 = 4 * MiB, WS_WQB = 5 * MiB + 512 * 1024, WS_WKVB = 7 * MiB, WS_WO0 = 8 * MiB, WS_W1_0 = 10 * MiB, WS_W2_0 = 18 * MiB;
constexpr size_t WS_WIN1 = 26 * MiB, WS_WO1 = 44 * MiB, WS_W1_1 = 46 * MiB, WS_W2_1 = 54 * MiB;
constexpr size_t WS_H = 64 * MiB;
constexpr size_t WS_R = 96 * MiB;
constexpr size_t WS_PROJ = WS_R;
constexpr size_t WS_Q = WS_R;
constexpr size_t WS_KV = WS_R + 48 * MiB;
constexpr size_t WS_KROPE = WS_R + 112 * MiB;
constexpr size_t WS_QA = WS_R + 128 * MiB;
constexpr size_t WS_KVA = WS_R + 140 * MiB;
constexpr size_t WS_KR = WS_R + 148 * MiB;
constexpr size_t WS_U = WS_R;
constexpr size_t WS_QKVG = WS_R;
constexpr size_t WS_O2 = WS_R + 96 * MiB;
constexpr size_t WS_LSE = WS_R + 128 * MiB;
constexpr size_t WS_END = 256 * MiB;

__device__ __forceinline__ float bf2f(unsigned h) { return __uint_as_float(h << 16); }
__device__ __forceinline__ unsigned pk2(float lo, float hi) { f32x2 v = {lo, hi}; bf16x2_t b = __builtin_convertvector(v, bf16x2_t); return __builtin_bit_cast(unsigned, b); }
__device__ __forceinline__ float wave_sum(float v) {
#pragma unroll
    for (int o = 1; o < 64; o <<= 1) v += __shfl_xor(v, o);
    return v;
}
__device__ __forceinline__ void unpack8(u32x4 w, float (&f)[8]) {
    f[0] = bf2f(w.x & 0xffffu); f[1] = bf2f(w.x >> 16); f[2] = bf2f(w.y & 0xffffu); f[3] = bf2f(w.y >> 16);
    f[4] = bf2f(w.z & 0xffffu); f[5] = bf2f(w.z >> 16); f[6] = bf2f(w.w & 0xffffu); f[7] = bf2f(w.w >> 16);
}
__device__ __forceinline__ u32x4 pack8(const float (&f)[8]) { u32x4 w; w.x = pk2(f[0], f[1]); w.y = pk2(f[2], f[3]); w.z = pk2(f[4], f[5]); w.w = pk2(f[6], f[7]); return w; }
#define LDS_WAIT() asm volatile("s_waitcnt lgkmcnt(0)" ::: "memory")

__device__ __forceinline__ int t5_bucket(int rel) {
    const int n = rel < 0 ? -rel : rel;
    int b = n;
    if (n >= 8) b = 8 + (n >= 15) + (n >= 27) + (n >= 50) + (n >= 91) + (n >= 166) + (n >= 305) + (n >= 559);
    return b + (rel > 0 ? 16 : 0);
}

__device__ __forceinline__ void transpose_item(const float* W, int K, int ldn, int N, bf16_t* WT, int row_off, LAS float* scr, int item, int lane) {
    const int nblk = N / 32, kb = item / nblk, nb = item % nblk, k0 = 64 * kb, n0 = 32 * nb;
#pragma unroll 8
    for (int i = 0; i < 32; ++i) { const int kk = 2 * i + (lane >> 5); scr[kk * 33 + (lane & 31)] = W[(size_t)(k0 + kk) * ldn + n0 + (lane & 31)]; }
    LDS_WAIT();
    const int c = lane & 7;
#pragma unroll
    for (int j = 0; j < 4; ++j) { const int n = (lane >> 3) + 8 * j; const LAS float* s = scr + (8 * c) * 33 + n;
        u32x4 o; o.x = pk2(s[0 * 33], s[1 * 33]); o.y = pk2(s[2 * 33], s[3 * 33]); o.z = pk2(s[4 * 33], s[5 * 33]); o.w = pk2(s[6 * 33], s[7 * 33]);
        *(u32x4*)(WT + (size_t)(row_off + n0 + n) * K + k0 + 8 * c) = o; }
    LDS_WAIT();
}

struct Ptrs {
    const float *x, *c; const int* pos; const float *ada_w, *ada_b, *norm_mix, *norm_mlp, *mlp_w1, *mlp_w2;
    const float *mla_w_in, *mla_g_qa, *mla_w_qb, *mla_g_kva, *mla_w_kvb, *mla_g_q, *mla_g_k, *mla_w_o;
    const float *dil_w_in, *dil_g_q, *dil_g_k, *dil_w_o, *rel_bias;
    float* out; unsigned char* ws;
};

__device__ __forceinline__ void p0_weights(const Ptrs& P, LAS float* scr, int gw, int ngw, int lane) {
    unsigned char* ws = P.ws;
    constexpr int I_IN0 = (DM / 64) * (MLA_IN / 32), I_QB = (QLORA / 64) * (1536 / 32), I_KVB = (KVLORA / 64) * (2048 / 32), I_O = (DM / 64) * (DM / 32);
    constexpr int I_1 = (DM / 64) * (DFF / 32), I_2 = (DFF / 64) * (DM / 32), I_IN1 = (DM / 64) * (DIL_IN / 32);
    constexpr int NITEMS = I_IN0 + I_QB + I_KVB + I_O + 2 * I_1 + 2 * I_2 + I_IN1 + I_O;
    for (int it = gw; it < NITEMS; it += ngw) {
        int r = it;
        if (r < I_IN0) { transpose_item(P.mla_w_in, DM, MLA_IN, MLA_IN, (bf16_t*)(ws + WS_WIN0), 0, scr, r, lane); continue; } r -= I_IN0;
        if (r < I_QB) { transpose_item(P.mla_w_qb, QLORA, 1536, 1536, (bf16_t*)(ws + WS_WQB), 0, scr, r, lane); continue; } r -= I_QB;
        if (r < I_KVB) { transpose_item(P.mla_w_kvb, KVLORA, 2048, 2048, (bf16_t*)(ws + WS_WKVB), 0, scr, r, lane); continue; } r -= I_KVB;
        if (r < I_O) { transpose_item(P.mla_w_o, DM, DM, DM, (bf16_t*)(ws + WS_WO0), 0, scr, r, lane); continue; } r -= I_O;
        if (r < I_1) { transpose_item(P.mlp_w1, DM, DFF, DFF, (bf16_t*)(ws + WS_W1_0), 0, scr, r, lane); continue; } r -= I_1;
        if (r < I_1) { transpose_item(P.mlp_w1 + (size_t)DM * DFF, DM, DFF, DFF, (bf16_t*)(ws + WS_W1_1), 0, scr, r, lane); continue; } r -= I_1;
        if (r < I_2) { transpose_item(P.mlp_w2, DFF, DM, DM, (bf16_t*)(ws + WS_W2_0), 0, scr, r, lane); continue; } r -= I_2;
        if (r < I_2) { transpose_item(P.mlp_w2 + (size_t)DFF * DM, DFF, DM, DM, (bf16_t*)(ws + WS_W2_1), 0, scr, r, lane); continue; } r -= I_2;
        if (r < I_IN1) { transpose_item(P.dil_w_in, DM, DIL_IN, DIL_IN, (bf16_t*)(ws + WS_WIN1), 0, scr, r, lane); continue; } r -= I_IN1;
        transpose_item(P.dil_w_o, DM, DM, DM, (bf16_t*)(ws + WS_WO1), 0, scr, r, lane);
    }
    u32x4* z = (u32x4*)(ws + WS_WIN0 + (size_t)MLA_IN * DM * 2);
    for (int i = gw * 64 + lane; i < 12288; i += ngw * 64) z[i] = (u32x4){0u, 0u, 0u, 0u};
}
__device__ __forceinline__ void p0_cs(const Ptrs& P, int gtid, int nthr) {
    float* cs = (float*)(P.ws + WS_CS);
    for (int i = gtid; i < MTOK * 16; i += nthr) { const int m = i >> 4, f = i & 15;
        const float inv = 1.0f / powf(10000.0f, (float)f * 0.0625f); const float ang = (float)P.pos[m] * inv;
        cs[m * 32 + f] = cosf(ang); cs[m * 32 + 16 + f] = sinf(ang); }
}
__device__ __forceinline__ void p0_mod(const Ptrs& P, LAS float* lds, int bid, int nblk, int tid, int nwaves) {
    LAS float* cond = lds; LAS float* red = lds + 8 * DM;
    float* mod = (float*)(P.ws + WS_MOD);
    for (int i = tid; i < 8 * DM; i += nwaves * 64) { const float v = P.c[i]; cond[i] = v / (1.0f + expf(-v)); }
    __syncthreads();
    const int w = tid >> 6, lane = tid & 63, col = lane & 31, kp = lane >> 5, kper = DM / nwaves;
    for (int item = bid; item < 2 * (MODW / 32); item += nblk) {
        const int l = item / (MODW / 32), n0 = (item % (MODW / 32)) * 32;
        float acc[8];
#pragma unroll
        for (int b = 0; b < 8; ++b) acc[b] = 0.f;
        const float* wp = P.ada_w + (size_t)l * DM * MODW + n0 + col;
#pragma unroll 8
        for (int kk = 0; kk < kper / 2; ++kk) { const int k = w * kper + 2 * kk + kp; const float wv = wp[(size_t)k * MODW];
#pragma unroll
            for (int b = 0; b < 8; ++b) acc[b] += cond[b * DM + k] * wv; }
#pragma unroll
        for (int b = 0; b < 8; ++b) { acc[b] += __shfl_xor(acc[b], 32); if (lane < 32) red[(w * 8 + b) * 32 + col] = acc[b]; }
        __syncthreads();
        if (tid < 256) { const int b = tid >> 5, cc = tid & 31; float s = P.ada_b[l * MODW + n0 + cc];
            for (int ww = 0; ww < nwaves; ++ww) s += red[(ww * 8 + b) * 32 + cc];
            mod[(size_t)(l * 8 + b) * MODW + n0 + cc] = s; }
        __syncthreads();
    }
}
__device__ __forceinline__ void lnmod_rows(const float* X, const float* g, const float* modl  , int shift_idx, int scale_idx, bf16_t* H, int gw, int ngw, int lane) {
    for (int m = gw; m < MTOK; m += ngw) {
        const f32x4* xr = (const f32x4*)(X + (size_t)m * DM) + lane;
        f32x4 v[4]; float ss = 0.f;
#pragma unroll
        for (int j = 0; j < 4; ++j) { v[j] = xr[64 * j]; ss += (v[j].x * v[j].x + v[j].y * v[j].y) + (v[j].z * v[j].z + v[j].w * v[j].w); }
        const float rstd = 1.0f / sqrtf(wave_sum(ss) * (1.0f / DM) + EPS);
        const float* mb = modl + (size_t)(m / SEQ) * MODW;
        u32x2* o = (u32x2*)(H + (size_t)m * DM) + lane;
#pragma unroll
        for (int j = 0; j < 4; ++j) { const int col = 4 * (lane + 64 * j);
            const f32x4 gg = *(const f32x4*)(g + col), sc = *(const f32x4*)(mb + scale_idx * DM + col), sh = *(const f32x4*)(mb + shift_idx * DM + col);
            const f32x4 y = v[j] * rstd * gg * (sc + 1.0f) + sh;
            u32x2 w; w.x = pk2(y.x, y.y); w.y = pk2(y.z, y.w); o[64 * j] = w; }
    }
}
__device__ __forceinline__ void mla_prep_rows(const Ptrs& P, int gw, int ngw, int lane) {
    const float* PROJ = (const float*)(P.ws + WS_PROJ); const float* cs = (const float*)(P.ws + WS_CS);
    bf16_t* QA = (bf16_t*)(P.ws + WS_QA); bf16_t* KVA = (bf16_t*)(P.ws + WS_KVA); float* KR = (float*)(P.ws + WS_KR);
    for (int m = gw; m < MTOK; m += ngw) {
        const float* p = PROJ + (size_t)m * MLA_INP;
        float q[8]; float ss = 0.f;
        if (lane < 48) { const f32x4 a = *(const f32x4*)(p + 8 * lane), b = *(const f32x4*)(p + 8 * lane + 4);
            q[0] = a.x; q[1] = a.y; q[2] = a.z; q[3] = a.w; q[4] = b.x; q[5] = b.y; q[6] = b.z; q[7] = b.w;
#pragma unroll
            for (int i = 0; i < 8; ++i) ss += q[i] * q[i]; }
        else {
#pragma unroll
            for (int i = 0; i < 8; ++i) q[i] = 0.f; }
        const float rq = 1.0f / sqrtf(wave_sum(ss) * (1.0f / QLORA) + EPS);
        if (lane < 48) { float o[8];
#pragma unroll
            for (int i = 0; i < 8; ++i) o[i] = q[i] * rq * P.mla_g_qa[8 * lane + i];
            *(u32x4*)(QA + (size_t)m * QLORA + 8 * lane) = pack8(o); }
        float kv[8]; float s2 = 0.f;
        if (lane < 32) { const f32x4 a = *(const f32x4*)(p + QLORA + 8 * lane), b = *(const f32x4*)(p + QLORA + 8 * lane + 4);
            kv[0] = a.x; kv[1] = a.y; kv[2] = a.z; kv[3] = a.w; kv[4] = b.x; kv[5] = b.y; kv[6] = b.z; kv[7] = b.w;
#pragma unroll
            for (int i = 0; i < 8; ++i) s2 += kv[i] * kv[i]; }
        else {
#pragma unroll
            for (int i = 0; i < 8; ++i) kv[i] = 0.f; }
        const float rk = 1.0f / sqrtf(wave_sum(s2) * (1.0f / KVLORA) + EPS);
        if (lane < 32) { float o[8];
#pragma unroll
            for (int i = 0; i < 8; ++i) o[i] = kv[i] * rk * P.mla_g_kva[8 * lane + i];
            *(u32x4*)(KVA + (size_t)m * KVLORA + 8 * lane) = pack8(o); }
        if (lane < 16) { const float x1 = p[QLORA + KVLORA + lane], x2 = p[QLORA + KVLORA + 16 + lane]; const float c = cs[m * 32 + lane], s = cs[m * 32 + 16 + lane];
            KR[m * 32 + lane] = x1 * c - x2 * s; KR[m * 32 + 16 + lane] = x2 * c + x1 * s; }
    }
}
__device__ __forceinline__ void mla_final_rows(const Ptrs& P, int gw, int ngw, int lane) {
    const float* cs = (const float*)(P.ws + WS_CS); const float* KR = (const float*)(P.ws + WS_KR);
    bf16_t* Q = (bf16_t*)(P.ws + WS_Q); bf16_t* KV = (bf16_t*)(P.ws + WS_KV); bf16_t* KROPE = (bf16_t*)(P.ws + WS_KROPE);
    const int h = lane >> 2, sub = lane & 3;
    for (int m = gw; m < MTOK; m += ngw) {
        float c4[4], s4[4];
#pragma unroll
        for (int t = 0; t < 4; ++t) { c4[t] = cs[m * 32 + 4 * sub + t]; s4[t] = cs[m * 32 + 16 + 4 * sub + t]; }
        {
            bf16_t* qb = Q + (size_t)m * 1536 + h * QKD;
            float a[8], b[8]; unpack8(*(const u32x4*)(qb + 16 * sub), a); unpack8(*(const u32x4*)(qb + 16 * sub + 8), b);
            const u32x2 w1 = *(const u32x2*)(qb + NOPE + 4 * sub), w2 = *(const u32x2*)(qb + NOPE + 16 + 4 * sub);
            const float r1[4] = {bf2f(w1.x & 0xffffu), bf2f(w1.x >> 16), bf2f(w1.y & 0xffffu), bf2f(w1.y >> 16)};
            const float r2[4] = {bf2f(w2.x & 0xffffu), bf2f(w2.x >> 16), bf2f(w2.y & 0xffffu), bf2f(w2.y >> 16)};
            float y1[4], y2[4]; float ss = 0.f;
#pragma unroll
            for (int t = 0; t < 4; ++t) { y1[t] = r1[t] * c4[t] - r2[t] * s4[t]; y2[t] = r2[t] * c4[t] + r1[t] * s4[t]; ss += y1[t] * y1[t] + y2[t] * y2[t]; }
#pragma unroll
            for (int i = 0; i < 8; ++i) ss += a[i] * a[i] + b[i] * b[i];
            ss += __shfl_xor(ss, 1); ss += __shfl_xor(ss, 2);
            const float rs = MLA_C2 / sqrtf(ss * (1.0f / QKD) + EPS);
#pragma unroll
            for (int i = 0; i < 8; ++i) { a[i] *= rs * P.mla_g_q[16 * sub + i]; b[i] *= rs * P.mla_g_q[16 * sub + 8 + i]; }
#pragma unroll
            for (int t = 0; t < 4; ++t) { y1[t] *= rs * P.mla_g_q[NOPE + 4 * sub + t]; y2[t] *= rs * P.mla_g_q[NOPE + 16 + 4 * sub + t]; }
            *(u32x4*)(qb + 16 * sub) = pack8(a); *(u32x4*)(qb + 16 * sub + 8) = pack8(b);
            u32x2 o1, o2; o1.x = pk2(y1[0], y1[1]); o1.y = pk2(y1[2], y1[3]); o2.x = pk2(y2[0], y2[1]); o2.y = pk2(y2[2], y2[3]);
            *(u32x2*)(qb + NOPE + 4 * sub) = o1; *(u32x2*)(qb + NOPE + 16 + 4 * sub) = o2;
        }
        {
            bf16_t* kb = KV + (size_t)m * 2048 + h * 128;
            float a[8], b[8]; unpack8(*(const u32x4*)(kb + 16 * sub), a); unpack8(*(const u32x4*)(kb + 16 * sub + 8), b);
            const f32x4 k1 = *(const f32x4*)(KR + m * 32 + 4 * sub), k2 = *(const f32x4*)(KR + m * 32 + 16 + 4 * sub);
            float ss = (k1.x * k1.x + k1.y * k1.y) + (k1.z * k1.z + k1.w * k1.w) + (k2.x * k2.x + k2.y * k2.y) + (k2.z * k2.z + k2.w * k2.w);
#pragma unroll
            for (int i = 0; i < 8; ++i) ss += a[i] * a[i] + b[i] * b[i];
            ss += __shfl_xor(ss, 1); ss += __shfl_xor(ss, 2);
            const float rs = 1.0f / sqrtf(ss * (1.0f / QKD) + EPS);
#pragma unroll
            for (int i = 0; i < 8; ++i) { a[i] *= rs * P.mla_g_k[16 * sub + i]; b[i] *= rs * P.mla_g_k[16 * sub + 8 + i]; }
            *(u32x4*)(kb + 16 * sub) = pack8(a); *(u32x4*)(kb + 16 * sub + 8) = pack8(b);
            const f32x4 g1 = *(const f32x4*)(P.mla_g_k + NOPE + 4 * sub), g2 = *(const f32x4*)(P.mla_g_k + NOPE + 16 + 4 * sub);
            u32x2 o1, o2; o1.x = pk2(k1.x * rs * g1.x, k1.y * rs * g1.y); o1.y = pk2(k1.z * rs * g1.z, k1.w * rs * g1.w);
            o2.x = pk2(k2.x * rs * g2.x, k2.y * rs * g2.y); o2.y = pk2(k2.z * rs * g2.z, k2.w * rs * g2.w);
            bf16_t* kr = KROPE + (size_t)m * 512 + h * 32;
            *(u32x2*)(kr + 4 * sub) = o1; *(u32x2*)(kr + 16 + 4 * sub) = o2;
        }
    }
}

struct EpiF32 { static constexpr int NV = 4; float* C; int ldc, pad;
    __device__ __forceinline__ void store(int row, int col, const float* v) const { *(f32x4*)(C + (size_t)row * ldc + col) = (f32x4){v[0], v[1], v[2], v[3]}; } };
struct EpiBf16 { static constexpr int NV = 8; bf16_t* C; int ldc, pad;
    __device__ __forceinline__ void store(int row, int col, const float* v) const { u32x4 w; w.x = pk2(v[0], v[1]); w.y = pk2(v[2], v[3]); w.z = pk2(v[4], v[5]); w.w = pk2(v[6], v[7]);
        *(u32x4*)(C + (size_t)row * ldc + col) = w; } };
struct EpiSqRelu { static constexpr int NV = 8; bf16_t* C; int ldc, pad;
    __device__ __forceinline__ void store(int row, int col, const float* v) const { float r[8];
#pragma unroll
        for (int i = 0; i < 8; ++i) { const float t = fmaxf(v[i], 0.f); r[i] = t * t; }
        u32x4 w; w.x = pk2(r[0], r[1]); w.y = pk2(r[2], r[3]); w.z = pk2(r[4], r[5]); w.w = pk2(r[6], r[7]);
        *(u32x4*)(C + (size_t)row * ldc + col) = w; } };
struct EpiResGate { static constexpr int NV = 4; const float* base; float* out; const float* gate  ;
    __device__ __forceinline__ void store(int row, int col, const float* v) const {
        const f32x4 b = *(const f32x4*)(base + (size_t)row * DM + col), g = *(const f32x4*)(gate + (size_t)(row / SEQ) * MODW + col);
        *(f32x4*)(out + (size_t)row * DM + col) = b + g * (f32x4){v[0], v[1], v[2], v[3]}; } };

namespace pg8 {
#define PG8_LAS __attribute__((address_space(3)))
typedef unsigned short bf16_t;
typedef short bf16x8 __attribute__((ext_vector_type(8)));
typedef float f32x4 __attribute__((ext_vector_type(4)));
typedef unsigned u32x4 __attribute__((ext_vector_type(4)));
constexpr int BM = 256, BK = 64, HALF = 128, HTB = HALF * BK * 2  , STAGE_BYTES = 8 * HTB, NXCD = 8, WGM = 8;

__host__ __device__ __forceinline__ int lds_byte(int r, int c) { const int st = (r >> 4) * 2 + (c >> 5), rr = r & 15, cc = c & 31, ob = rr * 64 + cc * 2; return st * 1024 + (ob ^ (((ob >> 9) & 1) << 5)); }
__host__ __device__ __forceinline__ void stage_rc(int b, int& R, int& C) { const int st = b / 1024, sb = b % 1024, swz = sb ^ (((sb >> 9) & 1) << 5); R = (st >> 1) * 16 + swz / 64; C = (st & 1) * 32 + (swz % 64) / 2; }
__host__ __device__ __forceinline__ int perm32(int rho) { const int n = rho >> 4, i = rho & 15; return 8 * (i >> 2) + 4 * n + (i & 3); }

struct Unit { int pm, pn; };
struct Gemm { const bf16_t* A; const bf16_t* Bt; int M, N, K; };

struct StaticOrder {
    int nM, nN, nwg, G, c;
    __host__ __device__ void init(int M, int N, int G_, int c_) { nM = M / BM; nN = N / BM; nwg = nM * nN; G = G_; c = c_; }
    __host__ __device__ bool next(int i, Unit& u) const {
        const long L = (long)i * G + c; if (L >= nwg) return false;
        int wgid = (int)L; { const int q = nwg / NXCD, r = nwg % NXCD, xcd = wgid % NXCD, off = wgid / NXCD; wgid = (xcd < r ? xcd * (q + 1) : r * (q + 1) + (xcd - r) * q) + off; }
        const int nig = WGM * nN, gid = wgid / nig, fm = gid * WGM, gsz = (nM - fm) < WGM ? (nM - fm) : WGM;
        u.pm = fm + ((wgid % nig) % gsz); u.pn = (wgid % nig) / gsz; return true;
    }
    __device__ __forceinline__ void a_ready(const Unit&) const {}
    __device__ __forceinline__ void done(const Unit&) const {}
};

template <class Epi, class Sched, bool ALIGN_EPI = false, bool SP2 = false>
__device__ __forceinline__ void gemm_phase(PG8_LAS unsigned char* lds, const Gemm g, const Sched& S, const Epi& E) {
    int tid_ = threadIdx.x; asm volatile("" : "+v"(tid_));
    const int tid = tid_, wid = __builtin_amdgcn_readfirstlane(tid >> 6), lane = tid & 63, wr = wid >> 2, wc = wid & 3, fr = lane & 15, fq = lane >> 4;
    const int K = g.K, nt = K / BK;
    unsigned voffA[2], voffB[2];
#pragma unroll
    for (int i = 0; i < 2; ++i) { int R, C; stage_rc(tid * 16 + i * 8192, R, C); const int Rb = Epi::PERM ? ((R & ~31) + perm32(R & 31)) : R;
        voffA[i] = (unsigned)(R * K + C) * 2u; voffB[i] = (unsigned)(Rb * K + C) * 2u; }
    const size_t kstep = (size_t)(BK * 2);
    const size_t hstep = (size_t)HALF * K * 2;
    const size_t tstep = 2 * hstep;
    const unsigned ldsw = (unsigned)wid * 1024u;
    const int aoff = lds_byte(wr * 64 + fr, fq * 8), boff = lds_byte(wc * 32 + fr, fq * 8);
#define PG8_SA(b, h) (((b) * 2 + (h)) * HTB)
#define PG8_SB(b, h) ((4 + (b) * 2 + (h)) * HTB)
#define PG8_STAGE(bufoff, gbase, voff) do { _Pragma("unroll") for (int _i = 0; _i < 2; ++_i) \
        __builtin_amdgcn_global_load_lds((const unsigned*)((const char*)(gbase) + (voff)[_i]), (PG8_LAS unsigned*)(lds + (bufoff) + ldsw + _i * 8192), 16, 0, 0); } while (0)
#define PG8_LDA(dst, b, h) do { _Pragma("unroll") for (int m = 0; m < 4; ++m) _Pragma("unroll") for (int k = 0; k < 2; ++k) dst[m][k] = *(const PG8_LAS bf16x8*)(lds + PG8_SA(b, h) + aoff + m * 2048 + k * 1024); } while (0)
#define PG8_LDB(dst, b, h) do { _Pragma("unroll") for (int n = 0; n < 2; ++n) _Pragma("unroll") for (int k = 0; k < 2; ++k) dst[n][k] = *(const PG8_LAS bf16x8*)(lds + PG8_SB(b, h) + boff + n * 2048 + k * 1024); } while (0)
#define PG8_MMA(ai, bj, At, Bt) do { __builtin_amdgcn_s_setprio(1); _Pragma("unroll") for (int m = 0; m < 4; ++m) _Pragma("unroll") for (int n = 0; n < 2; ++n) _Pragma("unroll") for (int k = 0; k < 2; ++k) \
        acc[ai][bj][m][n] = __builtin_amdgcn_mfma_f32_16x16x32_bf16(Bt[n][k], At[m][k], acc[ai][bj][m][n], 0, 0, 0); __builtin_amdgcn_s_setprio(0); } while (0)
#define PG8_WAIT_V(n) asm volatile("s_waitcnt vmcnt(" #n ")" ::: "memory")
#define PG8_WAIT_L(n) asm volatile("s_waitcnt lgkmcnt(" #n ")" ::: "memory")
#define PG8_BAR __builtin_amdgcn_s_barrier()
#define PG8_SCHED __builtin_amdgcn_sched_barrier(0)
    Unit cur, nxt; int ui = 0;
    if (!S.next(0, cur)) return;
    f32x4 acc[2][2][4][2];
#pragma unroll
    for (int a = 0; a < 2; ++a)
#pragma unroll
        for (int b = 0; b < 2; ++b)
#pragma unroll
            for (int m = 0; m < 4; ++m)
#pragma unroll
                for (int n = 0; n < 2; ++n) acc[a][b][m][n] = (f32x4){0.f, 0.f, 0.f, 0.f};
    bf16x8 At[4][2], B0[2][2], B1[2][2];
    const char* cA = (const char*)g.A + (size_t)cur.pm * tstep; const char* cB = (const char*)g.Bt + (size_t)cur.pn * tstep;
    S.a_ready(cur);
    if constexpr (SP2) {
        PG8_STAGE(PG8_SB(0, 0), cB, voffB); PG8_STAGE(PG8_SB(0, 1), cB + hstep, voffB); PG8_STAGE(PG8_SA(0, 0), cA, voffA); PG8_STAGE(PG8_SA(0, 1), cA + hstep, voffA);
        if (wr == 1) PG8_BAR;
        PG8_WAIT_V(2); PG8_BAR;
        PG8_STAGE(PG8_SB(1, 0), cB + kstep, voffB); PG8_STAGE(PG8_SA(1, 0), cA + kstep, voffA); PG8_STAGE(PG8_SB(1, 1), cB + hstep + kstep, voffB);
        PG8_WAIT_V(6); PG8_BAR;
    } else {
        PG8_STAGE(PG8_SB(0, 0), cB, voffB); PG8_STAGE(PG8_SA(0, 0), cA, voffA); PG8_STAGE(PG8_SB(0, 1), cB + hstep, voffB); PG8_STAGE(PG8_SA(0, 1), cA + hstep, voffA);
        if (wr == 1) PG8_BAR;
        PG8_WAIT_V(4); PG8_BAR;
        PG8_STAGE(PG8_SB(1, 0), cB + kstep, voffB); PG8_STAGE(PG8_SA(1, 0), cA + kstep, voffA); PG8_STAGE(PG8_SB(1, 1), cB + hstep + kstep, voffB);
        PG8_WAIT_V(6); PG8_BAR;
    }
    for (;;) {
        const bool has_next = S.next(ui + 1, nxt);
        const char* nA = has_next ? (const char*)g.A + (size_t)nxt.pm * tstep : cA; const char* nB = has_next ? (const char*)g.Bt + (size_t)nxt.pn * tstep : cB;
        for (int t = 0; t < nt; t += 2) {
            const bool last = (t == nt - 2);
            const char* a1 = cA + (size_t)(t + 1) * kstep;
            const char* a2 = last ? nA : cA + (size_t)(t + 2) * kstep; const char* b2 = last ? nB : cB + (size_t)(t + 2) * kstep;
            const char* a3 = a2 + kstep; const char* b3 = b2 + kstep;
            if (last && has_next) S.a_ready(nxt);
            if constexpr (SP2) {
            PG8_LDB(B0, 0, 0); PG8_LDB(B1, 0, 1); PG8_SCHED; PG8_LDA(At, 0, 0); PG8_STAGE(PG8_SA(1, 1), a1 + hstep, voffA);
            PG8_WAIT_V(8); PG8_WAIT_L(0); PG8_BAR; PG8_MMA(0, 0, At, B0); PG8_MMA(0, 1, At, B1); PG8_BAR; PG8_SCHED;
            PG8_LDA(At, 0, 1); PG8_STAGE(PG8_SB(0, 0), b2, voffB); PG8_STAGE(PG8_SB(0, 1), b2 + hstep, voffB); PG8_STAGE(PG8_SA(0, 0), a2, voffA);
            PG8_WAIT_V(8); PG8_WAIT_L(0); PG8_BAR; PG8_MMA(1, 0, At, B0); PG8_MMA(1, 1, At, B1); PG8_BAR; PG8_SCHED;
            PG8_LDB(B0, 1, 0); PG8_LDB(B1, 1, 1); PG8_SCHED; PG8_LDA(At, 1, 0); PG8_STAGE(PG8_SA(0, 1), a2 + hstep, voffA);
            PG8_WAIT_V(8); PG8_WAIT_L(0); PG8_BAR; PG8_MMA(0, 0, At, B0); PG8_MMA(0, 1, At, B1); PG8_BAR; PG8_SCHED;
            PG8_LDA(At, 1, 1); PG8_STAGE(PG8_SB(1, 0), b3, voffB); PG8_STAGE(PG8_SB(1, 1), b3 + hstep, voffB); PG8_STAGE(PG8_SA(1, 0), a3, voffA);
            PG8_WAIT_V(8); PG8_WAIT_L(0); PG8_BAR; PG8_MMA(1, 0, At, B0); PG8_MMA(1, 1, At, B1); PG8_BAR; PG8_SCHED;
            } else {
            PG8_LDB(B0, 0, 0); PG8_SCHED; PG8_LDA(At, 0, 0); PG8_STAGE(PG8_SA(1, 1), a1 + hstep, voffA);
            PG8_WAIT_L(8); PG8_BAR; PG8_WAIT_L(0); PG8_MMA(0, 0, At, B0); PG8_BAR; PG8_SCHED;
            PG8_LDB(B1, 0, 1); PG8_STAGE(PG8_SB(0, 0), b2, voffB);
            PG8_BAR; PG8_WAIT_L(0); PG8_MMA(0, 1, At, B1); PG8_BAR;
            PG8_LDA(At, 0, 1); PG8_STAGE(PG8_SA(0, 0), a2, voffA);
            PG8_BAR; PG8_WAIT_L(0); PG8_MMA(1, 0, At, B0); PG8_BAR; PG8_SCHED;
            PG8_STAGE(PG8_SB(0, 1), b2 + hstep, voffB);
            PG8_WAIT_V(6); PG8_BAR; PG8_MMA(1, 1, At, B1); PG8_BAR;
            PG8_LDB(B0, 1, 0); PG8_SCHED; PG8_LDA(At, 1, 0); PG8_STAGE(PG8_SA(0, 1), a2 + hstep, voffA);
            PG8_WAIT_L(8); PG8_BAR; PG8_WAIT_L(0); PG8_MMA(0, 0, At, B0); PG8_BAR; PG8_SCHED;
            PG8_LDB(B1, 1, 1); PG8_STAGE(PG8_SB(1, 0), b3, voffB);
            PG8_BAR; PG8_WAIT_L(0); PG8_MMA(0, 1, At, B1); PG8_BAR;
            PG8_LDA(At, 1, 1); PG8_STAGE(PG8_SA(1, 0), a3, voffA);
            PG8_BAR; PG8_WAIT_L(0); PG8_MMA(1, 0, At, B0); PG8_BAR; PG8_SCHED;
            PG8_STAGE(PG8_SB(1, 1), b3 + hstep, voffB);
            PG8_WAIT_V(6); PG8_BAR; PG8_MMA(1, 1, At, B1); PG8_BAR;
            }
        }
        if constexpr (ALIGN_EPI) { if (wr == 0) PG8_BAR; }
        if constexpr (!Epi::AFTER_DRAIN) { E(acc, cur, wr, wc, fr, fq); S.done(cur); }
        if (!has_next) break;
#pragma unroll
        for (int a = 0; a < 2; ++a)
#pragma unroll
            for (int b = 0; b < 2; ++b)
#pragma unroll
                for (int m = 0; m < 4; ++m)
#pragma unroll
                    for (int n = 0; n < 2; ++n) acc[a][b][m][n] = (f32x4){0.f, 0.f, 0.f, 0.f};
        cur = nxt; cA = nA; cB = nB; ++ui;
        if constexpr (ALIGN_EPI) { if (wr == 1) PG8_BAR; }
    }
    PG8_WAIT_V(0);
    if constexpr (!ALIGN_EPI) { if (wr == 0) PG8_BAR; }
    PG8_BAR;
    if constexpr (Epi::AFTER_DRAIN) { E.fused(acc, cur, wr, wc, fr, fq, lds, wid, lane); S.done(cur); }
#undef PG8_SA
#undef PG8_SB
#undef PG8_STAGE
#undef PG8_LDA
#undef PG8_LDB
#undef PG8_MMA
#undef PG8_WAIT_V
#undef PG8_WAIT_L
#undef PG8_BAR
#undef PG8_SCHED
}
}
#define XB_TMO      128
#define XB_XCNT(j)  (256  + 64 * (j))
#define XB_XSUB(j)  (1280 + 64 * (j))
#define XB_XGEN(j)  (2304 + 64 * (j))
#define XB_TOP      3328
#define XB_TOPGEN   3392
#define XCD_BAR_WORDS 3456
#define XB_SPIN_CAP (1u << 18)

__device__ __forceinline__ unsigned xb_ld(unsigned* p)              { return __hip_atomic_load(p, __ATOMIC_RELAXED, __HIP_MEMORY_SCOPE_AGENT); }
__device__ __forceinline__ unsigned xb_add(unsigned* p, unsigned v) { return __hip_atomic_fetch_add(p, v, __ATOMIC_RELAXED, __HIP_MEMORY_SCOPE_AGENT); }
__device__ __forceinline__ unsigned xb_xcc_id() { return (unsigned)__builtin_amdgcn_s_getreg((3 << 11) | 20) & 0xFu; }
#define XB_SPIN(cond, bar) do { unsigned _sp = 0; while (cond) { __builtin_amdgcn_s_sleep(1); \
    if ((++_sp & 255u) == 0u) { if (xb_ld(&(bar)[XB_TMO])) break; if (_sp > XB_SPIN_CAP) { atomicAdd(&(bar)[XB_TMO], 1u); break; } } } } while (0)

struct XcdBarrier {
    unsigned* bar; unsigned x;
    volatile LAS unsigned* st;
};

__device__ __forceinline__ XcdBarrier xcd_barrier_post(unsigned* bar, volatile LAS unsigned* st) {
    XcdBarrier b; b.bar = bar; b.x = xb_xcc_id(); b.st = st;
    if (threadIdx.x == 0) (void)xb_add(&bar[XB_XCNT(b.x)], 1u);
    return b;
}
__device__ __forceinline__ void xcd_barrier_complete(unsigned* bar, unsigned x, unsigned& nloc, unsigned& nx) {
    const unsigned G = gridDim.x * gridDim.y * gridDim.z;
    unsigned sum, cnt, mine, sp = 0u;
    for (;;) {
        sum = 0u; cnt = 0u; mine = 0u;
#pragma unroll
        for (unsigned j = 0; j < 16; ++j) { const unsigned c = xb_ld(&bar[XB_XCNT(j)]); sum += c; cnt += (c > 0u) ? 1u : 0u; mine = (j == x) ? c : mine; }
        if (sum == G) break;
        __builtin_amdgcn_s_sleep(1);
        if ((++sp & 255u) == 0u) { if (xb_ld(&bar[XB_TMO])) break; if (sp > XB_SPIN_CAP) { atomicAdd(&bar[XB_TMO], 1u); break; } }
    }
    nloc = mine > 0u ? mine : 1u; nx = cnt > 0u ? cnt : 1u;
}

__device__ __forceinline__ void xcd_barrier(const XcdBarrier& b) {
    asm volatile("s_waitcnt vmcnt(0)" ::: "memory");
    __syncthreads();
    if (threadIdx.x == 0) {
        unsigned* bar = b.bar;
        __builtin_amdgcn_s_waitcnt(0);
        unsigned nloc = b.st[0], nx = b.st[1];
        if (nloc == 0u) { xcd_barrier_complete(bar, b.x, nloc, nx); b.st[0] = nloc; b.st[1] = nx; }
        const unsigned old = xb_add(&bar[XB_XSUB(b.x)], 1u);
        const unsigned gen = old / nloc;
        if (old + 1u == (gen + 1u) * nloc) {
            __builtin_amdgcn_fence(__ATOMIC_RELEASE, "agent");
            asm volatile("s_waitcnt vmcnt(0)" ::: "memory");
            const unsigned og = xb_add(&bar[XB_TOP], 1u);
            const unsigned tg = og / nx;
            if (og + 1u == (tg + 1u) * nx) xb_add(&bar[XB_TOPGEN], 1u);
            else XB_SPIN(xb_ld(&bar[XB_TOPGEN]) == tg, bar);
            __builtin_amdgcn_fence(__ATOMIC_ACQUIRE, "agent");
            xb_add(&bar[XB_XGEN(b.x)], 1u);
            asm volatile("s_waitcnt vmcnt(0)" ::: "memory");
        } else {
            XB_SPIN(xb_ld(&bar[XB_XGEN(b.x)]) == gen, bar);
            __builtin_amdgcn_fence(__ATOMIC_ACQUIRE, "agent");
            asm volatile("s_waitcnt vmcnt(0)" ::: "memory");
        }
    }
    __syncthreads();
}

__global__ void __launch_bounds__(256) naive_mla_attn(const bf16_t* Q, const bf16_t* KV, const bf16_t* KROPE, bf16_t* O) {
    __shared__ float Ks[32][QKD]; __shared__ float Vs[32][VD];
    const int tid = threadIdx.x, qb = blockIdx.x & 7, h = (blockIdx.x >> 3) & 15, b = blockIdx.x >> 7;
    const size_t m = (size_t)b * SEQ + qb * 256 + tid;
    float q[QKD];
#pragma unroll
    for (int c = 0; c < 12; ++c) { float f[8]; unpack8(*(const u32x4*)(Q + m * 1536 + h * QKD + 8 * c), f);
#pragma unroll
        for (int i = 0; i < 8; ++i) q[8 * c + i] = f[i]; }
    float o[VD];
#pragma unroll
    for (int i = 0; i < VD; ++i) o[i] = 0.f;
    float mx = -INFINITY, l = 0.f;
    for (int t = 0; t < SEQ / 32; ++t) {
        __syncthreads();
        {
            for (int c = tid; c < 640; c += 256) { const int key = c / 20, ch = c % 20; const size_t km = (size_t)b * SEQ + t * 32 + key; float f[8];
                if (ch < 8) { unpack8(*(const u32x4*)(KV + km * 2048 + h * 128 + 8 * ch), f);
#pragma unroll
                    for (int i = 0; i < 8; ++i) Ks[key][8 * ch + i] = f[i]; }
                else if (ch < 12) { unpack8(*(const u32x4*)(KROPE + km * 512 + h * 32 + 8 * (ch - 8)), f);
#pragma unroll
                    for (int i = 0; i < 8; ++i) Ks[key][NOPE + 8 * (ch - 8) + i] = f[i]; }
                else { unpack8(*(const u32x4*)(KV + km * 2048 + h * 128 + 64 + 8 * (ch - 12)), f);
#pragma unroll
                    for (int i = 0; i < 8; ++i) Vs[key][8 * (ch - 12) + i] = f[i]; } }
        }
        __syncthreads();
        for (int key = 0; key < 32; ++key) {
            float s = 0.f;
#pragma unroll
            for (int d = 0; d < QKD; d += 4) { const f32x4 kk = *(const f32x4*)&Ks[key][d]; s += q[d] * kk.x + q[d + 1] * kk.y + q[d + 2] * kk.z + q[d + 3] * kk.w; }
            if (s > mx) { const float al = exp2f(mx - s); l *= al;
#pragma unroll
                for (int i = 0; i < VD; ++i) o[i] *= al;
                mx = s; }
            const float p = exp2f(s - mx); l += p;
#pragma unroll
            for (int d = 0; d < VD; d += 4) { const f32x4 vv = *(const f32x4*)&Vs[key][d]; o[d] += p * vv.x; o[d + 1] += p * vv.y; o[d + 2] += p * vv.z; o[d + 3] += p * vv.w; }
        }
    }
    const float rl = 1.0f / l;
#pragma unroll
    for (int c = 0; c < 8; ++c) { float f[8];
#pragma unroll
        for (int i = 0; i < 8; ++i) f[i] = o[8 * c + i] * rl;
        *(u32x4*)(O + m * DM + h * VD + 8 * c) = pack8(f); }
}

__global__ void __launch_bounds__(256) naive_dil_attn(const bf16_t* QKVG, const int* pos, const float* g_q, const float* g_k, const float* rel_bias, int g, int dil, bf16_t* O2, float* LSE) {
    const int tid = threadIdx.x, sb = blockIdx.x & 7, h = (blockIdx.x >> 3) & 15, b = blockIdx.x >> 7;
    const int s = sb * 256 + tid; const size_t m = (size_t)b * SEQ + s;
    float q[64]; float ss = 0.f;
#pragma unroll
    for (int c = 0; c < 8; ++c) { float f[8]; unpack8(*(const u32x4*)(QKVG + m * GCOLS + h * 64 + 8 * c), f);
#pragma unroll
        for (int i = 0; i < 8; ++i) { q[8 * c + i] = f[i]; ss += f[i] * f[i]; } }
    const float rq = DIL_C2 / sqrtf(ss * (1.0f / 64) + EPS);
#pragma unroll
    for (int i = 0; i < 64; ++i) q[i] *= rq * g_q[g * 64 + i] * g_k[g * 64 + i];
    float o[64];
#pragma unroll
    for (int i = 0; i < 64; ++i) o[i] = 0.f;
    float mx = -INFINITY, l = 0.f; const int pq = pos[m];
    for (int j = -64; j <= 64; ++j) {
        const int sk = s + j * dil; if (sk < 0 || sk >= SEQ) continue;
        const size_t km = (size_t)b * SEQ + sk;
        float dot = 0.f, sk2 = 0.f;
#pragma unroll
        for (int c = 0; c < 8; ++c) { float f[8]; unpack8(*(const u32x4*)(QKVG + km * GCOLS + 1024 + h * 64 + 8 * c), f);
#pragma unroll
            for (int i = 0; i < 8; ++i) { dot += q[8 * c + i] * f[i]; sk2 += f[i] * f[i]; } }
        const float bias = rel_bias[t5_bucket(pos[km] - pq) * 48 + g * 16 + h] * LOG2E;
        const float sc = dot / sqrtf(sk2 * (1.0f / 64) + EPS) + bias;
        if (sc > mx) { const float al = exp2f(mx - sc); l *= al;
#pragma unroll
            for (int i = 0; i < 64; ++i) o[i] *= al;
            mx = sc; }
        const float p = exp2f(sc - mx); l += p;
#pragma unroll
        for (int c = 0; c < 8; ++c) { float f[8]; unpack8(*(const u32x4*)(QKVG + km * GCOLS + 2048 + h * 64 + 8 * c), f);
#pragma unroll
            for (int i = 0; i < 8; ++i) o[8 * c + i] += p * f[i]; }
    }
    float lse = mx + log2f(l); float wn = 1.0f / l, wo = 0.f;
    if (g > 0) { const float lo = LSE[m * 16 + h]; const float mm = fmaxf(lo, lse); const float ea = exp2f(lo - mm), eb = exp2f(lse - mm); const float nl = mm + log2f(ea + eb);
        wo = exp2f(lo - nl); wn = exp2f(lse - nl) / l; lse = nl; }
    LSE[m * 16 + h] = lse;
#pragma unroll
    for (int c = 0; c < 8; ++c) { float f[8], old[8];
        if (g > 0) unpack8(*(const u32x4*)(O2 + m * DM + h * 64 + 8 * c), old);
#pragma unroll
        for (int i = 0; i < 8; ++i) f[i] = o[8 * c + i] * wn + (g > 0 ? old[i] * wo : 0.f);
        *(u32x4*)(O2 + m * DM + h * 64 + 8 * c) = pack8(f); }
}
constexpr int NWAVES = 8;
constexpr int RING_BYTES = 131072;
constexpr int LDSCTL_OFF = RING_BYTES, MISC_OFF = LDSCTL_OFF + 320;
constexpr int LDS_BYTES = 147456;
constexpr int CW_BAR = 4096;
constexpr size_t CTL_ZERO_BYTES = 256 * 1024;
static_assert((CW_BAR + 12 * XCD_BAR_WORDS) * 4 <= (int)CTL_ZERO_BYTES, "barrier words inside the memset region");

template <class E> struct EpiAd {
    static constexpr bool PERM = (E::NV == 8), AFTER_DRAIN = false; E e;
    __device__ __forceinline__ void operator()(const pg8::f32x4 (&acc)[2][2][4][2], const pg8::Unit& u, int wr, int wc, int fr, int fq) const {
#pragma unroll
        for (int ai = 0; ai < 2; ++ai)
#pragma unroll
            for (int m = 0; m < 4; ++m) { const int row = u.pm * 256 + ai * 128 + wr * 64 + m * 16 + fr;
#pragma unroll
                for (int bj = 0; bj < 2; ++bj) {
                    if constexpr (PERM) { const int col = u.pn * 256 + bj * 128 + wc * 32 + 8 * fq;
                        const float v[8] = {acc[ai][bj][m][0][0], acc[ai][bj][m][0][1], acc[ai][bj][m][0][2], acc[ai][bj][m][0][3], acc[ai][bj][m][1][0], acc[ai][bj][m][1][1], acc[ai][bj][m][1][2], acc[ai][bj][m][1][3]};
                        e.store(row, col, v); }
                    else {
#pragma unroll
                        for (int n = 0; n < 2; ++n) { const int col = u.pn * 256 + bj * 128 + wc * 32 + 16 * n + 4 * fq;
                            const float v[4] = {acc[ai][bj][m][n][0], acc[ai][bj][m][n][1], acc[ai][bj][m][n][2], acc[ai][bj][m][n][3]};
                            e.store(row, col, v); } } }
                if (m & 1) asm volatile("" ::: "memory"); }
    }
};
template <class E> __device__ __forceinline__ void run_gemm(LAS unsigned char* lds, const void* A, const void* Bt, int N, int K, const E& e) {
    pg8::Gemm g{(const bf16_t*)A, (const bf16_t*)Bt, MTOK, N, K}; pg8::StaticOrder S; S.init(MTOK, N, (int)gridDim.x, (int)blockIdx.x);
    EpiAd<E> ad{e};
    pg8::gemm_phase<EpiAd<E>, pg8::StaticOrder, true, true>(lds, g, S, ad);
}

struct Args { Ptrs P; int ph_lo, ph_hi, li, pad; };
__device__ __forceinline__ const Ptrs& kargs() { const Ptrs* p = (const Ptrs*)__builtin_amdgcn_kernarg_segment_ptr(); asm volatile("" : "+s"(p)); return *p; }
#define KA kargs()
#define MOD0 ((const float*)(KA.ws + WS_MOD))
#define MOD1 (MOD0 + 8 * MODW)
#define HB ((bf16_t*)(KA.ws + WS_H))
constexpr int NPHASE = 22;
#ifndef HYBRID
#define HYBRID 1
#endif
__global__ void __launch_bounds__(NWAVES * 64, 2) mega_fwd(Args args) {
    extern __shared__ __attribute__((aligned(16))) unsigned char lds_raw[];
    LAS unsigned char* lds = (LAS unsigned char*)lds_raw;
    volatile LAS unsigned* MISC = (volatile LAS unsigned*)(lds + MISC_OFF);
    const int tid = threadIdx.x, lane = tid & 63, wave = __builtin_amdgcn_readfirstlane(tid >> 6);
    const int G = gridDim.x, bx = blockIdx.x, gw = bx * NWAVES + wave, ngw = G * NWAVES;
    const int vcu = (G % 8 == 0) ? (bx % 8) * (G / 8) + bx / 8 : bx;
    for (int u = tid; u < (LDS_BYTES - LDSCTL_OFF) / 4; u += NWAVES * 64) ((LAS unsigned*)(lds + LDSCTL_OFF))[u] = 0u;
    __syncthreads();
    XcdBarrier bar = xcd_barrier_post((unsigned*)(args.P.ws + WS_CTL) + CW_BAR + args.li * XCD_BAR_WORDS, MISC + 8);
    const int lo = args.ph_lo, hi = args.ph_hi;
#define IN(k) (lo <= (k) && (k) < hi)
#define SEAM(k) do { if (IN(k) && IN((k) + 1)) xcd_barrier(bar); } while (0)

    if (IN(0)) {
        p0_weights(KA, (LAS float*)lds + wave * (64 * 33), gw, ngw, lane);
        p0_cs(KA, bx * 512 + tid, G * 512);
        __syncthreads();
        p0_mod(KA, (LAS float*)lds, bx, G, tid, NWAVES);
    }
    SEAM(0);
    if (IN(1)) lnmod_rows(KA.x, KA.norm_mix, MOD0, 0, 1, HB, gw, ngw, lane);
    SEAM(1);
    if (IN(2)) run_gemm(lds, KA.ws + WS_H, KA.ws + WS_WIN0, MLA_INP, DM, EpiF32{(float*)(KA.ws + WS_PROJ), MLA_INP, 0});
    SEAM(2);
    if (IN(3)) mla_prep_rows(KA, gw, ngw, lane);
    SEAM(3);
    if (IN(4)) {
        run_gemm(lds, KA.ws + WS_QA, KA.ws + WS_WQB, 1536, QLORA, EpiBf16{(bf16_t*)(KA.ws + WS_Q), 1536, 0});
        run_gemm(lds, KA.ws + WS_KVA, KA.ws + WS_WKVB, 2048, KVLORA, EpiBf16{(bf16_t*)(KA.ws + WS_KV), 2048, 0});
    }
    SEAM(4);
    if (IN(5)) mla_final_rows(KA, gw, ngw, lane);
    SEAM(5);
    if (IN(6)) {   }
    SEAM(6);
    if (IN(7)) run_gemm(lds, KA.ws + WS_H, KA.ws + WS_WO0, DM, DM, EpiResGate{KA.x, KA.out, MOD0 + 2 * DM});
    SEAM(7);
    if (IN(8)) lnmod_rows(KA.out, KA.norm_mlp, MOD0, 3, 4, HB, gw, ngw, lane);
    SEAM(8);
    if (IN(9)) run_gemm(lds, KA.ws + WS_H, KA.ws + WS_W1_0, DFF, DM, EpiSqRelu{(bf16_t*)(KA.ws + WS_U), DFF, 0});
    SEAM(9);
    if (IN(10)) run_gemm(lds, KA.ws + WS_U, KA.ws + WS_W2_0, DM, DFF, EpiResGate{KA.out, KA.out, MOD0 + 5 * DM});
    SEAM(10);
    if (IN(11)) lnmod_rows(KA.out, KA.norm_mix + DM, MOD1, 0, 1, HB, gw, ngw, lane);
    SEAM(11);
#pragma unroll 1
    for (int g = 0; g < 3; ++g) {
        if (IN(12 + 2 * g)) run_gemm(lds, KA.ws + WS_H, KA.ws + WS_WIN1 + (size_t)g * GCOLS * DM * 2, GCOLS, DM, EpiBf16{(bf16_t*)(KA.ws + WS_QKVG), GCOLS, 0});
        SEAM(12 + 2 * g);
        if (IN(13 + 2 * g)) {   }
        SEAM(13 + 2 * g);
    }
    if (IN(18)) run_gemm(lds, KA.ws + WS_O2, KA.ws + WS_WO1, DM, DM, EpiResGate{KA.out, KA.out, MOD1 + 2 * DM});
    SEAM(18);
    if (IN(19)) lnmod_rows(KA.out, KA.norm_mlp + DM, MOD1, 3, 4, HB, gw, ngw, lane);
    SEAM(19);
    if (IN(20)) run_gemm(lds, KA.ws + WS_H, KA.ws + WS_W1_1, DFF, DM, EpiSqRelu{(bf16_t*)(KA.ws + WS_U), DFF, 0});
    SEAM(20);
    if (IN(21)) run_gemm(lds, KA.ws + WS_U, KA.ws + WS_W2_1, DM, DFF, EpiResGate{KA.out, KA.out, MOD1 + 5 * DM});
#undef IN
#undef SEAM
}

extern "C" void kernel_launch(void* const* d_in, const int* in_sizes, int n_in, void* d_out, int out_size, void* d_ws, size_t ws_size, hipStream_t stream) {
    static int grid = 0;
    if (grid == 0) {
        if (n_in != 22 || ws_size < WS_END || out_size != MTOK * DM) { fprintf(stderr, "kernel_launch: unexpected n_in %d / ws %zu / out %d\n", n_in, ws_size, out_size); grid = -1; return; }
        int dev = 0, cus = 0, per_cu = 0;
        if (hipGetDevice(&dev) != hipSuccess || hipDeviceGetAttribute(&cus, hipDeviceAttributeMultiprocessorCount, dev) != hipSuccess) { grid = -1; return; }
        if (hipFuncSetAttribute((const void*)mega_fwd, hipFuncAttributeMaxDynamicSharedMemorySize, LDS_BYTES) != hipSuccess) { fprintf(stderr, "kernel_launch: hipFuncSetAttribute failed\n"); grid = -1; return; }
        if (hipOccupancyMaxActiveBlocksPerMultiprocessor(&per_cu, (const void*)mega_fwd, NWAVES * 64, LDS_BYTES) != hipSuccess || per_cu < 1) { fprintf(stderr, "kernel_launch: occupancy query says %d blocks per CU\n", per_cu); (void)hipGetLastError(); grid = -1; return; }
        if (per_cu > 1) per_cu = 1;
        grid = cus * per_cu;
    }
    if (grid < 0) return;
    if (hipMemsetAsync((char*)d_ws + WS_CTL, 0, CTL_ZERO_BYTES, stream) != hipSuccess) return;
    Args a{};
    Ptrs& P = a.P;
    P.x = (const float*)d_in[0]; P.c = (const float*)d_in[1]; P.pos = (const int*)d_in[2]; P.ada_w = (const float*)d_in[3]; P.ada_b = (const float*)d_in[4];
    P.norm_mix = (const float*)d_in[5]; P.norm_mlp = (const float*)d_in[6]; P.mlp_w1 = (const float*)d_in[7]; P.mlp_w2 = (const float*)d_in[8];
    P.mla_w_in = (const float*)d_in[9]; P.mla_g_qa = (const float*)d_in[10]; P.mla_w_qb = (const float*)d_in[11]; P.mla_g_kva = (const float*)d_in[12];
    P.mla_w_kvb = (const float*)d_in[13]; P.mla_g_q = (const float*)d_in[14]; P.mla_g_k = (const float*)d_in[15]; P.mla_w_o = (const float*)d_in[16];
    P.dil_w_in = (const float*)d_in[17]; P.dil_g_q = (const float*)d_in[18]; P.dil_g_k = (const float*)d_in[19]; P.dil_w_o = (const float*)d_in[20]; P.rel_bias = (const float*)d_in[21];
    P.out = (float*)d_out; P.ws = (unsigned char*)d_ws;
    unsigned char* ws = P.ws;
    int li = 0;
    auto launch = [&](int lo, int hi) { a.ph_lo = lo; a.ph_hi = hi; a.li = li++; hipLaunchKernelGGL(mega_fwd, dim3(grid), dim3(NWAVES * 64), LDS_BYTES, stream, a); };
#if HYBRID
    launch(0, 6);
    naive_mla_attn<<<NBATCH * NH * 8, 256, 0, stream>>>((const bf16_t*)(ws + WS_Q), (const bf16_t*)(ws + WS_KV), (const bf16_t*)(ws + WS_KROPE), (bf16_t*)(ws + WS_H));
    launch(7, 13);
    naive_dil_attn<<<NBATCH * NH * 8, 256, 0, stream>>>((const bf16_t*)(ws + WS_QKVG), P.pos, P.dil_g_q, P.dil_g_k, P.rel_bias, 0, 1, (bf16_t*)(ws + WS_O2), (float*)(ws + WS_LSE));
    launch(14, 15);
    naive_dil_attn<<<NBATCH * NH * 8, 256, 0, stream>>>((const bf16_t*)(ws + WS_QKVG), P.pos, P.dil_g_q, P.dil_g_k, P.rel_bias, 1, 4, (bf16_t*)(ws + WS_O2), (float*)(ws + WS_LSE));
    launch(16, 17);
    naive_dil_attn<<<NBATCH * NH * 8, 256, 0, stream>>>((const bf16_t*)(ws + WS_QKVG), P.pos, P.dil_g_q, P.dil_g_k, P.rel_bias, 2, 16, (bf16_t*)(ws + WS_O2), (float*)(ws + WS_LSE));
    launch(18, 22);
#else
    launch(0, NPHASE);
#endif
}
```

```cpp
#include <hip/hip_runtime.h>
#include <cstdint>
#include <cstdio>

#define LAS __attribute__((address_space(3)))
typedef unsigned short bf16_t;
typedef float f32x4 __attribute__((ext_vector_type(4)));
typedef float f32x2 __attribute__((ext_vector_type(2)));
typedef unsigned u32x4 __attribute__((ext_vector_type(4)));
typedef unsigned u32x2 __attribute__((ext_vector_type(2)));
typedef __bf16 bf16x2_t __attribute__((ext_vector_type(2)));

constexpr int DM = 1024, NBATCH = 8, SEQ = 2048, MTOK = NBATCH * SEQ;
constexpr int DFF = 4096, MODW = 6 * DM;
constexpr int QLORA = 384, KVLORA = 256, ROPE = 32, MLA_IN = 672, MLA_INP = 768;
constexpr int NH = 16, QKD = 96, NOPE = 64, VD = 64;
constexpr int DIL_IN = 9216, GCOLS = 3072, NBKT = 32;
constexpr float EPS = 1e-6f;
constexpr float LOG2E = 1.4426950408889634f;
constexpr float MLA_C2 = 0.10206207261596575f * LOG2E;
constexpr float DIL_C2 = 0.125f * LOG2E;

constexpr size_t MiB = 1u << 20;
constexpr size_t WS_CTL = 0, WS_MOD = 1 * MiB, WS_CS = 2 * MiB;
constexpr size_t WS_WIN0 = 4 * MiB, WS_WQB = 5 * MiB + 512 * 1024, WS_WKVB = 7 * MiB, WS_WO0 = 8 * MiB, WS_W1_0 = 10 * MiB, WS_W2_0 = 18 * MiB;
constexpr size_t WS_WIN1 = 26 * MiB, WS_WO1 = 44 * MiB, WS_W1_1 = 46 * MiB, WS_W2_1 = 54 * MiB;
constexpr size_t WS_H = 64 * MiB;
constexpr size_t WS_R = 96 * MiB;
constexpr size_t WS_PROJ = WS_R;
constexpr size_t WS_Q = WS_R;
constexpr size_t WS_KV = WS_R + 48 * MiB;
constexpr size_t WS_KROPE = WS_R + 112 * MiB;
constexpr size_t WS_QA = WS_R + 128 * MiB;
constexpr size_t WS_KVA = WS_R + 140 * MiB;
constexpr size_t WS_KR = WS_R + 148 * MiB;
constexpr size_t WS_U = WS_R;
constexpr size_t WS_QKVG = WS_R;
constexpr size_t WS_O2 = WS_R + 96 * MiB;
constexpr size_t WS_LSE = WS_R + 128 * MiB;
constexpr size_t WS_END = 256 * MiB;

__device__ __forceinline__ float bf2f(unsigned h) { return __uint_as_float(h << 16); }
__device__ __forceinline__ unsigned pk2(float lo, float hi) { f32x2 v = {lo, hi}; bf16x2_t b = __builtin_convertvector(v, bf16x2_t); return __builtin_bit_cast(unsigned, b); }
__device__ __forceinline__ float wave_sum(float v) {
#pragma unroll
    for (int o = 1; o < 64; o <<= 1) v += __shfl_xor(v, o);
    return v;
}
__device__ __forceinline__ void unpack8(u32x4 w, float (&f)[8]) {
    f[0] = bf2f(w.x & 0xffffu); f[1] = bf2f(w.x >> 16); f[2] = bf2f(w.y & 0xffffu); f[3] = bf2f(w.y >> 16);
    f[4] = bf2f(w.z & 0xffffu); f[5] = bf2f(w.z >> 16); f[6] = bf2f(w.w & 0xffffu); f[7] = bf2f(w.w >> 16);
}
__device__ __forceinline__ u32x4 pack8(const float (&f)[8]) { u32x4 w; w.x = pk2(f[0], f[1]); w.y = pk2(f[2], f[3]); w.z = pk2(f[4], f[5]); w.w = pk2(f[6], f[7]); return w; }
#define LDS_WAIT() asm volatile("s_waitcnt lgkmcnt(0)" ::: "memory")

__device__ __forceinline__ int t5_bucket(int rel) {
    const int n = rel < 0 ? -rel : rel;
    int b = n;
    if (n >= 8) b = 8 + (n >= 15) + (n >= 27) + (n >= 50) + (n >= 91) + (n >= 166) + (n >= 305) + (n >= 559);
    return b + (rel > 0 ? 16 : 0);
}

__device__ __forceinline__ void transpose_item(const float* W, int K, int ldn, int N, bf16_t* WT, int row_off, LAS float* scr, int item, int lane) {
    const int nblk = N / 32, kb = item / nblk, nb = item % nblk, k0 = 64 * kb, n0 = 32 * nb;
#pragma unroll 8
    for (int i = 0; i < 32; ++i) { const int kk = 2 * i + (lane >> 5); scr[kk * 33 + (lane & 31)] = W[(size_t)(k0 + kk) * ldn + n0 + (lane & 31)]; }
    LDS_WAIT();
    const int c = lane & 7;
#pragma unroll
    for (int j = 0; j < 4; ++j) { const int n = (lane >> 3) + 8 * j; const LAS float* s = scr + (8 * c) * 33 + n;
        u32x4 o; o.x = pk2(s[0 * 33], s[1 * 33]); o.y = pk2(s[2 * 33], s[3 * 33]); o.z = pk2(s[4 * 33], s[5 * 33]); o.w = pk2(s[6 * 33], s[7 * 33]);
        *(u32x4*)(WT + (size_t)(row_off + n0 + n) * K + k0 + 8 * c) = o; }
    LDS_WAIT();
}

struct Ptrs {
    const float *x, *c; const int* pos; const float *ada_w, *ada_b, *norm_mix, *norm_mlp, *mlp_w1, *mlp_w2;
    const float *mla_w_in, *mla_g_qa, *mla_w_qb, *mla_g_kva, *mla_w_kvb, *mla_g_q, *mla_g_k, *mla_w_o;
    const float *dil_w_in, *dil_g_q, *dil_g_k, *dil_w_o, *rel_bias;
    float* out; unsigned char* ws;
};

__device__ __forceinline__ void p0_weights(const Ptrs& P, LAS float* scr, int gw, int ngw, int lane) {
    unsigned char* ws = P.ws;
    constexpr int I_IN0 = (DM / 64) * (MLA_IN / 32), I_QB = (QLORA / 64) * (1536 / 32), I_KVB = (KVLORA / 64) * (2048 / 32), I_O = (DM / 64) * (DM / 32);
    constexpr int I_1 = (DM / 64) * (DFF / 32), I_2 = (DFF / 64) * (DM / 32), I_IN1 = (DM / 64) * (DIL_IN / 32);
    constexpr int NITEMS = I_IN0 + I_QB + I_KVB + I_O + 2 * I_1 + 2 * I_2 + I_IN1 + I_O;
    for (int it = gw; it < NITEMS; it += ngw) {
        int r = it;
        if (r < I_IN0) { transpose_item(P.mla_w_in, DM, MLA_IN, MLA_IN, (bf16_t*)(ws + WS_WIN0), 0, scr, r, lane); continue; } r -= I_IN0;
        if (r < I_QB) { transpose_item(P.mla_w_qb, QLORA, 1536, 1536, (bf16_t*)(ws + WS_WQB), 0, scr, r, lane); continue; } r -= I_QB;
        if (r < I_KVB) { transpose_item(P.mla_w_kvb, KVLORA, 2048, 2048, (bf16_t*)(ws + WS_WKVB), 0, scr, r, lane); continue; } r -= I_KVB;
        if (r < I_O) { transpose_item(P.mla_w_o, DM, DM, DM, (bf16_t*)(ws + WS_WO0), 0, scr, r, lane); continue; } r -= I_O;
        if (r < I_1) { transpose_item(P.mlp_w1, DM, DFF, DFF, (bf16_t*)(ws + WS_W1_0), 0, scr, r, lane); continue; } r -= I_1;
        if (r < I_1) { transpose_item(P.mlp_w1 + (size_t)DM * DFF, DM, DFF, DFF, (bf16_t*)(ws + WS_W1_1), 0, scr, r, lane); continue; } r -= I_1;
        if (r < I_2) { transpose_item(P.mlp_w2, DFF, DM, DM, (bf16_t*)(ws + WS_W2_0), 0, scr, r, lane); continue; } r -= I_2;
        if (r < I_2) { transpose_item(P.mlp_w2 + (size_t)DFF * DM, DFF, DM, DM, (bf16_t*)(ws + WS_W2_1), 0, scr, r, lane); continue; } r -= I_2;
        if (r < I_IN1) { transpose_item(P.dil_w_in, DM, DIL_IN, DIL_IN, (bf16_t*)(ws + WS_WIN1), 0, scr, r, lane); continue; } r -= I_IN1;
        transpose_item(P.dil_w_o, DM, DM, DM, (bf16_t*)(ws + WS_WO1), 0, scr, r, lane);
    }
    u32x4* z = (u32x4*)(ws + WS_WIN0 + (size_t)MLA_IN * DM * 2);
    for (int i = gw * 64 + lane; i < 12288; i += ngw * 64) z[i] = (u32x4){0u, 0u, 0u, 0u};
}
__device__ __forceinline__ void p0_cs(const Ptrs& P, int gtid, int nthr) {
    float* cs = (float*)(P.ws + WS_CS);
    for (int i = gtid; i < MTOK * 16; i += nthr) { const int m = i >> 4, f = i & 15;
        const float inv = 1.0f / powf(10000.0f, (float)f * 0.0625f); const float ang = (float)P.pos[m] * inv;
        cs[m * 32 + f] = cosf(ang); cs[m * 32 + 16 + f] = sinf(ang); }
}
__device__ __forceinline__ void p0_mod(const Ptrs& P, LAS float* lds, int bid, int nblk, int tid, int nwaves) {
    LAS float* cond = lds; LAS float* red = lds + 8 * DM;
    float* mod = (float*)(P.ws + WS_MOD);
    for (int i = tid; i < 8 * DM; i += nwaves * 64) { const float v = P.c[i]; cond[i] = v / (1.0f + expf(-v)); }
    __syncthreads();
    const int w = tid >> 6, lane = tid & 63, col = lane & 31, kp = lane >> 5, kper = DM / nwaves;
    for (int item = bid; item < 2 * (MODW / 32); item += nblk) {
        const int l = item / (MODW / 32), n0 = (item % (MODW / 32)) * 32;
        float acc[8];
#pragma unroll
        for (int b = 0; b < 8; ++b) acc[b] = 0.f;
        const float* wp = P.ada_w + (size_t)l * DM * MODW + n0 + col;
#pragma unroll 8
        for (int kk = 0; kk < kper / 2; ++kk) { const int k = w * kper + 2 * kk + kp; const float wv = wp[(size_t)k * MODW];
#pragma unroll
            for (int b = 0; b < 8; ++b) acc[b] += cond[b * DM + k] * wv; }
#pragma unroll
        for (int b = 0; b < 8; ++b) { acc[b] += __shfl_xor(acc[b], 32); if (lane < 32) red[(w * 8 + b) * 32 + col] = acc[b]; }
        __syncthreads();
        if (tid < 256) { const int b = tid >> 5, cc = tid & 31; float s = P.ada_b[l * MODW + n0 + cc];
            for (int ww = 0; ww < nwaves; ++ww) s += red[(ww * 8 + b) * 32 + cc];
            mod[(size_t)(l * 8 + b) * MODW + n0 + cc] = s; }
        __syncthreads();
    }
}
__device__ __forceinline__ void lnmod_rows(const float* X, const float* g, const float* modl  , int shift_idx, int scale_idx, bf16_t* H, int gw, int ngw, int lane) {
    for (int m = gw; m < MTOK; m += ngw) {
        const f32x4* xr = (const f32x4*)(X + (size_t)m * DM) + lane;
        f32x4 v[4]; float ss = 0.f;
#pragma unroll
        for (int j = 0; j < 4; ++j) { v[j] = xr[64 * j]; ss += (v[j].x * v[j].x + v[j].y * v[j].y) + (v[j].z * v[j].z + v[j].w * v[j].w); }
        const float rstd = 1.0f / sqrtf(wave_sum(ss) * (1.0f / DM) + EPS);
        const float* mb = modl + (size_t)(m / SEQ) * MODW;
        u32x2* o = (u32x2*)(H + (size_t)m * DM) + lane;
#pragma unroll
        for (int j = 0; j < 4; ++j) { const int col = 4 * (lane + 64 * j);
            const f32x4 gg = *(const f32x4*)(g + col), sc = *(const f32x4*)(mb + scale_idx * DM + col), sh = *(const f32x4*)(mb + shift_idx * DM + col);
            const f32x4 y = v[j] * rstd * gg * (sc + 1.0f) + sh;
            u32x2 w; w.x = pk2(y.x, y.y); w.y = pk2(y.z, y.w); o[64 * j] = w; }
    }
}
__device__ __forceinline__ void mla_prep_rows(const Ptrs& P, int gw, int ngw, int lane) {
    const float* PROJ = (const float*)(P.ws + WS_PROJ); const float* cs = (const float*)(P.ws + WS_CS);
    bf16_t* QA = (bf16_t*)(P.ws + WS_QA); bf16_t* KVA = (bf16_t*)(P.ws + WS_KVA); float* KR = (float*)(P.ws + WS_KR);
    for (int m = gw; m < MTOK; m += ngw) {
        const float* p = PROJ + (size_t)m * MLA_INP;
        float q[8]; float ss = 0.f;
        if (lane < 48) { const f32x4 a = *(const f32x4*)(p + 8 * lane), b = *(const f32x4*)(p + 8 * lane + 4);
            q[0] = a.x; q[1] = a.y; q[2] = a.z; q[3] = a.w; q[4] = b.x; q[5] = b.y; q[6] = b.z; q[7] = b.w;
#pragma unroll
            for (int i = 0; i < 8; ++i) ss += q[i] * q[i]; }
        else {
#pragma unroll
            for (int i = 0; i < 8; ++i) q[i] = 0.f; }
        const float rq = 1.0f / sqrtf(wave_sum(ss) * (1.0f / QLORA) + EPS);
        if (lane < 48) { float o[8];
#pragma unroll
            for (int i = 0; i < 8; ++i) o[i] = q[i] * rq * P.mla_g_qa[8 * lane + i];
            *(u32x4*)(QA + (size_t)m * QLORA + 8 * lane) = pack8(o); }
        float kv[8]; float s2 = 0.f;
        if (lane < 32) { const f32x4 a = *(const f32x4*)(p + QLORA + 8 * lane), b = *(const f32x4*)(p + QLORA + 8 * lane + 4);
            kv[0] = a.x; kv[1] = a.y; kv[2] = a.z; kv[3] = a.w; kv[4] = b.x; kv[5] = b.y; kv[6] = b.z; kv[7] = b.w;
#pragma unroll
            for (int i = 0; i < 8; ++i) s2 += kv[i] * kv[i]; }
        else {
#pragma unroll
            for (int i = 0; i < 8; ++i) kv[i] = 0.f; }
        const float rk = 1.0f / sqrtf(wave_sum(s2) * (1.0f / KVLORA) + EPS);
        if (lane < 32) { float o[8];
#pragma unroll
            for (int i = 0; i < 8; ++i) o[i] = kv[i] * rk * P.mla_g_kva[8 * lane + i];
            *(u32x4*)(KVA + (size_t)m * KVLORA + 8 * lane) = pack8(o); }
        if (lane < 16) { const float x1 = p[QLORA + KVLORA + lane], x2 = p[QLORA + KVLORA + 16 + lane]; const float c = cs[m * 32 + lane], s = cs[m * 32 + 16 + lane];
            KR[m * 32 + lane] = x1 * c - x2 * s; KR[m * 32 + 16 + lane] = x2 * c + x1 * s; }
    }
}
__device__ __forceinline__ void mla_final_rows(const Ptrs& P, int gw, int ngw, int lane) {
    const float* cs = (const float*)(P.ws + WS_CS); const float* KR = (const float*)(P.ws + WS_KR);
    bf16_t* Q = (bf16_t*)(P.ws + WS_Q); bf16_t* KV = (bf16_t*)(P.ws + WS_KV); bf16_t* KROPE = (bf16_t*)(P.ws + WS_KROPE);
    const int h = lane >> 2, sub = lane & 3;
    for (int m = gw; m < MTOK; m += ngw) {
        float c4[4], s4[4];
#pragma unroll
        for (int t = 0; t < 4; ++t) { c4[t] = cs[m * 32 + 4 * sub + t]; s4[t] = cs[m * 32 + 16 + 4 * sub + t]; }
        {
            bf16_t* qb = Q + (size_t)m * 1536 + h * QKD;
            float a[8], b[8]; unpack8(*(const u32x4*)(qb + 16 * sub), a); unpack8(*(const u32x4*)(qb + 16 * sub + 8), b);
            const u32x2 w1 = *(const u32x2*)(qb + NOPE + 4 * sub), w2 = *(const u32x2*)(qb + NOPE + 16 + 4 * sub);
            const float r1[4] = {bf2f(w1.x & 0xffffu), bf2f(w1.x >> 16), bf2f(w1.y & 0xffffu), bf2f(w1.y >> 16)};
            const float r2[4] = {bf2f(w2.x & 0xffffu), bf2f(w2.x >> 16), bf2f(w2.y & 0xffffu), bf2f(w2.y >> 16)};
            float y1[4], y2[4]; float ss = 0.f;
#pragma unroll
            for (int t = 0; t < 4; ++t) { y1[t] = r1[t] * c4[t] - r2[t] * s4[t]; y2[t] = r2[t] * c4[t] + r1[t] * s4[t]; ss += y1[t] * y1[t] + y2[t] * y2[t]; }
#pragma unroll
            for (int i = 0; i < 8; ++i) ss += a[i] * a[i] + b[i] * b[i];
            ss += __shfl_xor(ss, 1); ss += __shfl_xor(ss, 2);
            const float rs = MLA_C2 / sqrtf(ss * (1.0f / QKD) + EPS);
#pragma unroll
            for (int i = 0; i < 8; ++i) { a[i] *= rs * P.mla_g_q[16 * sub + i]; b[i] *= rs * P.mla_g_q[16 * sub + 8 + i]; }
#pragma unroll
            for (int t = 0; t < 4; ++t) { y1[t] *= rs * P.mla_g_q[NOPE + 4 * sub + t]; y2[t] *= rs * P.mla_g_q[NOPE + 16 + 4 * sub + t]; }
            *(u32x4*)(qb + 16 * sub) = pack8(a); *(u32x4*)(qb + 16 * sub + 8) = pack8(b);
            u32x2 o1, o2; o1.x = pk2(y1[0], y1[1]); o1.y = pk2(y1[2], y1[3]); o2.x = pk2(y2[0], y2[1]); o2.y = pk2(y2[2], y2[3]);
            *(u32x2*)(qb + NOPE + 4 * sub) = o1; *(u32x2*)(qb + NOPE + 16 + 4 * sub) = o2;
        }
        {
            bf16_t* kb = KV + (size_t)m * 2048 + h * 128;
            float a[8], b[8]; unpack8(*(const u32x4*)(kb + 16 * sub), a); unpack8(*(const u32x4*)(kb + 16 * sub + 8), b);
            const f32x4 k1 = *(const f32x4*)(KR + m * 32 + 4 * sub), k2 = *(const f32x4*)(KR + m * 32 + 16 + 4 * sub);
            float ss = (k1.x * k1.x + k1.y * k1.y) + (k1.z * k1.z + k1.w * k1.w) + (k2.x * k2.x + k2.y * k2.y) + (k2.z * k2.z + k2.w * k2.w);
#pragma unroll
            for (int i = 0; i < 8; ++i) ss += a[i] * a[i] + b[i] * b[i];
            ss += __shfl_xor(ss, 1); ss += __shfl_xor(ss, 2);
            const float rs = 1.0f / sqrtf(ss * (1.0f / QKD) + EPS);
#pragma unroll
            for (int i = 0; i < 8; ++i) { a[i] *= rs * P.mla_g_k[16 * sub + i]; b[i] *= rs * P.mla_g_k[16 * sub + 8 + i]; }
            *(u32x4*)(kb + 16 * sub) = pack8(a); *(u32x4*)(kb + 16 * sub + 8) = pack8(b);
            const f32x4 g1 = *(const f32x4*)(P.mla_g_k + NOPE + 4 * sub), g2 = *(const f32x4*)(P.mla_g_k + NOPE + 16 + 4 * sub);
            u32x2 o1, o2; o1.x = pk2(k1.x * rs * g1.x, k1.y * rs * g1.y); o1.y = pk2(k1.z * rs * g1.z, k1.w * rs * g1.w);
            o2.x = pk2(k2.x * rs * g2.x, k2.y * rs * g2.y); o2.y = pk2(k2.z * rs * g2.z, k2.w * rs * g2.w);
            bf16_t* kr = KROPE + (size_t)m * 512 + h * 32;
            *(u32x2*)(kr + 4 * sub) = o1; *(u32x2*)(kr + 16 + 4 * sub) = o2;
        }
    }
}

struct EpiF32 { static constexpr int NV = 4; float* C; int ldc, pad;
    __device__ __forceinline__ void store(int row, int col, const float* v) const { *(f32x4*)(C + (size_t)row * ldc + col) = (f32x4){v[0], v[1], v[2], v[3]}; } };
struct EpiBf16 { static constexpr int NV = 8; bf16_t* C; int ldc, pad;
    __device__ __forceinline__ void store(int row, int col, const float* v) const { u32x4 w; w.x = pk2(v[0], v[1]); w.y = pk2(v[2], v[3]); w.z = pk2(v[4], v[5]); w.w = pk2(v[6], v[7]);
        *(u32x4*)(C + (size_t)row * ldc + col) = w; } };
struct EpiSqRelu { static constexpr int NV = 8; bf16_t* C; int ldc, pad;
    __device__ __forceinline__ void store(int row, int col, const float* v) const { float r[8];
#pragma unroll
        for (int i = 0; i < 8; ++i) { const float t = fmaxf(v[i], 0.f); r[i] = t * t; }
        u32x4 w; w.x = pk2(r[0], r[1]); w.y = pk2(r[2], r[3]); w.z = pk2(r[4], r[5]); w.w = pk2(r[6], r[7]);
        *(u32x4*)(C + (size_t)row * ldc + col) = w; } };
struct EpiResGate { static constexpr int NV = 4; const float* base; float* out; const float* gate  ;
    __device__ __forceinline__ void store(int row, int col, const float* v) const {
        const f32x4 b = *(const f32x4*)(base + (size_t)row * DM + col), g = *(const f32x4*)(gate + (size_t)(row / SEQ) * MODW + col);
        *(f32x4*)(out + (size_t)row * DM + col) = b + g * (f32x4){v[0], v[1], v[2], v[3]}; } };

namespace pg8 {
#define PG8_LAS __attribute__((address_space(3)))
typedef unsigned short bf16_t;
typedef short bf16x8 __attribute__((ext_vector_type(8)));
typedef float f32x4 __attribute__((ext_vector_type(4)));
typedef unsigned u32x4 __attribute__((ext_vector_type(4)));
constexpr int BM = 256, BK = 64, HALF = 128, HTB = HALF * BK * 2  , STAGE_BYTES = 8 * HTB, NXCD = 8, WGM = 8;

__host__ __device__ __forceinline__ int lds_byte(int r, int c) { const int st = (r >> 4) * 2 + (c >> 5), rr = r & 15, cc = c & 31, ob = rr * 64 + cc * 2; return st * 1024 + (ob ^ (((ob >> 9) & 1) << 5)); }
__host__ __device__ __forceinline__ void stage_rc(int b, int& R, int& C) { const int st = b / 1024, sb = b % 1024, swz = sb ^ (((sb >> 9) & 1) << 5); R = (st >> 1) * 16 + swz / 64; C = (st & 1) * 32 + (swz % 64) / 2; }
__host__ __device__ __forceinline__ int perm32(int rho) { const int n = rho >> 4, i = rho & 15; return 8 * (i >> 2) + 4 * n + (i & 3); }

struct Unit { int pm, pn; };
struct Gemm { const bf16_t* A; const bf16_t* Bt; int M, N, K; };

struct StaticOrder {
    int nM, nN, nwg, G, c;
    __host__ __device__ void init(int M, int N, int G_, int c_) { nM = M / BM; nN = N / BM; nwg = nM * nN; G = G_; c = c_; }
    __host__ __device__ bool next(int i, Unit& u) const {
        const long L = (long)i * G + c; if (L >= nwg) return false;
        int wgid = (int)L; { const int q = nwg / NXCD, r = nwg % NXCD, xcd = wgid % NXCD, off = wgid / NXCD; wgid = (xcd < r ? xcd * (q + 1) : r * (q + 1) + (xcd - r) * q) + off; }
        const int nig = WGM * nN, gid = wgid / nig, fm = gid * WGM, gsz = (nM - fm) < WGM ? (nM - fm) : WGM;
        u.pm = fm + ((wgid % nig) % gsz); u.pn = (wgid % nig) / gsz; return true;
    }
    __device__ __forceinline__ void a_ready(const Unit&) const {}
    __device__ __forceinline__ void done(const Unit&) const {}
};

template <class Epi, class Sched, bool ALIGN_EPI = false, bool SP2 = false>
__device__ __forceinline__ void gemm_phase(PG8_LAS unsigned char* lds, const Gemm g, const Sched& S, const Epi& E) {
    int tid_ = threadIdx.x; asm volatile("" : "+v"(tid_));
    const int tid = tid_, wid = __builtin_amdgcn_readfirstlane(tid >> 6), lane = tid & 63, wr = wid >> 2, wc = wid & 3, fr = lane & 15, fq = lane >> 4;
    const int K = g.K, nt = K / BK;
    unsigned voffA[2], voffB[2];
#pragma unroll
    for (int i = 0; i < 2; ++i) { int R, C; stage_rc(tid * 16 + i * 8192, R, C); const int Rb = Epi::PERM ? ((R & ~31) + perm32(R & 31)) : R;
        voffA[i] = (unsigned)(R * K + C) * 2u; voffB[i] = (unsigned)(Rb * K + C) * 2u; }
    const size_t kstep = (size_t)(BK * 2);
    const size_t hstep = (size_t)HALF * K * 2;
    const size_t tstep = 2 * hstep;
    const unsigned ldsw = (unsigned)wid * 1024u;
    const int aoff = lds_byte(wr * 64 + fr, fq * 8), boff = lds_byte(wc * 32 + fr, fq * 8);
#define PG8_SA(b, h) (((b) * 2 + (h)) * HTB)
#define PG8_SB(b, h) ((4 + (b) * 2 + (h)) * HTB)
#define PG8_STAGE(bufoff, gbase, voff) do { _Pragma("unroll") for (int _i = 0; _i < 2; ++_i) \
        __builtin_amdgcn_global_load_lds((const unsigned*)((const char*)(gbase) + (voff)[_i]), (PG8_LAS unsigned*)(lds + (bufoff) + ldsw + _i * 8192), 16, 0, 0); } while (0)
#define PG8_LDA(dst, b, h) do { _Pragma("unroll") for (int m = 0; m < 4; ++m) _Pragma("unroll") for (int k = 0; k < 2; ++k) dst[m][k] = *(const PG8_LAS bf16x8*)(lds + PG8_SA(b, h) + aoff + m * 2048 + k * 1024); } while (0)
#define PG8_LDB(dst, b, h) do { _Pragma("unroll") for (int n = 0; n < 2; ++n) _Pragma("unroll") for (int k = 0; k < 2; ++k) dst[n][k] = *(const PG8_LAS bf16x8*)(lds + PG8_SB(b, h) + boff + n * 2048 + k * 1024); } while (0)
#define PG8_MMA(ai, bj, At, Bt) do { __builtin_amdgcn_s_setprio(1); _Pragma("unroll") for (int m = 0; m < 4; ++m) _Pragma("unroll") for (int n = 0; n < 2; ++n) _Pragma("unroll") for (int k = 0; k < 2; ++k) \
        acc[ai][bj][m][n] = __builtin_amdgcn_mfma_f32_16x16x32_bf16(Bt[n][k], At[m][k], acc[ai][bj][m][n], 0, 0, 0); __builtin_amdgcn_s_setprio(0); } while (0)
#define PG8_WAIT_V(n) asm volatile("s_waitcnt vmcnt(" #n ")" ::: "memory")
#define PG8_WAIT_L(n) asm volatile("s_waitcnt lgkmcnt(" #n ")" ::: "memory")
#define PG8_BAR __builtin_amdgcn_s_barrier()
#define PG8_SCHED __builtin_amdgcn_sched_barrier(0)
    Unit cur, nxt; int ui = 0;
    if (!S.next(0, cur)) return;
    f32x4 acc[2][2][4][2];
#pragma unroll
    for (int a = 0; a < 2; ++a)
#pragma unroll
        for (int b = 0; b < 2; ++b)
#pragma unroll
            for (int m = 0; m < 4; ++m)
#pragma unroll
                for (int n = 0; n < 2; ++n) acc[a][b][m][n] = (f32x4){0.f, 0.f, 0.f, 0.f};
    bf16x8 At[4][2], B0[2][2], B1[2][2];
    const char* cA = (const char*)g.A + (size_t)cur.pm * tstep; const char* cB = (const char*)g.Bt + (size_t)cur.pn * tstep;
    S.a_ready(cur);
    if constexpr (SP2) {
        PG8_STAGE(PG8_SB(0, 0), cB, voffB); PG8_STAGE(PG8_SB(0, 1), cB + hstep, voffB); PG8_STAGE(PG8_SA(0, 0), cA, voffA); PG8_STAGE(PG8_SA(0, 1), cA + hstep, voffA);
        if (wr == 1) PG8_BAR;
        PG8_WAIT_V(2); PG8_BAR;
        PG8_STAGE(PG8_SB(1, 0), cB + kstep, voffB); PG8_STAGE(PG8_SA(1, 0), cA + kstep, voffA); PG8_STAGE(PG8_SB(1, 1), cB + hstep + kstep, voffB);
        PG8_WAIT_V(6); PG8_BAR;
    } else {
        PG8_STAGE(PG8_SB(0, 0), cB, voffB); PG8_STAGE(PG8_SA(0, 0), cA, voffA); PG8_STAGE(PG8_SB(0, 1), cB + hstep, voffB); PG8_STAGE(PG8_SA(0, 1), cA + hstep, voffA);
        if (wr == 1) PG8_BAR;
        PG8_WAIT_V(4); PG8_BAR;
        PG8_STAGE(PG8_SB(1, 0), cB + kstep, voffB); PG8_STAGE(PG8_SA(1, 0), cA + kstep, voffA); PG8_STAGE(PG8_SB(1, 1), cB + hstep + kstep, voffB);
        PG8_WAIT_V(6); PG8_BAR;
    }
    for (;;) {
        const bool has_next = S.next(ui + 1, nxt);
        const char* nA = has_next ? (const char*)g.A + (size_t)nxt.pm * tstep : cA; const char* nB = has_next ? (const char*)g.Bt + (size_t)nxt.pn * tstep : cB;
        for (int t = 0; t < nt; t += 2) {
            const bool last = (t == nt - 2);
            const char* a1 = cA + (size_t)(t + 1) * kstep;
            const char* a2 = last ? nA : cA + (size_t)(t + 2) * kstep; const char* b2 = last ? nB : cB + (size_t)(t + 2) * kstep;
            const char* a3 = a2 + kstep; const char* b3 = b2 + kstep;
            if (last && has_next) S.a_ready(nxt);
            if constexpr (SP2) {
            PG8_LDB(B0, 0, 0); PG8_LDB(B1, 0, 1); PG8_SCHED; PG8_LDA(At, 0, 0); PG8_STAGE(PG8_SA(1, 1), a1 + hstep, voffA);
            PG8_WAIT_V(8); PG8_WAIT_L(0); PG8_BAR; PG8_MMA(0, 0, At, B0); PG8_MMA(0, 1, At, B1); PG8_BAR; PG8_SCHED;
            PG8_LDA(At, 0, 1); PG8_STAGE(PG8_SB(0, 0), b2, voffB); PG8_STAGE(PG8_SB(0, 1), b2 + hstep, voffB); PG8_STAGE(PG8_SA(0, 0), a2, voffA);
            PG8_WAIT_V(8); PG8_WAIT_L(0); PG8_BAR; PG8_MMA(1, 0, At, B0); PG8_MMA(1, 1, At, B1); PG8_BAR; PG8_SCHED;
            PG8_LDB(B0, 1, 0); PG8_LDB(B1, 1, 1); PG8_SCHED; PG8_LDA(At, 1, 0); PG8_STAGE(PG8_SA(0, 1), a2 + hstep, voffA);
            PG8_WAIT_V(8); PG8_WAIT_L(0); PG8_BAR; PG8_MMA(0, 0, At, B0); PG8_MMA(0, 1, At, B1); PG8_BAR; PG8_SCHED;
            PG8_LDA(At, 1, 1); PG8_STAGE(PG8_SB(1, 0), b3, voffB); PG8_STAGE(PG8_SB(1, 1), b3 + hstep, voffB); PG8_STAGE(PG8_SA(1, 0), a3, voffA);
            PG8_WAIT_V(8); PG8_WAIT_L(0); PG8_BAR; PG8_MMA(1, 0, At, B0); PG8_MMA(1, 1, At, B1); PG8_BAR; PG8_SCHED;
            } else {
            PG8_LDB(B0, 0, 0); PG8_SCHED; PG8_LDA(At, 0, 0); PG8_STAGE(PG8_SA(1, 1), a1 + hstep, voffA);
            PG8_WAIT_L(8); PG8_BAR; PG8_WAIT_L(0); PG8_MMA(0, 0, At, B0); PG8_BAR; PG8_SCHED;
            PG8_LDB(B1, 0, 1); PG8_STAGE(PG8_SB(0, 0), b2, voffB);
            PG8_BAR; PG8_WAIT_L(0); PG8_MMA(0, 1, At, B1); PG8_BAR;
            PG8_LDA(At, 0, 1); PG8_STAGE(PG8_SA(0, 0), a2, voffA);
            PG8_BAR; PG8_WAIT_L(0); PG8_MMA(1, 0, At, B0); PG8_BAR; PG8_SCHED;
            PG8_STAGE(PG8_SB(0, 1), b2 + hstep, voffB);
            PG8_WAIT_V(6); PG8_BAR; PG8_MMA(1, 1, At, B1); PG8_BAR;
            PG8_LDB(B0, 1, 0); PG8_SCHED; PG8_LDA(At, 1, 0); PG8_STAGE(PG8_SA(0, 1), a2 + hstep, voffA);
            PG8_WAIT_L(8); PG8_BAR; PG8_WAIT_L(0); PG8_MMA(0, 0, At, B0); PG8_BAR; PG8_SCHED;
            PG8_LDB(B1, 1, 1); PG8_STAGE(PG8_SB(1, 0), b3, voffB);
            PG8_BAR; PG8_WAIT_L(0); PG8_MMA(0, 1, At, B1); PG8_BAR;
            PG8_LDA(At, 1, 1); PG8_STAGE(PG8_SA(1, 0), a3, voffA);
            PG8_BAR; PG8_WAIT_L(0); PG8_MMA(1, 0, At, B0); PG8_BAR; PG8_SCHED;
            PG8_STAGE(PG8_SB(1, 1), b3 + hstep, voffB);
            PG8_WAIT_V(6); PG8_BAR; PG8_MMA(1, 1, At, B1); PG8_BAR;
            }
        }
        if constexpr (ALIGN_EPI) { if (wr == 0) PG8_BAR; }
        if constexpr (!Epi::AFTER_DRAIN) { E(acc, cur, wr, wc, fr, fq); S.done(cur); }
        if (!has_next) break;
#pragma unroll
        for (int a = 0; a < 2; ++a)
#pragma unroll
            for (int b = 0; b < 2; ++b)
#pragma unroll
                for (int m = 0; m < 4; ++m)
#pragma unroll
                    for (int n = 0; n < 2; ++n) acc[a][b][m][n] = (f32x4){0.f, 0.f, 0.f, 0.f};
        cur = nxt; cA = nA; cB = nB; ++ui;
        if constexpr (ALIGN_EPI) { if (wr == 1) PG8_BAR; }
    }
    PG8_WAIT_V(0);
    if constexpr (!ALIGN_EPI) { if (wr == 0) PG8_BAR; }
    PG8_BAR;
    if constexpr (Epi::AFTER_DRAIN) { E.fused(acc, cur, wr, wc, fr, fq, lds, wid, lane); S.done(cur); }
#undef PG8_SA
#undef PG8_SB
#undef PG8_STAGE
#undef PG8_LDA
#undef PG8_LDB
#undef PG8_MMA
#undef PG8_WAIT_V
#undef PG8_WAIT_L
#undef PG8_BAR
#undef PG8_SCHED
}
}
#define XB_TMO      128
#define XB_XCNT(j)  (256  + 64 * (j))
#define XB_XSUB(j)  (1280 + 64 * (j))
#define XB_XGEN(j)  (2304 + 64 * (j))
#define XB_TOP      3328
#define XB_TOPGEN   3392
#define XCD_BAR_WORDS 3456
#define XB_SPIN_CAP (1u << 18)

__device__ __forceinline__ unsigned xb_ld(unsigned* p)              { return __hip_atomic_load(p, __ATOMIC_RELAXED, __HIP_MEMORY_SCOPE_AGENT); }
__device__ __forceinline__ unsigned xb_add(unsigned* p, unsigned v) { return __hip_atomic_fetch_add(p, v, __ATOMIC_RELAXED, __HIP_MEMORY_SCOPE_AGENT); }
__device__ __forceinline__ unsigned xb_xcc_id() { return (unsigned)__builtin_amdgcn_s_getreg((3 << 11) | 20) & 0xFu; }
#define XB_SPIN(cond, bar) do { unsigned _sp = 0; while (cond) { __builtin_amdgcn_s_sleep(1); \
    if ((++_sp & 255u) == 0u) { if (xb_ld(&(bar)[XB_TMO])) break; if (_sp > XB_SPIN_CAP) { atomicAdd(&(bar)[XB_TMO], 1u); break; } } } } while (0)

struct XcdBarrier {
    unsigned* bar; unsigned x;
    volatile LAS unsigned* st;
};

__device__ __forceinline__ XcdBarrier xcd_barrier_post(unsigned* bar, volatile LAS unsigned* st) {
    XcdBarrier b; b.bar = bar; b.x = xb_xcc_id(); b.st = st;
    if (threadIdx.x == 0) (void)xb_add(&bar[XB_XCNT(b.x)], 1u);
    return b;
}
__device__ __forceinline__ void xcd_barrier_complete(unsigned* bar, unsigned x, unsigned& nloc, unsigned& nx) {
    const unsigned G = gridDim.x * gridDim.y * gridDim.z;
    unsigned sum, cnt, mine, sp = 0u;
    for (;;) {
        sum = 0u; cnt = 0u; mine = 0u;
#pragma unroll
        for (unsigned j = 0; j < 16; ++j) { const unsigned c = xb_ld(&bar[XB_XCNT(j)]); sum += c; cnt += (c > 0u) ? 1u : 0u; mine = (j == x) ? c : mine; }
        if (sum == G) break;
        __builtin_amdgcn_s_sleep(1);
        if ((++sp & 255u) == 0u) { if (xb_ld(&bar[XB_TMO])) break; if (sp > XB_SPIN_CAP) { atomicAdd(&bar[XB_TMO], 1u); break; } }
    }
    nloc = mine > 0u ? mine : 1u; nx = cnt > 0u ? cnt : 1u;
}

__device__ __forceinline__ void xcd_barrier(const XcdBarrier& b) {
    asm volatile("s_waitcnt vmcnt(0)" ::: "memory");
    __syncthreads();
    if (threadIdx.x == 0) {
        unsigned* bar = b.bar;
        __builtin_amdgcn_s_waitcnt(0);
        unsigned nloc = b.st[0], nx = b.st[1];
        if (nloc == 0u) { xcd_barrier_complete(bar, b.x, nloc, nx); b.st[0] = nloc; b.st[1] = nx; }
        const unsigned old = xb_add(&bar[XB_XSUB(b.x)], 1u);
        const unsigned gen = old / nloc;
        if (old + 1u == (gen + 1u) * nloc) {
            __builtin_amdgcn_fence(__ATOMIC_RELEASE, "agent");
            asm volatile("s_waitcnt vmcnt(0)" ::: "memory");
            const unsigned og = xb_add(&bar[XB_TOP], 1u);
            const unsigned tg = og / nx;
            if (og + 1u == (tg + 1u) * nx) xb_add(&bar[XB_TOPGEN], 1u);
            else XB_SPIN(xb_ld(&bar[XB_TOPGEN]) == tg, bar);
            __builtin_amdgcn_fence(__ATOMIC_ACQUIRE, "agent");
            xb_add(&bar[XB_XGEN(b.x)], 1u);
            asm volatile("s_waitcnt vmcnt(0)" ::: "memory");
        } else {
            XB_SPIN(xb_ld(&bar[XB_XGEN(b.x)]) == gen, bar);
            __builtin_amdgcn_fence(__ATOMIC_ACQUIRE, "agent");
            asm volatile("s_waitcnt vmcnt(0)" ::: "memory");
        }
    }
    __syncthreads();
}
namespace att {
typedef short bf16x8 __attribute__((ext_vector_type(8)));
typedef short s16x4 __attribute__((ext_vector_type(4)));
typedef float f32x16 __attribute__((ext_vector_type(16)));
__device__ __forceinline__ int crow(int r, int hi) { return (r & 3) + 8 * (r >> 2) + 4 * hi; }
template <int NCB> __device__ __forceinline__ int v_st(int k, int c) { const int kk = (k & ~0xC) | ((k & 4) << 1) | ((k & 8) >> 1); return ((kk >> 3) * NCB + (c >> 5)) * 512 + ((kk & 7) * 32 + (c & 31)) * 2; }
__device__ __forceinline__ int v_rd_base(int lane) { return ((lane & 3) << 3) | (((lane >> 2) & 3) << 6) | (((lane >> 4) & 1) << 5) | (((lane >> 5) & 1) << 8); }
__device__ __forceinline__ s16x4 vtr(const LAS unsigned char* p) { typedef short v4i16_t __attribute__((ext_vector_type(4)));
    return __builtin_bit_cast(s16x4, __builtin_amdgcn_ds_read_tr16_b64_v4i16((LAS v4i16_t*)p)); }
__device__ __forceinline__ float swap_max(float v) { auto rr = __builtin_amdgcn_permlane32_swap(__float_as_uint(v), __float_as_uint(v), false, false); return fmaxf(__uint_as_float(rr[0]), __uint_as_float(rr[1])); }
__device__ __forceinline__ float swap_add(float v) { auto rr = __builtin_amdgcn_permlane32_swap(__float_as_uint(v), __float_as_uint(v), false, false); return __uint_as_float(rr[0]) + __uint_as_float(rr[1]); }
#define ATT_PK4(P, BASE, OUT) do { const unsigned a0_ = pk2(P[BASE + 0], P[BASE + 1]), a1_ = pk2(P[BASE + 2], P[BASE + 3]); \
    const unsigned b0_ = pk2(P[BASE + 4], P[BASE + 5]), b1_ = pk2(P[BASE + 6], P[BASE + 7]); \
    auto r0_ = __builtin_amdgcn_permlane32_swap(a0_, b0_, false, false); auto r1_ = __builtin_amdgcn_permlane32_swap(a1_, b1_, false, false); \
    u32x4 w_ = {r0_[0], r1_[0], r0_[1], r1_[1]}; OUT = __builtin_bit_cast(bf16x8, w_); } while (0)

constexpr int KPITCH = 208, KTILE = 64 * KPITCH, VTILE = 64 * 64 * 2;
constexpr int OFF_K = 0, OFF_V = 2 * KTILE, OFF_WS = OFF_V + 2 * VTILE, MLA_LDS = OFF_WS + 8 * 64 * 4;
static_assert(MLA_LDS <= 131072 && (OFF_V % 16) == 0 && (KTILE % 16) == 0, "MLA attention LDS map");

__device__ __forceinline__ void mla_unit(const bf16_t* Q, const bf16_t* KV, const bf16_t* KROPE, bf16_t* O, LAS unsigned char* lds, int b, int h, int qb) {
    int tid_ = threadIdx.x; asm volatile("" : "+v"(tid_));
    const int tid = tid_, lane = tid & 63, r32 = lane & 31, hi = lane >> 5, wid = __builtin_amdgcn_readfirstlane(tid >> 6);
    const size_t row0 = (size_t)b * SEQ;
    const bf16_t* ksrc = KV + (row0 + (tid >> 3)) * 2048 + h * 128 + (tid & 7) * 8;
    const bf16_t* rsrc = KROPE + (row0 + (tid >> 2)) * 512 + h * 32 + (tid & 3) * 8;
    const int kdst = OFF_K + (tid >> 3) * KPITCH + (tid & 7) * 16;
    const int rdst = OFF_K + (tid >> 2) * KPITCH + 128 + (tid & 3) * 16;
    const int vdst = OFF_V + v_st<2>(tid >> 3, (tid & 7) * 8);
    const bool has_r = wid < 4;
    const bf16_t* qp = Q + (row0 + qb * 256 + wid * 32 + r32) * 1536 + h * QKD + hi * 8;
    bf16x8 qr[6];
#pragma unroll
    for (int d0 = 0; d0 < 6; ++d0) qr[d0] = *(const bf16x8*)(qp + 16 * d0);
    f32x16 o0, o1;
#pragma unroll
    for (int r = 0; r < 16; ++r) { o0[r] = 0.f; o1[r] = 0.f; }
    float m = -1e30f, l = 0.f;
    LAS float* wsf = (LAS float*)(lds + OFF_WS) + wid * 64;
    u32x4 kreg, rreg = {0u, 0u, 0u, 0u}, vreg;
#define ATT_LOAD(t) do { kreg = *(const u32x4*)(ksrc + (size_t)(t) * 64 * 2048); vreg = *(const u32x4*)(ksrc + (size_t)(t) * 64 * 2048 + 64); if (has_r) rreg = *(const u32x4*)(rsrc + (size_t)(t) * 64 * 512); } while (0)
#define ATT_WRITE(buf) do { *(LAS u32x4*)(lds + kdst + (buf) * KTILE) = kreg; *(LAS u32x4*)(lds + vdst + (buf) * VTILE) = vreg; if (has_r) *(LAS u32x4*)(lds + rdst + (buf) * KTILE) = rreg; } while (0)
    ATT_LOAD(0); ATT_WRITE(0); ATT_LOAD(1);
    const int NT = SEQ / 64;
#pragma unroll 1
    for (int t = 0; t < NT; ++t) {
        __syncthreads();
        const int cur = t & 1;
        if (t + 1 < NT) { ATT_WRITE(cur ^ 1); if (t + 2 < NT) ATT_LOAD(t + 2); }
        f32x16 p0, p1;
#pragma unroll
        for (int r = 0; r < 16; ++r) { p0[r] = 0.f; p1[r] = 0.f; }
        const LAS unsigned char* kb = lds + OFF_K + cur * KTILE + r32 * KPITCH + hi * 16;
#pragma unroll
        for (int d0 = 0; d0 < 6; ++d0) {
            const bf16x8 a0 = *(const LAS bf16x8*)(kb + d0 * 32), a1 = *(const LAS bf16x8*)(kb + 32 * KPITCH + d0 * 32);
            p0 = __builtin_amdgcn_mfma_f32_32x32x16_bf16(a0, qr[d0], p0, 0, 0, 0);
            p1 = __builtin_amdgcn_mfma_f32_32x32x16_bf16(a1, qr[d0], p1, 0, 0, 0); }
        float pmax = fmaxf(p0[0], p1[0]);
#pragma unroll
        for (int r = 1; r < 16; ++r) pmax = fmaxf(pmax, fmaxf(p0[r], p1[r]));
        pmax = swap_max(pmax);
        const float mn = fmaxf(m, pmax), alpha = __builtin_amdgcn_exp2f(m - mn); m = mn;
        float ps = 0.f;
#pragma unroll
        for (int r = 0; r < 16; ++r) { p0[r] = __builtin_amdgcn_exp2f(p0[r] - mn); p1[r] = __builtin_amdgcn_exp2f(p1[r] - mn); ps += p0[r] + p1[r]; }
        ps = swap_add(ps);
        l = l * alpha + ps;
        if (hi == 0) wsf[r32] = alpha;
#pragma unroll
        for (int r = 0; r < 16; ++r) { const float a = wsf[crow(r, hi)]; o0[r] *= a; o1[r] *= a; }
        bf16x8 pa0, pa1, pa2, pa3;
        ATT_PK4(p0, 0, pa0); ATT_PK4(p0, 8, pa1); ATT_PK4(p1, 0, pa2); ATT_PK4(p1, 8, pa3);
        const LAS unsigned char* vb = lds + OFF_V + cur * VTILE + v_rd_base(lane);
#define ATT_VF(d0, ks) ({ const s16x4 lo_ = vtr(vb + (d0) * 512 + (ks) * 2048), hi_ = vtr(vb + (d0) * 512 + (ks) * 2048 + 1024); (bf16x8){lo_[0], lo_[1], lo_[2], lo_[3], hi_[0], hi_[1], hi_[2], hi_[3]}; })
        o0 = __builtin_amdgcn_mfma_f32_32x32x16_bf16(pa0, ATT_VF(0, 0), o0, 0, 0, 0); o1 = __builtin_amdgcn_mfma_f32_32x32x16_bf16(pa0, ATT_VF(1, 0), o1, 0, 0, 0);
        o0 = __builtin_amdgcn_mfma_f32_32x32x16_bf16(pa1, ATT_VF(0, 1), o0, 0, 0, 0); o1 = __builtin_amdgcn_mfma_f32_32x32x16_bf16(pa1, ATT_VF(1, 1), o1, 0, 0, 0);
        o0 = __builtin_amdgcn_mfma_f32_32x32x16_bf16(pa2, ATT_VF(0, 2), o0, 0, 0, 0); o1 = __builtin_amdgcn_mfma_f32_32x32x16_bf16(pa2, ATT_VF(1, 2), o1, 0, 0, 0);
        o0 = __builtin_amdgcn_mfma_f32_32x32x16_bf16(pa3, ATT_VF(0, 3), o0, 0, 0, 0); o1 = __builtin_amdgcn_mfma_f32_32x32x16_bf16(pa3, ATT_VF(1, 3), o1, 0, 0, 0);
    }
    if (hi == 0) wsf[32 + r32] = l;
    bf16_t* op = O + (row0 + qb * 256 + wid * 32) * DM + h * VD + r32;
#pragma unroll
    for (int r = 0; r < 16; ++r) { const float rl = 1.0f / wsf[32 + crow(r, hi)]; const unsigned w = pk2(o0[r] * rl, o1[r] * rl);
        op[(size_t)crow(r, hi) * DM] = (bf16_t)(w & 0xffffu); op[(size_t)crow(r, hi) * DM + 32] = (bf16_t)(w >> 16); }
#undef ATT_LOAD
#undef ATT_WRITE
#undef ATT_VF
}
template <class F> __device__ __forceinline__ void for_units(int nunits, int vcu, int G, F f) {
    if (nunits % G == 0) { const int per = nunits / G; for (int i = 0; i < per; ++i) f(vcu * per + i); }
    else for (int u = vcu; u < nunits; u += G) f(u);
}
}

__global__ void __launch_bounds__(256) naive_mla_attn(const bf16_t* Q, const bf16_t* KV, const bf16_t* KROPE, bf16_t* O) {
    __shared__ float Ks[32][QKD]; __shared__ float Vs[32][VD];
    const int tid = threadIdx.x, qb = blockIdx.x & 7, h = (blockIdx.x >> 3) & 15, b = blockIdx.x >> 7;
    const size_t m = (size_t)b * SEQ + qb * 256 + tid;
    float q[QKD];
#pragma unroll
    for (int c = 0; c < 12; ++c) { float f[8]; unpack8(*(const u32x4*)(Q + m * 1536 + h * QKD + 8 * c), f);
#pragma unroll
        for (int i = 0; i < 8; ++i) q[8 * c + i] = f[i]; }
    float o[VD];
#pragma unroll
    for (int i = 0; i < VD; ++i) o[i] = 0.f;
    float mx = -INFINITY, l = 0.f;
    for (int t = 0; t < SEQ / 32; ++t) {
        __syncthreads();
        {
            for (int c = tid; c < 640; c += 256) { const int key = c / 20, ch = c % 20; const size_t km = (size_t)b * SEQ + t * 32 + key; float f[8];
                if (ch < 8) { unpack8(*(const u32x4*)(KV + km * 2048 + h * 128 + 8 * ch), f);
#pragma unroll
                    for (int i = 0; i < 8; ++i) Ks[key][8 * ch + i] = f[i]; }
                else if (ch < 12) { unpack8(*(const u32x4*)(KROPE + km * 512 + h * 32 + 8 * (ch - 8)), f);
#pragma unroll
                    for (int i = 0; i < 8; ++i) Ks[key][NOPE + 8 * (ch - 8) + i] = f[i]; }
                else { unpack8(*(const u32x4*)(KV + km * 2048 + h * 128 + 64 + 8 * (ch - 12)), f);
#pragma unroll
                    for (int i = 0; i < 8; ++i) Vs[key][8 * (ch - 12) + i] = f[i]; } }
        }
        __syncthreads();
        for (int key = 0; key < 32; ++key) {
            float s = 0.f;
#pragma unroll
            for (int d = 0; d < QKD; d += 4) { const f32x4 kk = *(const f32x4*)&Ks[key][d]; s += q[d] * kk.x + q[d + 1] * kk.y + q[d + 2] * kk.z + q[d + 3] * kk.w; }
            if (s > mx) { const float al = exp2f(mx - s); l *= al;
#pragma unroll
                for (int i = 0; i < VD; ++i) o[i] *= al;
                mx = s; }
            const float p = exp2f(s - mx); l += p;
#pragma unroll
            for (int d = 0; d < VD; d += 4) { const f32x4 vv = *(const f32x4*)&Vs[key][d]; o[d] += p * vv.x; o[d + 1] += p * vv.y; o[d + 2] += p * vv.z; o[d + 3] += p * vv.w; }
        }
    }
    const float rl = 1.0f / l;
#pragma unroll
    for (int c = 0; c < 8; ++c) { float f[8];
#pragma unroll
        for (int i = 0; i < 8; ++i) f[i] = o[8 * c + i] * rl;
        *(u32x4*)(O + m * DM + h * VD + 8 * c) = pack8(f); }
}

__global__ void __launch_bounds__(256) naive_dil_attn(const bf16_t* QKVG, const int* pos, const float* g_q, const float* g_k, const float* rel_bias, int g, int dil, bf16_t* O2, float* LSE) {
    const int tid = threadIdx.x, sb = blockIdx.x & 7, h = (blockIdx.x >> 3) & 15, b = blockIdx.x >> 7;
    const int s = sb * 256 + tid; const size_t m = (size_t)b * SEQ + s;
    float q[64]; float ss = 0.f;
#pragma unroll
    for (int c = 0; c < 8; ++c) { float f[8]; unpack8(*(const u32x4*)(QKVG + m * GCOLS + h * 64 + 8 * c), f);
#pragma unroll
        for (int i = 0; i < 8; ++i) { q[8 * c + i] = f[i]; ss += f[i] * f[i]; } }
    const float rq = DIL_C2 / sqrtf(ss * (1.0f / 64) + EPS);
#pragma unroll
    for (int i = 0; i < 64; ++i) q[i] *= rq * g_q[g * 64 + i] * g_k[g * 64 + i];
    float o[64];
#pragma unroll
    for (int i = 0; i < 64; ++i) o[i] = 0.f;
    float mx = -INFINITY, l = 0.f; const int pq = pos[m];
    for (int j = -64; j <= 64; ++j) {
        const int sk = s + j * dil; if (sk < 0 || sk >= SEQ) continue;
        const size_t km = (size_t)b * SEQ + sk;
        float dot = 0.f, sk2 = 0.f;
#pragma unroll
        for (int c = 0; c < 8; ++c) { float f[8]; unpack8(*(const u32x4*)(QKVG + km * GCOLS + 1024 + h * 64 + 8 * c), f);
#pragma unroll
            for (int i = 0; i < 8; ++i) { dot += q[8 * c + i] * f[i]; sk2 += f[i] * f[i]; } }
        const float bias = rel_bias[t5_bucket(pos[km] - pq) * 48 + g * 16 + h] * LOG2E;
        const float sc = dot / sqrtf(sk2 * (1.0f / 64) + EPS) + bias;
        if (sc > mx) { const float al = exp2f(mx - sc); l *= al;
#pragma unroll
            for (int i = 0; i < 64; ++i) o[i] *= al;
            mx = sc; }
        const float p = exp2f(sc - mx); l += p;
#pragma unroll
        for (int c = 0; c < 8; ++c) { float f[8]; unpack8(*(const u32x4*)(QKVG + km * GCOLS + 2048 + h * 64 + 8 * c), f);
#pragma unroll
            for (int i = 0; i < 8; ++i) o[8 * c + i] += p * f[i]; }
    }
    float lse = mx + log2f(l); float wn = 1.0f / l, wo = 0.f;
    if (g > 0) { const float lo = LSE[m * 16 + h]; const float mm = fmaxf(lo, lse); const float ea = exp2f(lo - mm), eb = exp2f(lse - mm); const float nl = mm + log2f(ea + eb);
        wo = exp2f(lo - nl); wn = exp2f(lse - nl) / l; lse = nl; }
    LSE[m * 16 + h] = lse;
#pragma unroll
    for (int c = 0; c < 8; ++c) { float f[8], old[8];
        if (g > 0) unpack8(*(const u32x4*)(O2 + m * DM + h * 64 + 8 * c), old);
#pragma unroll
        for (int i = 0; i < 8; ++i) f[i] = o[8 * c + i] * wn + (g > 0 ? old[i] * wo : 0.f);
        *(u32x4*)(O2 + m * DM + h * 64 + 8 * c) = pack8(f); }
}
constexpr int NWAVES = 8;
constexpr int RING_BYTES = 131072;
constexpr int LDSCTL_OFF = RING_BYTES, MISC_OFF = LDSCTL_OFF + 320;
constexpr int LDS_BYTES = 147456;
constexpr int CW_BAR = 4096;
constexpr size_t CTL_ZERO_BYTES = 256 * 1024;
static_assert((CW_BAR + 12 * XCD_BAR_WORDS) * 4 <= (int)CTL_ZERO_BYTES, "barrier words inside the memset region");

template <class E> struct EpiAd {
    static constexpr bool PERM = (E::NV == 8), AFTER_DRAIN = false; E e;
    __device__ __forceinline__ void operator()(const pg8::f32x4 (&acc)[2][2][4][2], const pg8::Unit& u, int wr, int wc, int fr, int fq) const {
#pragma unroll
        for (int ai = 0; ai < 2; ++ai)
#pragma unroll
            for (int m = 0; m < 4; ++m) { const int row = u.pm * 256 + ai * 128 + wr * 64 + m * 16 + fr;
#pragma unroll
                for (int bj = 0; bj < 2; ++bj) {
                    if constexpr (PERM) { const int col = u.pn * 256 + bj * 128 + wc * 32 + 8 * fq;
                        const float v[8] = {acc[ai][bj][m][0][0], acc[ai][bj][m][0][1], acc[ai][bj][m][0][2], acc[ai][bj][m][0][3], acc[ai][bj][m][1][0], acc[ai][bj][m][1][1], acc[ai][bj][m][1][2], acc[ai][bj][m][1][3]};
                        e.store(row, col, v); }
                    else {
#pragma unroll
                        for (int n = 0; n < 2; ++n) { const int col = u.pn * 256 + bj * 128 + wc * 32 + 16 * n + 4 * fq;
                            const float v[4] = {acc[ai][bj][m][n][0], acc[ai][bj][m][n][1], acc[ai][bj][m][n][2], acc[ai][bj][m][n][3]};
                            e.store(row, col, v); } } }
                if (m & 1) asm volatile("" ::: "memory"); }
    }
};
template <class E> __device__ __forceinline__ void run_gemm(LAS unsigned char* lds, const void* A, const void* Bt, int N, int K, const E& e) {
    pg8::Gemm g{(const bf16_t*)A, (const bf16_t*)Bt, MTOK, N, K}; pg8::StaticOrder S; S.init(MTOK, N, (int)gridDim.x, (int)blockIdx.x);
    EpiAd<E> ad{e};
    pg8::gemm_phase<EpiAd<E>, pg8::StaticOrder, true, true>(lds, g, S, ad);
}

struct Args { Ptrs P; int ph_lo, ph_hi, li, pad; };
__device__ __forceinline__ const Ptrs& kargs() { const Ptrs* p = (const Ptrs*)__builtin_amdgcn_kernarg_segment_ptr(); asm volatile("" : "+s"(p)); return *p; }
#define KA kargs()
#define MOD0 ((const float*)(KA.ws + WS_MOD))
#define MOD1 (MOD0 + 8 * MODW)
#define HB ((bf16_t*)(KA.ws + WS_H))
constexpr int NPHASE = 22;
#ifndef HYBRID
#define HYBRID 2
#endif
__global__ void __launch_bounds__(NWAVES * 64, 2) mega_fwd(Args args) {
    extern __shared__ __attribute__((aligned(16))) unsigned char lds_raw[];
    LAS unsigned char* lds = (LAS unsigned char*)lds_raw;
    volatile LAS unsigned* MISC = (volatile LAS unsigned*)(lds + MISC_OFF);
    const int tid = threadIdx.x, lane = tid & 63, wave = __builtin_amdgcn_readfirstlane(tid >> 6);
    const int G = gridDim.x, bx = blockIdx.x, gw = bx * NWAVES + wave, ngw = G * NWAVES;
    const int vcu = (G % 8 == 0) ? (bx % 8) * (G / 8) + bx / 8 : bx;
    for (int u = tid; u < (LDS_BYTES - LDSCTL_OFF) / 4; u += NWAVES * 64) ((LAS unsigned*)(lds + LDSCTL_OFF))[u] = 0u;
    __syncthreads();
    XcdBarrier bar = xcd_barrier_post((unsigned*)(args.P.ws + WS_CTL) + CW_BAR + args.li * XCD_BAR_WORDS, MISC + 8);
    const int lo = args.ph_lo, hi = args.ph_hi;
#define IN(k) (lo <= (k) && (k) < hi)
#define SEAM(k) do { if (IN(k) && IN((k) + 1)) xcd_barrier(bar); } while (0)

    if (IN(0)) {
        p0_weights(KA, (LAS float*)lds + wave * (64 * 33), gw, ngw, lane);
        p0_cs(KA, bx * 512 + tid, G * 512);
        __syncthreads();
        p0_mod(KA, (LAS float*)lds, bx, G, tid, NWAVES);
    }
    SEAM(0);
    if (IN(1)) lnmod_rows(KA.x, KA.norm_mix, MOD0, 0, 1, HB, gw, ngw, lane);
    SEAM(1);
    if (IN(2)) run_gemm(lds, KA.ws + WS_H, KA.ws + WS_WIN0, MLA_INP, DM, EpiF32{(float*)(KA.ws + WS_PROJ), MLA_INP, 0});
    SEAM(2);
    if (IN(3)) mla_prep_rows(KA, gw, ngw, lane);
    SEAM(3);
    if (IN(4)) {
        run_gemm(lds, KA.ws + WS_QA, KA.ws + WS_WQB, 1536, QLORA, EpiBf16{(bf16_t*)(KA.ws + WS_Q), 1536, 0});
        run_gemm(lds, KA.ws + WS_KVA, KA.ws + WS_WKVB, 2048, KVLORA, EpiBf16{(bf16_t*)(KA.ws + WS_KV), 2048, 0});
    }
    SEAM(4);
    if (IN(5)) mla_final_rows(KA, gw, ngw, lane);
    SEAM(5);
    if (IN(6)) att::for_units(NBATCH * NH * 8, vcu, G, [&](int u) { att::mla_unit((const bf16_t*)(KA.ws + WS_Q), (const bf16_t*)(KA.ws + WS_KV), (const bf16_t*)(KA.ws + WS_KROPE), HB, lds, u >> 7, (u >> 3) & 15, u & 7); });
    SEAM(6);
    if (IN(7)) run_gemm(lds, KA.ws + WS_H, KA.ws + WS_WO0, DM, DM, EpiResGate{KA.x, KA.out, MOD0 + 2 * DM});
    SEAM(7);
    if (IN(8)) lnmod_rows(KA.out, KA.norm_mlp, MOD0, 3, 4, HB, gw, ngw, lane);
    SEAM(8);
    if (IN(9)) run_gemm(lds, KA.ws + WS_H, KA.ws + WS_W1_0, DFF, DM, EpiSqRelu{(bf16_t*)(KA.ws + WS_U), DFF, 0});
    SEAM(9);
    if (IN(10)) run_gemm(lds, KA.ws + WS_U, KA.ws + WS_W2_0, DM, DFF, EpiResGate{KA.out, KA.out, MOD0 + 5 * DM});
    SEAM(10);
    if (IN(11)) lnmod_rows(KA.out, KA.norm_mix + DM, MOD1, 0, 1, HB, gw, ngw, lane);
    SEAM(11);
#pragma unroll 1
    for (int g = 0; g < 3; ++g) {
        if (IN(12 + 2 * g)) run_gemm(lds, KA.ws + WS_H, KA.ws + WS_WIN1 + (size_t)g * GCOLS * DM * 2, GCOLS, DM, EpiBf16{(bf16_t*)(KA.ws + WS_QKVG), GCOLS, 0});
        SEAM(12 + 2 * g);
        if (IN(13 + 2 * g)) {   }
        SEAM(13 + 2 * g);
    }
    if (IN(18)) run_gemm(lds, KA.ws + WS_O2, KA.ws + WS_WO1, DM, DM, EpiResGate{KA.out, KA.out, MOD1 + 2 * DM});
    SEAM(18);
    if (IN(19)) lnmod_rows(KA.out, KA.norm_mlp + DM, MOD1, 3, 4, HB, gw, ngw, lane);
    SEAM(19);
    if (IN(20)) run_gemm(lds, KA.ws + WS_H, KA.ws + WS_W1_1, DFF, DM, EpiSqRelu{(bf16_t*)(KA.ws + WS_U), DFF, 0});
    SEAM(20);
    if (IN(21)) run_gemm(lds, KA.ws + WS_U, KA.ws + WS_W2_1, DM, DFF, EpiResGate{KA.out, KA.out, MOD1 + 5 * DM});
#undef IN
#undef SEAM
}

extern "C" void kernel_launch(void* const* d_in, const int* in_sizes, int n_in, void* d_out, int out_size, void* d_ws, size_t ws_size, hipStream_t stream) {
    static int grid = 0;
    if (grid == 0) {
        if (n_in != 22 || ws_size < WS_END || out_size != MTOK * DM) { fprintf(stderr, "kernel_launch: unexpected n_in %d / ws %zu / out %d\n", n_in, ws_size, out_size); grid = -1; return; }
        int dev = 0, cus = 0, per_cu = 0;
        if (hipGetDevice(&dev) != hipSuccess || hipDeviceGetAttribute(&cus, hipDeviceAttributeMultiprocessorCount, dev) != hipSuccess) { grid = -1; return; }
        if (hipFuncSetAttribute((const void*)mega_fwd, hipFuncAttributeMaxDynamicSharedMemorySize, LDS_BYTES) != hipSuccess) { fprintf(stderr, "kernel_launch: hipFuncSetAttribute failed\n"); grid = -1; return; }
        if (hipOccupancyMaxActiveBlocksPerMultiprocessor(&per_cu, (const void*)mega_fwd, NWAVES * 64, LDS_BYTES) != hipSuccess || per_cu < 1) { fprintf(stderr, "kernel_launch: occupancy query says %d blocks per CU\n", per_cu); (void)hipGetLastError(); grid = -1; return; }
        if (per_cu > 1) per_cu = 1;
        grid = cus * per_cu;
    }
    if (grid < 0) return;
    if (hipMemsetAsync((char*)d_ws + WS_CTL, 0, CTL_ZERO_BYTES, stream) != hipSuccess) return;
    Args a{};
    Ptrs& P = a.P;
    P.x = (const float*)d_in[0]; P.c = (const float*)d_in[1]; P.pos = (const int*)d_in[2]; P.ada_w = (const float*)d_in[3]; P.ada_b = (const float*)d_in[4];
    P.norm_mix = (const float*)d_in[5]; P.norm_mlp = (const float*)d_in[6]; P.mlp_w1 = (const float*)d_in[7]; P.mlp_w2 = (const float*)d_in[8];
    P.mla_w_in = (const float*)d_in[9]; P.mla_g_qa = (const float*)d_in[10]; P.mla_w_qb = (const float*)d_in[11]; P.mla_g_kva = (const float*)d_in[12];
    P.mla_w_kvb = (const float*)d_in[13]; P.mla_g_q = (const float*)d_in[14]; P.mla_g_k = (const float*)d_in[15]; P.mla_w_o = (const float*)d_in[16];
    P.dil_w_in = (const float*)d_in[17]; P.dil_g_q = (const float*)d_in[18]; P.dil_g_k = (const float*)d_in[19]; P.dil_w_o = (const float*)d_in[20]; P.rel_bias = (const float*)d_in[21];
    P.out = (float*)d_out; P.ws = (unsigned char*)d_ws;
    unsigned char* ws = P.ws;
    int li = 0;
    auto launch = [&](int lo, int hi) { a.ph_lo = lo; a.ph_hi = hi; a.li = li++; hipLaunchKernelGGL(mega_fwd, dim3(grid), dim3(NWAVES * 64), LDS_BYTES, stream, a); };
#if HYBRID
#if HYBRID == 1
    launch(0, 6);
    naive_mla_attn<<<NBATCH * NH * 8, 256, 0, stream>>>((const bf16_t*)(ws + WS_Q), (const bf16_t*)(ws + WS_KV), (const bf16_t*)(ws + WS_KROPE), (bf16_t*)(ws + WS_H));
    launch(7, 13);
#else
    launch(0, 13);
#endif
    naive_dil_attn<<<NBATCH * NH * 8, 256, 0, stream>>>((const bf16_t*)(ws + WS_QKVG), P.pos, P.dil_g_q, P.dil_g_k, P.rel_bias, 0, 1, (bf16_t*)(ws + WS_O2), (float*)(ws + WS_LSE));
    launch(14, 15);
    naive_dil_attn<<<NBATCH * NH * 8, 256, 0, stream>>>((const bf16_t*)(ws + WS_QKVG), P.pos, P.dil_g_q, P.dil_g_k, P.rel_bias, 1, 4, (bf16_t*)(ws + WS_O2), (float*)(ws + WS_LSE));
    launch(16, 17);
    naive_dil_attn<<<NBATCH * NH * 8, 256, 0, stream>>>((const bf16_t*)(ws + WS_QKVG), P.pos, P.dil_g_q, P.dil_g_k, P.rel_bias, 2, 16, (bf16_t*)(ws + WS_O2), (float*)(ws + WS_LSE));
    launch(18, 22);
#else
    launch(0, NPHASE);
#endif
}
```

```cpp
#include <hip/hip_runtime.h>
#include <cstdint>
#include <cstdio>

#define LAS __attribute__((address_space(3)))
typedef unsigned short bf16_t;
typedef float f32x4 __attribute__((ext_vector_type(4)));
typedef float f32x2 __attribute__((ext_vector_type(2)));
typedef unsigned u32x4 __attribute__((ext_vector_type(4)));
typedef unsigned u32x2 __attribute__((ext_vector_type(2)));
typedef __bf16 bf16x2_t __attribute__((ext_vector_type(2)));

constexpr int DM = 1024, NBATCH = 8, SEQ = 2048, MTOK = NBATCH * SEQ;
constexpr int DFF = 4096, MODW = 6 * DM;
constexpr int QLORA = 384, KVLORA = 256, ROPE = 32, MLA_IN = 672, MLA_INP = 768;
constexpr int NH = 16, QKD = 96, NOPE = 64, VD = 64;
constexpr int DIL_IN = 9216, GCOLS = 3072, NBKT = 32;
constexpr float EPS = 1e-6f;
constexpr float LOG2E = 1.4426950408889634f;
constexpr float MLA_C2 = 0.10206207261596575f * LOG2E;
constexpr float DIL_C2 = 0.125f * LOG2E;

constexpr size_t MiB = 1u << 20;
constexpr size_t WS_CTL = 0, WS_MOD = 1 * MiB, WS_CS = 2 * MiB;
constexpr size_t WS_WIN0 = 4 * MiB, WS_WQB = 5 * MiB + 512 * 1024, WS_WKVB = 7 * MiB, WS_WO0 = 8 * MiB, WS_W1_0 = 10 * MiB, WS_W2_0 = 18 * MiB;
constexpr size_t WS_WIN1 = 26 * MiB, WS_WO1 = 44 * MiB, WS_W1_1 = 46 * MiB, WS_W2_1 = 54 * MiB;
constexpr size_t WS_H = 64 * MiB;
constexpr size_t WS_R = 96 * MiB;
constexpr size_t WS_PROJ = WS_R;
constexpr size_t WS_Q = WS_R;
constexpr size_t WS_KV = WS_R + 48 * MiB;
constexpr size_t WS_KROPE = WS_R + 112 * MiB;
constexpr size_t WS_QA = WS_R + 128 * MiB;
constexpr size_t WS_KVA = WS_R + 140 * MiB;
constexpr size_t WS_KR = WS_R + 148 * MiB;
constexpr size_t WS_U = WS_R;
constexpr size_t WS_QKVG = WS_R;
constexpr size_t WS_O2 = WS_R + 96 * MiB;
constexpr size_t WS_LSE = WS_R + 128 * MiB;
constexpr size_t WS_END = 256 * MiB;

__device__ __forceinline__ float bf2f(unsigned h) { return __uint_as_float(h << 16); }
__device__ __forceinline__ unsigned pk2(float lo, float hi) { f32x2 v = {lo, hi}; bf16x2_t b = __builtin_convertvector(v, bf16x2_t); return __builtin_bit_cast(unsigned, b); }
__device__ __forceinline__ float wave_sum(float v) {
#pragma unroll
    for (int o = 1; o < 64; o <<= 1) v += __shfl_xor(v, o);
    return v;
}
__device__ __forceinline__ void unpack8(u32x4 w, float (&f)[8]) {
    f[0] = bf2f(w.x & 0xffffu); f[1] = bf2f(w.x >> 16); f[2] = bf2f(w.y & 0xffffu); f[3] = bf2f(w.y >> 16);
    f[4] = bf2f(w.z & 0xffffu); f[5] = bf2f(w.z >> 16); f[6] = bf2f(w.w & 0xffffu); f[7] = bf2f(w.w >> 16);
}
__device__ __forceinline__ u32x4 pack8(const float (&f)[8]) { u32x4 w; w.x = pk2(f[0], f[1]); w.y = pk2(f[2], f[3]); w.z = pk2(f[4], f[5]); w.w = pk2(f[6], f[7]); return w; }
#define LDS_WAIT() asm volatile("s_waitcnt lgkmcnt(0)" ::: "memory")

__device__ __forceinline__ int t5_bucket(int rel) {
    const int n = rel < 0 ? -rel : rel;
    int b = n;
    if (n >= 8) b = 8 + (n >= 15) + (n >= 27) + (n >= 50) + (n >= 91) + (n >= 166) + (n >= 305) + (n >= 559);
    return b + (rel > 0 ? 16 : 0);
}

__device__ __forceinline__ void transpose_item(const float* W, int K, int ldn, int N, bf16_t* WT, int row_off, LAS float* scr, int item, int lane) {
    const int nblk = N / 32, kb = item / nblk, nb = item % nblk, k0 = 64 * kb, n0 = 32 * nb;
#pragma unroll 8
    for (int i = 0; i < 32; ++i) { const int kk = 2 * i + (lane >> 5); scr[kk * 33 + (lane & 31)] = W[(size_t)(k0 + kk) * ldn + n0 + (lane & 31)]; }
    LDS_WAIT();
    const int c = lane & 7;
#pragma unroll
    for (int j = 0; j < 4; ++j) { const int n = (lane >> 3) + 8 * j; const LAS float* s = scr + (8 * c) * 33 + n;
        u32x4 o; o.x = pk2(s[0 * 33], s[1 * 33]); o.y = pk2(s[2 * 33], s[3 * 33]); o.z = pk2(s[4 * 33], s[5 * 33]); o.w = pk2(s[6 * 33], s[7 * 33]);
        *(u32x4*)(WT + (size_t)(row_off + n0 + n) * K + k0 + 8 * c) = o; }
    LDS_WAIT();
}

struct Ptrs {
    const float *x, *c; const int* pos; const float *ada_w, *ada_b, *norm_mix, *norm_mlp, *mlp_w1, *mlp_w2;
    const float *mla_w_in, *mla_g_qa, *mla_w_qb, *mla_g_kva, *mla_w_kvb, *mla_g_q, *mla_g_k, *mla_w_o;
    const float *dil_w_in, *dil_g_q, *dil_g_k, *dil_w_o, *rel_bias;
    float* out; unsigned char* ws;
};

__device__ __forceinline__ void p0_weights(const Ptrs& P, LAS float* scr, int gw, int ngw, int lane) {
    unsigned char* ws = P.ws;
    constexpr int I_IN0 = (DM / 64) * (MLA_IN / 32), I_QB = (QLORA / 64) * (1536 / 32), I_KVB = (KVLORA / 64) * (2048 / 32), I_O = (DM / 64) * (DM / 32);
    constexpr int I_1 = (DM / 64) * (DFF / 32), I_2 = (DFF / 64) * (DM / 32), I_IN1 = (DM / 64) * (DIL_IN / 32);
    constexpr int NITEMS = I_IN0 + I_QB + I_KVB + I_O + 2 * I_1 + 2 * I_2 + I_IN1 + I_O;
    for (int it = gw; it < NITEMS; it += ngw) {
        int r = it;
        if (r < I_IN0) { transpose_item(P.mla_w_in, DM, MLA_IN, MLA_IN, (bf16_t*)(ws + WS_WIN0), 0, scr, r, lane); continue; } r -= I_IN0;
        if (r < I_QB) { transpose_item(P.mla_w_qb, QLORA, 1536, 1536, (bf16_t*)(ws + WS_WQB), 0, scr, r, lane); continue; } r -= I_QB;
        if (r < I_KVB) { transpose_item(P.mla_w_kvb, KVLORA, 2048, 2048, (bf16_t*)(ws + WS_WKVB), 0, scr, r, lane); continue; } r -= I_KVB;
        if (r < I_O) { transpose_item(P.mla_w_o, DM, DM, DM, (bf16_t*)(ws + WS_WO0), 0, scr, r, lane); continue; } r -= I_O;
        if (r < I_1) { transpose_item(P.mlp_w1, DM, DFF, DFF, (bf16_t*)(ws + WS_W1_0), 0, scr, r, lane); continue; } r -= I_1;
        if (r < I_1) { transpose_item(P.mlp_w1 + (size_t)DM * DFF, DM, DFF, DFF, (bf16_t*)(ws + WS_W1_1), 0, scr, r, lane); continue; } r -= I_1;
        if (r < I_2) { transpose_item(P.mlp_w2, DFF, DM, DM, (bf16_t*)(ws + WS_W2_0), 0, scr, r, lane); continue; } r -= I_2;
        if (r < I_2) { transpose_item(P.mlp_w2 + (size_t)DFF * DM, DFF, DM, DM, (bf16_t*)(ws + WS_W2_1), 0, scr, r, lane); continue; } r -= I_2;
        if (r < I_IN1) { transpose_item(P.dil_w_in, DM, DIL_IN, DIL_IN, (bf16_t*)(ws + WS_WIN1), 0, scr, r, lane); continue; } r -= I_IN1;
        transpose_item(P.dil_w_o, DM, DM, DM, (bf16_t*)(ws + WS_WO1), 0, scr, r, lane);
    }
    u32x4* z = (u32x4*)(ws + WS_WIN0 + (size_t)MLA_IN * DM * 2);
    for (int i = gw * 64 + lane; i < 12288; i += ngw * 64) z[i] = (u32x4){0u, 0u, 0u, 0u};
}
__device__ __forceinline__ void p0_cs(const Ptrs& P, int gtid, int nthr) {
    float* cs = (float*)(P.ws + WS_CS);
    for (int i = gtid; i < MTOK * 16; i += nthr) { const int m = i >> 4, f = i & 15;
        const float inv = 1.0f / powf(10000.0f, (float)f * 0.0625f); const float ang = (float)P.pos[m] * inv;
        cs[m * 32 + f] = cosf(ang); cs[m * 32 + 16 + f] = sinf(ang); }
}
__device__ __forceinline__ void p0_mod(const Ptrs& P, LAS float* lds, int bid, int nblk, int tid, int nwaves) {
    LAS float* cond = lds; LAS float* red = lds + 8 * DM;
    float* mod = (float*)(P.ws + WS_MOD);
    for (int i = tid; i < 8 * DM; i += nwaves * 64) { const float v = P.c[i]; cond[i] = v / (1.0f + expf(-v)); }
    __syncthreads();
    const int w = tid >> 6, lane = tid & 63, col = lane & 31, kp = lane >> 5, kper = DM / nwaves;
    for (int item = bid; item < 2 * (MODW / 32); item += nblk) {
        const int l = item / (MODW / 32), n0 = (item % (MODW / 32)) * 32;
        float acc[8];
#pragma unroll
        for (int b = 0; b < 8; ++b) acc[b] = 0.f;
        const float* wp = P.ada_w + (size_t)l * DM * MODW + n0 + col;
#pragma unroll 8
        for (int kk = 0; kk < kper / 2; ++kk) { const int k = w * kper + 2 * kk + kp; const float wv = wp[(size_t)k * MODW];
#pragma unroll
            for (int b = 0; b < 8; ++b) acc[b] += cond[b * DM + k] * wv; }
#pragma unroll
        for (int b = 0; b < 8; ++b) { acc[b] += __shfl_xor(acc[b], 32); if (lane < 32) red[(w * 8 + b) * 32 + col] = acc[b]; }
        __syncthreads();
        if (tid < 256) { const int b = tid >> 5, cc = tid & 31; float s = P.ada_b[l * MODW + n0 + cc];
            for (int ww = 0; ww < nwaves; ++ww) s += red[(ww * 8 + b) * 32 + cc];
            mod[(size_t)(l * 8 + b) * MODW + n0 + cc] = s; }
        __syncthreads();
    }
}
__device__ __forceinline__ void lnmod_rows(const float* X, const float* g, const float* modl  , int shift_idx, int scale_idx, bf16_t* H, int gw, int ngw, int lane) {
    for (int m = gw; m < MTOK; m += ngw) {
        const f32x4* xr = (const f32x4*)(X + (size_t)m * DM) + lane;
        f32x4 v[4]; float ss = 0.f;
#pragma unroll
        for (int j = 0; j < 4; ++j) { v[j] = xr[64 * j]; ss += (v[j].x * v[j].x + v[j].y * v[j].y) + (v[j].z * v[j].z + v[j].w * v[j].w); }
        const float rstd = 1.0f / sqrtf(wave_sum(ss) * (1.0f / DM) + EPS);
        const float* mb = modl + (size_t)(m / SEQ) * MODW;
        u32x2* o = (u32x2*)(H + (size_t)m * DM) + lane;
#pragma unroll
        for (int j = 0; j < 4; ++j) { const int col = 4 * (lane + 64 * j);
            const f32x4 gg = *(const f32x4*)(g + col), sc = *(const f32x4*)(mb + scale_idx * DM + col), sh = *(const f32x4*)(mb + shift_idx * DM + col);
            const f32x4 y = v[j] * rstd * gg * (sc + 1.0f) + sh;
            u32x2 w; w.x = pk2(y.x, y.y); w.y = pk2(y.z, y.w); o[64 * j] = w; }
    }
}
__device__ __forceinline__ void mla_prep_rows(const Ptrs& P, int gw, int ngw, int lane) {
    const float* PROJ = (const float*)(P.ws + WS_PROJ); const float* cs = (const float*)(P.ws + WS_CS);
    bf16_t* QA = (bf16_t*)(P.ws + WS_QA); bf16_t* KVA = (bf16_t*)(P.ws + WS_KVA); float* KR = (float*)(P.ws + WS_KR);
    for (int m = gw; m < MTOK; m += ngw) {
        const float* p = PROJ + (size_t)m * MLA_INP;
        float q[8]; float ss = 0.f;
        if (lane < 48) { const f32x4 a = *(const f32x4*)(p + 8 * lane), b = *(const f32x4*)(p + 8 * lane + 4);
            q[0] = a.x; q[1] = a.y; q[2] = a.z; q[3] = a.w; q[4] = b.x; q[5] = b.y; q[6] = b.z; q[7] = b.w;
#pragma unroll
            for (int i = 0; i < 8; ++i) ss += q[i] * q[i]; }
        else {
#pragma unroll
            for (int i = 0; i < 8; ++i) q[i] = 0.f; }
        const float rq = 1.0f / sqrtf(wave_sum(ss) * (1.0f / QLORA) + EPS);
        if (lane < 48) { float o[8];
#pragma unroll
            for (int i = 0; i < 8; ++i) o[i] = q[i] * rq * P.mla_g_qa[8 * lane + i];
            *(u32x4*)(QA + (size_t)m * QLORA + 8 * lane) = pack8(o); }
        float kv[8]; float s2 = 0.f;
        if (lane < 32) { const f32x4 a = *(const f32x4*)(p + QLORA + 8 * lane), b = *(const f32x4*)(p + QLORA + 8 * lane + 4);
            kv[0] = a.x; kv[1] = a.y; kv[2] = a.z; kv[3] = a.w; kv[4] = b.x; kv[5] = b.y; kv[6] = b.z; kv[7] = b.w;
#pragma unroll
            for (int i = 0; i < 8; ++i) s2 += kv[i] * kv[i]; }
        else {
#pragma unroll
            for (int i = 0; i < 8; ++i) kv[i] = 0.f; }
        const float rk = 1.0f / sqrtf(wave_sum(s2) * (1.0f / KVLORA) + EPS);
        if (lane < 32) { float o[8];
#pragma unroll
            for (int i = 0; i < 8; ++i) o[i] = kv[i] * rk * P.mla_g_kva[8 * lane + i];
            *(u32x4*)(KVA + (size_t)m * KVLORA + 8 * lane) = pack8(o); }
        if (lane < 16) { const float x1 = p[QLORA + KVLORA + lane], x2 = p[QLORA + KVLORA + 16 + lane]; const float c = cs[m * 32 + lane], s = cs[m * 32 + 16 + lane];
            KR[m * 32 + lane] = x1 * c - x2 * s; KR[m * 32 + 16 + lane] = x2 * c + x1 * s; }
    }
}
__device__ __forceinline__ void mla_final_rows(const Ptrs& P, int gw, int ngw, int lane) {
    const float* cs = (const float*)(P.ws + WS_CS); const float* KR = (const float*)(P.ws + WS_KR);
    bf16_t* Q = (bf16_t*)(P.ws + WS_Q); bf16_t* KV = (bf16_t*)(P.ws + WS_KV); bf16_t* KROPE = (bf16_t*)(P.ws + WS_KROPE);
    const int h = lane >> 2, sub = lane & 3;
    for (int m = gw; m < MTOK; m += ngw) {
        float c4[4], s4[4];
#pragma unroll
        for (int t = 0; t < 4; ++t) { c4[t] = cs[m * 32 + 4 * sub + t]; s4[t] = cs[m * 32 + 16 + 4 * sub + t]; }
        {
            bf16_t* qb = Q + (size_t)m * 1536 + h * QKD;
            float a[8], b[8]; unpack8(*(const u32x4*)(qb + 16 * sub), a); unpack8(*(const u32x4*)(qb + 16 * sub + 8), b);
            const u32x2 w1 = *(const u32x2*)(qb + NOPE + 4 * sub), w2 = *(const u32x2*)(qb + NOPE + 16 + 4 * sub);
            const float r1[4] = {bf2f(w1.x & 0xffffu), bf2f(w1.x >> 16), bf2f(w1.y & 0xffffu), bf2f(w1.y >> 16)};
            const float r2[4] = {bf2f(w2.x & 0xffffu), bf2f(w2.x >> 16), bf2f(w2.y & 0xffffu), bf2f(w2.y >> 16)};
            float y1[4], y2[4]; float ss = 0.f;
#pragma unroll
            for (int t = 0; t < 4; ++t) { y1[t] = r1[t] * c4[t] - r2[t] * s4[t]; y2[t] = r2[t] * c4[t] + r1[t] * s4[t]; ss += y1[t] * y1[t] + y2[t] * y2[t]; }
#pragma unroll
            for (int i = 0; i < 8; ++i) ss += a[i] * a[i] + b[i] * b[i];
            ss += __shfl_xor(ss, 1); ss += __shfl_xor(ss, 2);
            const float rs = MLA_C2 / sqrtf(ss * (1.0f / QKD) + EPS);
#pragma unroll
            for (int i = 0; i < 8; ++i) { a[i] *= rs * P.mla_g_q[16 * sub + i]; b[i] *= rs * P.mla_g_q[16 * sub + 8 + i]; }
#pragma unroll
            for (int t = 0; t < 4; ++t) { y1[t] *= rs * P.mla_g_q[NOPE + 4 * sub + t]; y2[t] *= rs * P.mla_g_q[NOPE + 16 + 4 * sub + t]; }
            *(u32x4*)(qb + 16 * sub) = pack8(a); *(u32x4*)(qb + 16 * sub + 8) = pack8(b);
            u32x2 o1, o2; o1.x = pk2(y1[0], y1[1]); o1.y = pk2(y1[2], y1[3]); o2.x = pk2(y2[0], y2[1]); o2.y = pk2(y2[2], y2[3]);
            *(u32x2*)(qb + NOPE + 4 * sub) = o1; *(u32x2*)(qb + NOPE + 16 + 4 * sub) = o2;
        }
        {
            bf16_t* kb = KV + (size_t)m * 2048 + h * 128;
            float a[8], b[8]; unpack8(*(const u32x4*)(kb + 16 * sub), a); unpack8(*(const u32x4*)(kb + 16 * sub + 8), b);
            const f32x4 k1 = *(const f32x4*)(KR + m * 32 + 4 * sub), k2 = *(const f32x4*)(KR + m * 32 + 16 + 4 * sub);
            float ss = (k1.x * k1.x + k1.y * k1.y) + (k1.z * k1.z + k1.w * k1.w) + (k2.x * k2.x + k2.y * k2.y) + (k2.z * k2.z + k2.w * k2.w);
#pragma unroll
            for (int i = 0; i < 8; ++i) ss += a[i] * a[i] + b[i] * b[i];
            ss += __shfl_xor(ss, 1); ss += __shfl_xor(ss, 2);
            const float rs = 1.0f / sqrtf(ss * (1.0f / QKD) + EPS);
#pragma unroll
            for (int i = 0; i < 8; ++i) { a[i] *= rs * P.mla_g_k[16 * sub + i]; b[i] *= rs * P.mla_g_k[16 * sub + 8 + i]; }
            *(u32x4*)(kb + 16 * sub) = pack8(a); *(u32x4*)(kb + 16 * sub + 8) = pack8(b);
            const f32x4 g1 = *(const f32x4*)(P.mla_g_k + NOPE + 4 * sub), g2 = *(const f32x4*)(P.mla_g_k + NOPE + 16 + 4 * sub);
            u32x2 o1, o2; o1.x = pk2(k1.x * rs * g1.x, k1.y * rs * g1.y); o1.y = pk2(k1.z * rs * g1.z, k1.w * rs * g1.w);
            o2.x = pk2(k2.x * rs * g2.x, k2.y * rs * g2.y); o2.y = pk2(k2.z * rs * g2.z, k2.w * rs * g2.w);
            bf16_t* kr = KROPE + (size_t)m * 512 + h * 32;
            *(u32x2*)(kr + 4 * sub) = o1; *(u32x2*)(kr + 16 + 4 * sub) = o2;
        }
    }
}

struct EpiF32 { static constexpr int NV = 4; float* C; int ldc, pad;
    __device__ __forceinline__ void store(int row, int col, const float* v) const { *(f32x4*)(C + (size_t)row * ldc + col) = (f32x4){v[0], v[1], v[2], v[3]}; } };
struct EpiBf16 { static constexpr int NV = 8; bf16_t* C; int ldc, pad;
    __device__ __forceinline__ void store(int row, int col, const float* v) const { u32x4 w; w.x = pk2(v[0], v[1]); w.y = pk2(v[2], v[3]); w.z = pk2(v[4], v[5]); w.w = pk2(v[6], v[7]);
        *(u32x4*)(C + (size_t)row * ldc + col) = w; } };
struct EpiSqRelu { static constexpr int NV = 8; bf16_t* C; int ldc, pad;
    __device__ __forceinline__ void store(int row, int col, const float* v) const { float r[8];
#pragma unroll
        for (int i = 0; i < 8; ++i) { const float t = fmaxf(v[i], 0.f); r[i] = t * t; }
        u32x4 w; w.x = pk2(r[0], r[1]); w.y = pk2(r[2], r[3]); w.z = pk2(r[4], r[5]); w.w = pk2(r[6], r[7]);
        *(u32x4*)(C + (size_t)row * ldc + col) = w; } };
struct EpiResGate { static constexpr int NV = 4; const float* base; float* out; const float* gate  ;
    __device__ __forceinline__ void store(int row, int col, const float* v) const {
        const f32x4 b = *(const f32x4*)(base + (size_t)row * DM + col), g = *(const f32x4*)(gate + (size_t)(row / SEQ) * MODW + col);
        *(f32x4*)(out + (size_t)row * DM + col) = b + g * (f32x4){v[0], v[1], v[2], v[3]}; } };

namespace pg8 {
#define PG8_LAS __attribute__((address_space(3)))
typedef unsigned short bf16_t;
typedef short bf16x8 __attribute__((ext_vector_type(8)));
typedef float f32x4 __attribute__((ext_vector_type(4)));
typedef unsigned u32x4 __attribute__((ext_vector_type(4)));
constexpr int BM = 256, BK = 64, HALF = 128, HTB = HALF * BK * 2  , STAGE_BYTES = 8 * HTB, NXCD = 8, WGM = 8;

__host__ __device__ __forceinline__ int lds_byte(int r, int c) { const int st = (r >> 4) * 2 + (c >> 5), rr = r & 15, cc = c & 31, ob = rr * 64 + cc * 2; return st * 1024 + (ob ^ (((ob >> 9) & 1) << 5)); }
__host__ __device__ __forceinline__ void stage_rc(int b, int& R, int& C) { const int st = b / 1024, sb = b % 1024, swz = sb ^ (((sb >> 9) & 1) << 5); R = (st >> 1) * 16 + swz / 64; C = (st & 1) * 32 + (swz % 64) / 2; }
__host__ __device__ __forceinline__ int perm32(int rho) { const int n = rho >> 4, i = rho & 15; return 8 * (i >> 2) + 4 * n + (i & 3); }

struct Unit { int pm, pn; };
struct Gemm { const bf16_t* A; const bf16_t* Bt; int M, N, K; };

struct StaticOrder {
    int nM, nN, nwg, G, c;
    __host__ __device__ void init(int M, int N, int G_, int c_) { nM = M / BM; nN = N / BM; nwg = nM * nN; G = G_; c = c_; }
    __host__ __device__ bool next(int i, Unit& u) const {
        const long L = (long)i * G + c; if (L >= nwg) return false;
        int wgid = (int)L; { const int q = nwg / NXCD, r = nwg % NXCD, xcd = wgid % NXCD, off = wgid / NXCD; wgid = (xcd < r ? xcd * (q + 1) : r * (q + 1) + (xcd - r) * q) + off; }
        const int nig = WGM * nN, gid = wgid / nig, fm = gid * WGM, gsz = (nM - fm) < WGM ? (nM - fm) : WGM;
        u.pm = fm + ((wgid % nig) % gsz); u.pn = (wgid % nig) / gsz; return true;
    }
    __device__ __forceinline__ void a_ready(const Unit&) const {}
    __device__ __forceinline__ void done(const Unit&) const {}
};

template <class Epi, class Sched, bool ALIGN_EPI = false, bool SP2 = false>
__device__ __forceinline__ void gemm_phase(PG8_LAS unsigned char* lds, const Gemm g, const Sched& S, const Epi& E) {
    int tid_ = threadIdx.x; asm volatile("" : "+v"(tid_));
    const int tid = tid_, wid = __builtin_amdgcn_readfirstlane(tid >> 6), lane = tid & 63, wr = wid >> 2, wc = wid & 3, fr = lane & 15, fq = lane >> 4;
    const int K = g.K, nt = K / BK;
    unsigned voffA[2], voffB[2];
#pragma unroll
    for (int i = 0; i < 2; ++i) { int R, C; stage_rc(tid * 16 + i * 8192, R, C); const int Rb = Epi::PERM ? ((R & ~31) + perm32(R & 31)) : R;
        voffA[i] = (unsigned)(R * K + C) * 2u; voffB[i] = (unsigned)(Rb * K + C) * 2u; }
    const size_t kstep = (size_t)(BK * 2);
    const size_t hstep = (size_t)HALF * K * 2;
    const size_t tstep = 2 * hstep;
    const unsigned ldsw = (unsigned)wid * 1024u;
    const int aoff = lds_byte(wr * 64 + fr, fq * 8), boff = lds_byte(wc * 32 + fr, fq * 8);
#define PG8_SA(b, h) (((b) * 2 + (h)) * HTB)
#define PG8_SB(b, h) ((4 + (b) * 2 + (h)) * HTB)
#define PG8_STAGE(bufoff, gbase, voff) do { _Pragma("unroll") for (int _i = 0; _i < 2; ++_i) \
        __builtin_amdgcn_global_load_lds((const unsigned*)((const char*)(gbase) + (voff)[_i]), (PG8_LAS unsigned*)(lds + (bufoff) + ldsw + _i * 8192), 16, 0, 0); } while (0)
#define PG8_LDA(dst, b, h) do { _Pragma("unroll") for (int m = 0; m < 4; ++m) _Pragma("unroll") for (int k = 0; k < 2; ++k) dst[m][k] = *(const PG8_LAS bf16x8*)(lds + PG8_SA(b, h) + aoff + m * 2048 + k * 1024); } while (0)
#define PG8_LDB(dst, b, h) do { _Pragma("unroll") for (int n = 0; n < 2; ++n) _Pragma("unroll") for (int k = 0; k < 2; ++k) dst[n][k] = *(const PG8_LAS bf16x8*)(lds + PG8_SB(b, h) + boff + n * 2048 + k * 1024); } while (0)
#define PG8_MMA(ai, bj, At, Bt) do { __builtin_amdgcn_s_setprio(1); _Pragma("unroll") for (int m = 0; m < 4; ++m) _Pragma("unroll") for (int n = 0; n < 2; ++n) _Pragma("unroll") for (int k = 0; k < 2; ++k) \
        acc[ai][bj][m][n] = __builtin_amdgcn_mfma_f32_16x16x32_bf16(Bt[n][k], At[m][k], acc[ai][bj][m][n], 0, 0, 0); __builtin_amdgcn_s_setprio(0); } while (0)
#define PG8_WAIT_V(n) asm volatile("s_waitcnt vmcnt(" #n ")" ::: "memory")
#define PG8_WAIT_L(n) asm volatile("s_waitcnt lgkmcnt(" #n ")" ::: "memory")
#define PG8_BAR __builtin_amdgcn_s_barrier()
#define PG8_SCHED __builtin_amdgcn_sched_barrier(0)
    Unit cur, nxt; int ui = 0;
    if (!S.next(0, cur)) return;
    f32x4 acc[2][2][4][2];
#pragma unroll
    for (int a = 0; a < 2; ++a)
#pragma unroll
        for (int b = 0; b < 2; ++b)
#pragma unroll
            for (int m = 0; m < 4; ++m)
#pragma unroll
                for (int n = 0; n < 2; ++n) acc[a][b][m][n] = (f32x4){0.f, 0.f, 0.f, 0.f};
    bf16x8 At[4][2], B0[2][2], B1[2][2];
    const char* cA = (const char*)g.A + (size_t)cur.pm * tstep; const char* cB = (const char*)g.Bt + (size_t)cur.pn * tstep;
    S.a_ready(cur);
    if constexpr (SP2) {
        PG8_STAGE(PG8_SB(0, 0), cB, voffB); PG8_STAGE(PG8_SB(0, 1), cB + hstep, voffB); PG8_STAGE(PG8_SA(0, 0), cA, voffA); PG8_STAGE(PG8_SA(0, 1), cA + hstep, voffA);
        if (wr == 1) PG8_BAR;
        PG8_WAIT_V(2); PG8_BAR;
        PG8_STAGE(PG8_SB(1, 0), cB + kstep, voffB); PG8_STAGE(PG8_SA(1, 0), cA + kstep, voffA); PG8_STAGE(PG8_SB(1, 1), cB + hstep + kstep, voffB);
        PG8_WAIT_V(6); PG8_BAR;
    } else {
        PG8_STAGE(PG8_SB(0, 0), cB, voffB); PG8_STAGE(PG8_SA(0, 0), cA, voffA); PG8_STAGE(PG8_SB(0, 1), cB + hstep, voffB); PG8_STAGE(PG8_SA(0, 1), cA + hstep, voffA);
        if (wr == 1) PG8_BAR;
        PG8_WAIT_V(4); PG8_BAR;
        PG8_STAGE(PG8_SB(1, 0), cB + kstep, voffB); PG8_STAGE(PG8_SA(1, 0), cA + kstep, voffA); PG8_STAGE(PG8_SB(1, 1), cB + hstep + kstep, voffB);
        PG8_WAIT_V(6); PG8_BAR;
    }
    for (;;) {
        const bool has_next = S.next(ui + 1, nxt);
        const char* nA = has_next ? (const char*)g.A + (size_t)nxt.pm * tstep : cA; const char* nB = has_next ? (const char*)g.Bt + (size_t)nxt.pn * tstep : cB;
        for (int t = 0; t < nt; t += 2) {
            const bool last = (t == nt - 2);
            const char* a1 = cA + (size_t)(t + 1) * kstep;
            const char* a2 = last ? nA : cA + (size_t)(t + 2) * kstep; const char* b2 = last ? nB : cB + (size_t)(t + 2) * kstep;
            const char* a3 = a2 + kstep; const char* b3 = b2 + kstep;
            if (last && has_next) S.a_ready(nxt);
            if constexpr (SP2) {
            PG8_LDB(B0, 0, 0); PG8_LDB(B1, 0, 1); PG8_SCHED; PG8_LDA(At, 0, 0); PG8_STAGE(PG8_SA(1, 1), a1 + hstep, voffA);
            PG8_WAIT_V(8); PG8_WAIT_L(0); PG8_BAR; PG8_MMA(0, 0, At, B0); PG8_MMA(0, 1, At, B1); PG8_BAR; PG8_SCHED;
            PG8_LDA(At, 0, 1); PG8_STAGE(PG8_SB(0, 0), b2, voffB); PG8_STAGE(PG8_SB(0, 1), b2 + hstep, voffB); PG8_STAGE(PG8_SA(0, 0), a2, voffA);
            PG8_WAIT_V(8); PG8_WAIT_L(0); PG8_BAR; PG8_MMA(1, 0, At, B0); PG8_MMA(1, 1, At, B1); PG8_BAR; PG8_SCHED;
            PG8_LDB(B0, 1, 0); PG8_LDB(B1, 1, 1); PG8_SCHED; PG8_LDA(At, 1, 0); PG8_STAGE(PG8_SA(0, 1), a2 + hstep, voffA);
            PG8_WAIT_V(8); PG8_WAIT_L(0); PG8_BAR; PG8_MMA(0, 0, At, B0); PG8_MMA(0, 1, At, B1); PG8_BAR; PG8_SCHED;
            PG8_LDA(At, 1, 1); PG8_STAGE(PG8_SB(1, 0), b3, voffB); PG8_STAGE(PG8_SB(1, 1), b3 + hstep, voffB); PG8_STAGE(PG8_SA(1, 0), a3, voffA);
            PG8_WAIT_V(8); PG8_WAIT_L(0); PG8_BAR; PG8_MMA(1, 0, At, B0); PG8_MMA(1, 1, At, B1); PG8_BAR; PG8_SCHED;
            } else {
            PG8_LDB(B0, 0, 0); PG8_SCHED; PG8_LDA(At, 0, 0); PG8_STAGE(PG8_SA(1, 1), a1 + hstep, voffA);
            PG8_WAIT_L(8); PG8_BAR; PG8_WAIT_L(0); PG8_MMA(0, 0, At, B0); PG8_BAR; PG8_SCHED;
            PG8_LDB(B1, 0, 1); PG8_STAGE(PG8_SB(0, 0), b2, voffB);
            PG8_BAR; PG8_WAIT_L(0); PG8_MMA(0, 1, At, B1); PG8_BAR;
            PG8_LDA(At, 0, 1); PG8_STAGE(PG8_SA(0, 0), a2, voffA);
            PG8_BAR; PG8_WAIT_L(0); PG8_MMA(1, 0, At, B0); PG8_BAR; PG8_SCHED;
            PG8_STAGE(PG8_SB(0, 1), b2 + hstep, voffB);
            PG8_WAIT_V(6); PG8_BAR; PG8_MMA(1, 1, At, B1); PG8_BAR;
            PG8_LDB(B0, 1, 0); PG8_SCHED; PG8_LDA(At, 1, 0); PG8_STAGE(PG8_SA(0, 1), a2 + hstep, voffA);
            PG8_WAIT_L(8); PG8_BAR; PG8_WAIT_L(0); PG8_MMA(0, 0, At, B0); PG8_BAR; PG8_SCHED;
            PG8_LDB(B1, 1, 1); PG8_STAGE(PG8_SB(1, 0), b3, voffB);
            PG8_BAR; PG8_WAIT_L(0); PG8_MMA(0, 1, At, B1); PG8_BAR;
            PG8_LDA(At, 1, 1); PG8_STAGE(PG8_SA(1, 0), a3, voffA);
            PG8_BAR; PG8_WAIT_L(0); PG8_MMA(1, 0, At, B0); PG8_BAR; PG8_SCHED;
            PG8_STAGE(PG8_SB(1, 1), b3 + hstep, voffB);
            PG8_WAIT_V(6); PG8_BAR; PG8_MMA(1, 1, At, B1); PG8_BAR;
            }
        }
        if constexpr (ALIGN_EPI) { if (wr == 0) PG8_BAR; }
        if constexpr (!Epi::AFTER_DRAIN) { E(acc, cur, wr, wc, fr, fq); S.done(cur); }
        if (!has_next) break;
#pragma unroll
        for (int a = 0; a < 2; ++a)
#pragma unroll
            for (int b = 0; b < 2; ++b)
#pragma unroll
                for (int m = 0; m < 4; ++m)
#pragma unroll
                    for (int n = 0; n < 2; ++n) acc[a][b][m][n] = (f32x4){0.f, 0.f, 0.f, 0.f};
        cur = nxt; cA = nA; cB = nB; ++ui;
        if constexpr (ALIGN_EPI) { if (wr == 1) PG8_BAR; }
    }
    PG8_WAIT_V(0);
    if constexpr (!ALIGN_EPI) { if (wr == 0) PG8_BAR; }
    PG8_BAR;
    if constexpr (Epi::AFTER_DRAIN) { E.fused(acc, cur, wr, wc, fr, fq, lds, wid, lane); S.done(cur); }
#undef PG8_SA
#undef PG8_SB
#undef PG8_STAGE
#undef PG8_LDA
#undef PG8_LDB
#undef PG8_MMA
#undef PG8_WAIT_V
#undef PG8_WAIT_L
#undef PG8_BAR
#undef PG8_SCHED
}
}
#define XB_TMO      128
#define XB_XCNT(j)  (256  + 64 * (j))
#define XB_XSUB(j)  (1280 + 64 * (j))
#define XB_XGEN(j)  (2304 + 64 * (j))
#define XB_TOP      3328
#define XB_TOPGEN   3392
#define XCD_BAR_WORDS 3456
#define XB_SPIN_CAP (1u << 18)

__device__ __forceinline__ unsigned xb_ld(unsigned* p)              { return __hip_atomic_load(p, __ATOMIC_RELAXED, __HIP_MEMORY_SCOPE_AGENT); }
__device__ __forceinline__ unsigned xb_add(unsigned* p, unsigned v) { return __hip_atomic_fetch_add(p, v, __ATOMIC_RELAXED, __HIP_MEMORY_SCOPE_AGENT); }
__device__ __forceinline__ unsigned xb_xcc_id() { return (unsigned)__builtin_amdgcn_s_getreg((3 << 11) | 20) & 0xFu; }
#define XB_SPIN(cond, bar) do { unsigned _sp = 0; while (cond) { __builtin_amdgcn_s_sleep(1); \
    if ((++_sp & 255u) == 0u) { if (xb_ld(&(bar)[XB_TMO])) break; if (_sp > XB_SPIN_CAP) { atomicAdd(&(bar)[XB_TMO], 1u); break; } } } } while (0)

struct XcdBarrier {
    unsigned* bar; unsigned x;
    volatile LAS unsigned* st;
};

__device__ __forceinline__ XcdBarrier xcd_barrier_post(unsigned* bar, volatile LAS unsigned* st) {
    XcdBarrier b; b.bar = bar; b.x = xb_xcc_id(); b.st = st;
    if (threadIdx.x == 0) (void)xb_add(&bar[XB_XCNT(b.x)], 1u);
    return b;
}
__device__ __forceinline__ void xcd_barrier_complete(unsigned* bar, unsigned x, unsigned& nloc, unsigned& nx) {
    const unsigned G = gridDim.x * gridDim.y * gridDim.z;
    unsigned sum, cnt, mine, sp = 0u;
    for (;;) {
        sum = 0u; cnt = 0u; mine = 0u;
#pragma unroll
        for (unsigned j = 0; j < 16; ++j) { const unsigned c = xb_ld(&bar[XB_XCNT(j)]); sum += c; cnt += (c > 0u) ? 1u : 0u; mine = (j == x) ? c : mine; }
        if (sum == G) break;
        __builtin_amdgcn_s_sleep(1);
        if ((++sp & 255u) == 0u) { if (xb_ld(&bar[XB_TMO])) break; if (sp > XB_SPIN_CAP) { atomicAdd(&bar[XB_TMO], 1u); break; } }
    }
    nloc = mine > 0u ? mine : 1u; nx = cnt > 0u ? cnt : 1u;
}

__device__ __forceinline__ void xcd_barrier(const XcdBarrier& b) {
    asm volatile("s_waitcnt vmcnt(0)" ::: "memory");
    __syncthreads();
    if (threadIdx.x == 0) {
        unsigned* bar = b.bar;
        __builtin_amdgcn_s_waitcnt(0);
        unsigned nloc = b.st[0], nx = b.st[1];
        if (nloc == 0u) { xcd_barrier_complete(bar, b.x, nloc, nx); b.st[0] = nloc; b.st[1] = nx; }
        const unsigned old = xb_add(&bar[XB_XSUB(b.x)], 1u);
        const unsigned gen = old / nloc;
        if (old + 1u == (gen + 1u) * nloc) {
            __builtin_amdgcn_fence(__ATOMIC_RELEASE, "agent");
            asm volatile("s_waitcnt vmcnt(0)" ::: "memory");
            const unsigned og = xb_add(&bar[XB_TOP], 1u);
            const unsigned tg = og / nx;
            if (og + 1u == (tg + 1u) * nx) xb_add(&bar[XB_TOPGEN], 1u);
            else XB_SPIN(xb_ld(&bar[XB_TOPGEN]) == tg, bar);
            __builtin_amdgcn_fence(__ATOMIC_ACQUIRE, "agent");
            xb_add(&bar[XB_XGEN(b.x)], 1u);
            asm volatile("s_waitcnt vmcnt(0)" ::: "memory");
        } else {
            XB_SPIN(xb_ld(&bar[XB_XGEN(b.x)]) == gen, bar);
            __builtin_amdgcn_fence(__ATOMIC_ACQUIRE, "agent");
            asm volatile("s_waitcnt vmcnt(0)" ::: "memory");
        }
    }
    __syncthreads();
}
namespace att {
typedef short bf16x8 __attribute__((ext_vector_type(8)));
typedef short s16x4 __attribute__((ext_vector_type(4)));
typedef float f32x16 __attribute__((ext_vector_type(16)));
__device__ __forceinline__ int crow(int r, int hi) { return (r & 3) + 8 * (r >> 2) + 4 * hi; }
template <int NCB> __device__ __forceinline__ int v_st(int k, int c) { const int kk = (k & ~0xC) | ((k & 4) << 1) | ((k & 8) >> 1); return ((kk >> 3) * NCB + (c >> 5)) * 512 + ((kk & 7) * 32 + (c & 31)) * 2; }
__device__ __forceinline__ int v_rd_base(int lane) { return ((lane & 3) << 3) | (((lane >> 2) & 3) << 6) | (((lane >> 4) & 1) << 5) | (((lane >> 5) & 1) << 8); }
__device__ __forceinline__ s16x4 vtr(const LAS unsigned char* p) { typedef short v4i16_t __attribute__((ext_vector_type(4)));
    return __builtin_bit_cast(s16x4, __builtin_amdgcn_ds_read_tr16_b64_v4i16((LAS v4i16_t*)p)); }
__device__ __forceinline__ float swap_max(float v) { auto rr = __builtin_amdgcn_permlane32_swap(__float_as_uint(v), __float_as_uint(v), false, false); return fmaxf(__uint_as_float(rr[0]), __uint_as_float(rr[1])); }
__device__ __forceinline__ float swap_add(float v) { auto rr = __builtin_amdgcn_permlane32_swap(__float_as_uint(v), __float_as_uint(v), false, false); return __uint_as_float(rr[0]) + __uint_as_float(rr[1]); }
#define ATT_PK4(P, BASE, OUT) do { const unsigned a0_ = pk2(P[BASE + 0], P[BASE + 1]), a1_ = pk2(P[BASE + 2], P[BASE + 3]); \
    const unsigned b0_ = pk2(P[BASE + 4], P[BASE + 5]), b1_ = pk2(P[BASE + 6], P[BASE + 7]); \
    auto r0_ = __builtin_amdgcn_permlane32_swap(a0_, b0_, false, false); auto r1_ = __builtin_amdgcn_permlane32_swap(a1_, b1_, false, false); \
    u32x4 w_ = {r0_[0], r1_[0], r0_[1], r1_[1]}; OUT = __builtin_bit_cast(bf16x8, w_); } while (0)

constexpr int KPITCH = 208, KTILE = 64 * KPITCH, VTILE = 64 * 64 * 2;
constexpr int OFF_K = 0, OFF_V = 2 * KTILE, OFF_WS = OFF_V + 2 * VTILE, MLA_LDS = OFF_WS + 8 * 64 * 4;
static_assert(MLA_LDS <= 131072 && (OFF_V % 16) == 0 && (KTILE % 16) == 0, "MLA attention LDS map");

__device__ __forceinline__ void mla_unit(const bf16_t* Q, const bf16_t* KV, const bf16_t* KROPE, bf16_t* O, LAS unsigned char* lds, int b, int h, int qb) {
    int tid_ = threadIdx.x; asm volatile("" : "+v"(tid_));
    const int tid = tid_, lane = tid & 63, r32 = lane & 31, hi = lane >> 5, wid = __builtin_amdgcn_readfirstlane(tid >> 6);
    const size_t row0 = (size_t)b * SEQ;
    const bf16_t* ksrc = KV + (row0 + (tid >> 3)) * 2048 + h * 128 + (tid & 7) * 8;
    const bf16_t* rsrc = KROPE + (row0 + (tid >> 2)) * 512 + h * 32 + (tid & 3) * 8;
    const int kdst = OFF_K + (tid >> 3) * KPITCH + (tid & 7) * 16;
    const int rdst = OFF_K + (tid >> 2) * KPITCH + 128 + (tid & 3) * 16;
    const int vdst = OFF_V + v_st<2>(tid >> 3, (tid & 7) * 8);
    const bool has_r = wid < 4;
    const bf16_t* qp = Q + (row0 + qb * 256 + wid * 32 + r32) * 1536 + h * QKD + hi * 8;
    bf16x8 qr[6];
#pragma unroll
    for (int d0 = 0; d0 < 6; ++d0) qr[d0] = *(const bf16x8*)(qp + 16 * d0);
    f32x16 o0, o1;
#pragma unroll
    for (int r = 0; r < 16; ++r) { o0[r] = 0.f; o1[r] = 0.f; }
    float m = -1e30f, l = 0.f;
    LAS float* wsf = (LAS float*)(lds + OFF_WS) + wid * 64;
    u32x4 kreg, rreg = {0u, 0u, 0u, 0u}, vreg;
#define ATT_LOAD(t) do { kreg = *(const u32x4*)(ksrc + (size_t)(t) * 64 * 2048); vreg = *(const u32x4*)(ksrc + (size_t)(t) * 64 * 2048 + 64); if (has_r) rreg = *(const u32x4*)(rsrc + (size_t)(t) * 64 * 512); } while (0)
#define ATT_WRITE(buf) do { *(LAS u32x4*)(lds + kdst + (buf) * KTILE) = kreg; *(LAS u32x4*)(lds + vdst + (buf) * VTILE) = vreg; if (has_r) *(LAS u32x4*)(lds + rdst + (buf) * KTILE) = rreg; } while (0)
    ATT_LOAD(0); ATT_WRITE(0); ATT_LOAD(1);
    const int NT = SEQ / 64;
#pragma unroll 1
    for (int t = 0; t < NT; ++t) {
        __syncthreads();
        const int cur = t & 1;
        if (t + 1 < NT) { ATT_WRITE(cur ^ 1); if (t + 2 < NT) ATT_LOAD(t + 2); }
        f32x16 p0, p1;
#pragma unroll
        for (int r = 0; r < 16; ++r) { p0[r] = 0.f; p1[r] = 0.f; }
        const LAS unsigned char* kb = lds + OFF_K + cur * KTILE + r32 * KPITCH + hi * 16;
#pragma unroll
        for (int d0 = 0; d0 < 6; ++d0) {
            const bf16x8 a0 = *(const LAS bf16x8*)(kb + d0 * 32), a1 = *(const LAS bf16x8*)(kb + 32 * KPITCH + d0 * 32);
            p0 = __builtin_amdgcn_mfma_f32_32x32x16_bf16(a0, qr[d0], p0, 0, 0, 0);
            p1 = __builtin_amdgcn_mfma_f32_32x32x16_bf16(a1, qr[d0], p1, 0, 0, 0); }
        float pmax = fmaxf(p0[0], p1[0]);
#pragma unroll
        for (int r = 1; r < 16; ++r) pmax = fmaxf(pmax, fmaxf(p0[r], p1[r]));
        pmax = swap_max(pmax);
        const float mn = fmaxf(m, pmax), alpha = __builtin_amdgcn_exp2f(m - mn); m = mn;
        float ps = 0.f;
#pragma unroll
        for (int r = 0; r < 16; ++r) { p0[r] = __builtin_amdgcn_exp2f(p0[r] - mn); p1[r] = __builtin_amdgcn_exp2f(p1[r] - mn); ps += p0[r] + p1[r]; }
        ps = swap_add(ps);
        l = l * alpha + ps;
        if (hi == 0) wsf[r32] = alpha;
#pragma unroll
        for (int r = 0; r < 16; ++r) { const float a = wsf[crow(r, hi)]; o0[r] *= a; o1[r] *= a; }
        bf16x8 pa0, pa1, pa2, pa3;
        ATT_PK4(p0, 0, pa0); ATT_PK4(p0, 8, pa1); ATT_PK4(p1, 0, pa2); ATT_PK4(p1, 8, pa3);
        const LAS unsigned char* vb = lds + OFF_V + cur * VTILE + v_rd_base(lane);
#define ATT_VF(d0, ks) ({ const s16x4 lo_ = vtr(vb + (d0) * 512 + (ks) * 2048), hi_ = vtr(vb + (d0) * 512 + (ks) * 2048 + 1024); (bf16x8){lo_[0], lo_[1], lo_[2], lo_[3], hi_[0], hi_[1], hi_[2], hi_[3]}; })
        o0 = __builtin_amdgcn_mfma_f32_32x32x16_bf16(pa0, ATT_VF(0, 0), o0, 0, 0, 0); o1 = __builtin_amdgcn_mfma_f32_32x32x16_bf16(pa0, ATT_VF(1, 0), o1, 0, 0, 0);
        o0 = __builtin_amdgcn_mfma_f32_32x32x16_bf16(pa1, ATT_VF(0, 1), o0, 0, 0, 0); o1 = __builtin_amdgcn_mfma_f32_32x32x16_bf16(pa1, ATT_VF(1, 1), o1, 0, 0, 0);
        o0 = __builtin_amdgcn_mfma_f32_32x32x16_bf16(pa2, ATT_VF(0, 2), o0, 0, 0, 0); o1 = __builtin_amdgcn_mfma_f32_32x32x16_bf16(pa2, ATT_VF(1, 2), o1, 0, 0, 0);
        o0 = __builtin_amdgcn_mfma_f32_32x32x16_bf16(pa3, ATT_VF(0, 3), o0, 0, 0, 0); o1 = __builtin_amdgcn_mfma_f32_32x32x16_bf16(pa3, ATT_VF(1, 3), o1, 0, 0, 0);
    }
    if (hi == 0) wsf[32 + r32] = l;
    bf16_t* op = O + (row0 + qb * 256 + wid * 32) * DM + h * VD + r32;
#pragma unroll
    for (int r = 0; r < 16; ++r) { const float rl = 1.0f / wsf[32 + crow(r, hi)]; const unsigned w = pk2(o0[r] * rl, o1[r] * rl);
        op[(size_t)crow(r, hi) * DM] = (bf16_t)(w & 0xffffu); op[(size_t)crow(r, hi) * DM + 32] = (bf16_t)(w >> 16); }
#undef ATT_LOAD
#undef ATT_WRITE
#undef ATT_VF
}
template <class F> __device__ __forceinline__ void for_units(int nunits, int vcu, int G, F f) {
    if (nunits % G == 0) { const int per = nunits / G; for (int i = 0; i < per; ++i) f(vcu * per + i); }
    else for (int u = vcu; u < nunits; u += G) f(u);
}
}
namespace att {
constexpr int DK_PITCH = 144, DROWS = 384;
constexpr int DOFF_K = 0, DOFF_V = DROWS * DK_PITCH  , DOFF_POS = DOFF_V + (DROWS / 16) * 2048  , DOFF_LUT = DOFF_POS + DROWS * 4  , DOFF_WS = DOFF_LUT + 4864  , DIL_LDS = DOFF_WS + 8 * 96 * 4;
static_assert(DIL_LDS <= 131072 && (DOFF_V % 16) == 0 && (DOFF_WS % 16) == 0, "dilated attention LDS map");
constexpr int LUT_R = 600;

__device__ __forceinline__ void dil_unit(const bf16_t* QKVG, const int* pos, const float* g_q, const float* g_k, const float* rel_bias, int g, bf16_t* O2, float* LSE, LAS unsigned char* lds, int b, int h, int j) {
    int tid_ = threadIdx.x; asm volatile("" : "+v"(tid_));
    const int tid = tid_, lane = tid & 63, r32 = lane & 31, hi = lane >> 5, wid = __builtin_amdgcn_readfirstlane(tid >> 6);
    const int lgD = 2 * g, lgL = 11 - lgD, Lm1 = (1 << lgL) - 1;
    const size_t row0 = (size_t)b * SEQ; const int u0 = 256 * j;
    LAS float* lut = (LAS float*)(lds + DOFF_LUT); LAS int* posk = (LAS int*)(lds + DOFF_POS);
    for (int idx = tid; idx <= 2 * LUT_R; idx += 512) lut[idx] = rel_bias[t5_bucket(idx - LUT_R) * 48 + g * 16 + h] * LOG2E;
    if (tid < DROWS) { const int u = u0 - 64 + tid; const bool ok = (u >= 0) && (u < SEQ); const int s = ((u & Lm1) << lgD) + (u >> lgL); posk[tid] = ok ? pos[row0 + s] : 0; }
    const int ch = tid & 7;
    float gk[8];
#pragma unroll
    for (int i = 0; i < 8; ++i) gk[i] = g_k[g * 64 + ch * 8 + i];
#pragma unroll
    for (int k = 0; k < 6; ++k) {
        const int i = (tid >> 3) + 64 * k; const int u = u0 - 64 + i; const bool ok = (u >= 0) && (u < SEQ);
        const int s = ((u & Lm1) << lgD) + (u >> lgL);
        const bf16_t* src = QKVG + (row0 + (ok ? s : 0)) * GCOLS + 1024 + h * 64 + ch * 8;
        u32x4 kw = *(const u32x4*)src, vw = *(const u32x4*)(src + 1024);
        float f[8]; unpack8(kw, f); float ss = 0.f;
#pragma unroll
        for (int e = 0; e < 8; ++e) ss += f[e] * f[e];
        ss += __shfl_xor(ss, 1); ss += __shfl_xor(ss, 2); ss += __shfl_xor(ss, 4);
        const float rs = 1.0f / sqrtf(ss * (1.0f / 64) + EPS);
#pragma unroll
        for (int e = 0; e < 8; ++e) f[e] *= rs * gk[e];
        kw = pack8(f);
        if (!ok) { kw = (u32x4){0u, 0u, 0u, 0u}; vw = kw; }
        *(LAS u32x4*)(lds + DOFF_K + i * DK_PITCH + ch * 16) = kw;
        *(LAS u32x4*)(lds + DOFF_V + (i >> 6) * 8192 + v_st<2>(i & 63, ch * 8)) = vw;
    }
    const int uq = u0 + 32 * wid + r32; const int sq = ((uq & Lm1) << lgD) + (uq >> lgL); const size_t grow = row0 + sq;
    const int posq = pos[grow];
    bf16x8 qr[4];
    {   float qf[4][8]; float ss = 0.f;
#pragma unroll
        for (int d0 = 0; d0 < 4; ++d0) { unpack8(*(const u32x4*)(QKVG + grow * GCOLS + h * 64 + 16 * d0 + 8 * hi), qf[d0]);
#pragma unroll
            for (int e = 0; e < 8; ++e) ss += qf[d0][e] * qf[d0][e]; }
        ss = swap_add(ss);
        const float rs = DIL_C2 / sqrtf(ss * (1.0f / 64) + EPS);
#pragma unroll
        for (int d0 = 0; d0 < 4; ++d0) {
#pragma unroll
            for (int e = 0; e < 8; ++e) qf[d0][e] *= rs * g_q[g * 64 + 16 * d0 + 8 * hi + e];
            qr[d0] = __builtin_bit_cast(bf16x8, pack8(qf[d0])); }
    }
    __syncthreads();
    f32x16 p[5];
    const int seqq = uq >> lgL;
#pragma unroll
    for (int ht = 0; ht < 5; ++ht) {
        const int i0 = 32 * (wid + ht);
#pragma unroll
        for (int r = 0; r < 16; ++r) p[ht][r] = 0.f;
        const LAS unsigned char* kb = lds + DOFF_K + (i0 + r32) * DK_PITCH + hi * 16;
#pragma unroll
        for (int d0 = 0; d0 < 4; ++d0) p[ht] = __builtin_amdgcn_mfma_f32_32x32x16_bf16(*(const LAS bf16x8*)(kb + d0 * 32), qr[d0], p[ht], 0, 0, 0);
#pragma unroll
        for (int r = 0; r < 16; ++r) { const int c = crow(r, hi), ik = i0 + c, uk = u0 - 64 + ik, delta = 32 * ht + c - 64 - r32;
            const bool valid = ((uk >> lgL) == seqq) && (delta >= -64) && (delta <= 64);
            int rel = posk[ik] - posq; rel = rel < -LUT_R ? -LUT_R : (rel > LUT_R ? LUT_R : rel);
            p[ht][r] = valid ? p[ht][r] + lut[rel + LUT_R] : -INFINITY; }
    }
    float mx = p[0][0];
#pragma unroll
    for (int ht = 0; ht < 5; ++ht)
#pragma unroll
        for (int r = 0; r < 16; ++r) mx = fmaxf(mx, p[ht][r]);
    mx = swap_max(mx);
    float l = 0.f;
#pragma unroll
    for (int ht = 0; ht < 5; ++ht)
#pragma unroll
        for (int r = 0; r < 16; ++r) { p[ht][r] = __builtin_amdgcn_exp2f(p[ht][r] - mx); l += p[ht][r]; }
    l = swap_add(l);
    f32x16 o0, o1;
#pragma unroll
    for (int r = 0; r < 16; ++r) { o0[r] = 0.f; o1[r] = 0.f; }
    const LAS unsigned char* vb = lds + DOFF_V + v_rd_base(lane);
#pragma unroll
    for (int ht = 0; ht < 5; ++ht) {
        bf16x8 pa0, pa1; ATT_PK4(p[ht], 0, pa0); ATT_PK4(p[ht], 8, pa1);
        const LAS unsigned char* vk = vb + 2 * (wid + ht) * 2048;
#define DIL_VF(d0, ks) ({ const s16x4 lo_ = vtr(vk + (d0) * 512 + (ks) * 2048), hi_ = vtr(vk + (d0) * 512 + (ks) * 2048 + 1024); (bf16x8){lo_[0], lo_[1], lo_[2], lo_[3], hi_[0], hi_[1], hi_[2], hi_[3]}; })
        o0 = __builtin_amdgcn_mfma_f32_32x32x16_bf16(pa0, DIL_VF(0, 0), o0, 0, 0, 0); o1 = __builtin_amdgcn_mfma_f32_32x32x16_bf16(pa0, DIL_VF(1, 0), o1, 0, 0, 0);
        o0 = __builtin_amdgcn_mfma_f32_32x32x16_bf16(pa1, DIL_VF(0, 1), o0, 0, 0, 0); o1 = __builtin_amdgcn_mfma_f32_32x32x16_bf16(pa1, DIL_VF(1, 1), o1, 0, 0, 0);
#undef DIL_VF
    }
    float lse = mx + log2f(l), wn = 1.0f / l, wo = 0.f;
    if (g > 0) { const float lo = LSE[grow * 16 + h]; const float mm = fmaxf(lo, lse); const float nl = mm + log2f(__builtin_amdgcn_exp2f(lo - mm) + __builtin_amdgcn_exp2f(lse - mm));
        wo = __builtin_amdgcn_exp2f(lo - nl); wn = __builtin_amdgcn_exp2f(lse - nl) / l; lse = nl; }
    LAS float* wsf = (LAS float*)(lds + DOFF_WS) + wid * 96;
    if (hi == 0) { LSE[grow * 16 + h] = lse; wsf[r32] = wn; wsf[32 + r32] = wo; ((LAS int*)wsf)[64 + r32] = (int)grow; }
#pragma unroll
    for (int r = 0; r < 16; ++r) { const int c = crow(r, hi); const float a = wsf[c], bo = wsf[32 + c]; const int gr = ((LAS int*)wsf)[64 + c];
        bf16_t* op = O2 + (size_t)gr * DM + h * 64 + r32;
        float v0 = o0[r] * a, v1 = o1[r] * a;
        if (g > 0) { v0 += bf2f(op[0]) * bo; v1 += bf2f(op[32]) * bo; }
        const unsigned w = pk2(v0, v1); op[0] = (bf16_t)(w & 0xffffu); op[32] = (bf16_t)(w >> 16); }
    __syncthreads();
}
}

__global__ void __launch_bounds__(256) naive_mla_attn(const bf16_t* Q, const bf16_t* KV, const bf16_t* KROPE, bf16_t* O) {
    __shared__ float Ks[32][QKD]; __shared__ float Vs[32][VD];
    const int tid = threadIdx.x, qb = blockIdx.x & 7, h = (blockIdx.x >> 3) & 15, b = blockIdx.x >> 7;
    const size_t m = (size_t)b * SEQ + qb * 256 + tid;
    float q[QKD];
#pragma unroll
    for (int c = 0; c < 12; ++c) { float f[8]; unpack8(*(const u32x4*)(Q + m * 1536 + h * QKD + 8 * c), f);
#pragma unroll
        for (int i = 0; i < 8; ++i) q[8 * c + i] = f[i]; }
    float o[VD];
#pragma unroll
    for (int i = 0; i < VD; ++i) o[i] = 0.f;
    float mx = -INFINITY, l = 0.f;
    for (int t = 0; t < SEQ / 32; ++t) {
        __syncthreads();
        {
            for (int c = tid; c < 640; c += 256) { const int key = c / 20, ch = c % 20; const size_t km = (size_t)b * SEQ + t * 32 + key; float f[8];
                if (ch < 8) { unpack8(*(const u32x4*)(KV + km * 2048 + h * 128 + 8 * ch), f);
#pragma unroll
                    for (int i = 0; i < 8; ++i) Ks[key][8 * ch + i] = f[i]; }
                else if (ch < 12) { unpack8(*(const u32x4*)(KROPE + km * 512 + h * 32 + 8 * (ch - 8)), f);
#pragma unroll
                    for (int i = 0; i < 8; ++i) Ks[key][NOPE + 8 * (ch - 8) + i] = f[i]; }
                else { unpack8(*(const u32x4*)(KV + km * 2048 + h * 128 + 64 + 8 * (ch - 12)), f);
#pragma unroll
                    for (int i = 0; i < 8; ++i) Vs[key][8 * (ch - 12) + i] = f[i]; } }
        }
        __syncthreads();
        for (int key = 0; key < 32; ++key) {
            float s = 0.f;
#pragma unroll
            for (int d = 0; d < QKD; d += 4) { const f32x4 kk = *(const f32x4*)&Ks[key][d]; s += q[d] * kk.x + q[d + 1] * kk.y + q[d + 2] * kk.z + q[d + 3] * kk.w; }
            if (s > mx) { const float al = exp2f(mx - s); l *= al;
#pragma unroll
                for (int i = 0; i < VD; ++i) o[i] *= al;
                mx = s; }
            const float p = exp2f(s - mx); l += p;
#pragma unroll
            for (int d = 0; d < VD; d += 4) { const f32x4 vv = *(const f32x4*)&Vs[key][d]; o[d] += p * vv.x; o[d + 1] += p * vv.y; o[d + 2] += p * vv.z; o[d + 3] += p * vv.w; }
        }
    }
    const float rl = 1.0f / l;
#pragma unroll
    for (int c = 0; c < 8; ++c) { float f[8];
#pragma unroll
        for (int i = 0; i < 8; ++i) f[i] = o[8 * c + i] * rl;
        *(u32x4*)(O + m * DM + h * VD + 8 * c) = pack8(f); }
}

__global__ void __launch_bounds__(256) naive_dil_attn(const bf16_t* QKVG, const int* pos, const float* g_q, const float* g_k, const float* rel_bias, int g, int dil, bf16_t* O2, float* LSE) {
    const int tid = threadIdx.x, sb = blockIdx.x & 7, h = (blockIdx.x >> 3) & 15, b = blockIdx.x >> 7;
    const int s = sb * 256 + tid; const size_t m = (size_t)b * SEQ + s;
    float q[64]; float ss = 0.f;
#pragma unroll
    for (int c = 0; c < 8; ++c) { float f[8]; unpack8(*(const u32x4*)(QKVG + m * GCOLS + h * 64 + 8 * c), f);
#pragma unroll
        for (int i = 0; i < 8; ++i) { q[8 * c + i] = f[i]; ss += f[i] * f[i]; } }
    const float rq = DIL_C2 / sqrtf(ss * (1.0f / 64) + EPS);
#pragma unroll
    for (int i = 0; i < 64; ++i) q[i] *= rq * g_q[g * 64 + i] * g_k[g * 64 + i];
    float o[64];
#pragma unroll
    for (int i = 0; i < 64; ++i) o[i] = 0.f;
    float mx = -INFINITY, l = 0.f; const int pq = pos[m];
    for (int j = -64; j <= 64; ++j) {
        const int sk = s + j * dil; if (sk < 0 || sk >= SEQ) continue;
        const size_t km = (size_t)b * SEQ + sk;
        float dot = 0.f, sk2 = 0.f;
#pragma unroll
        for (int c = 0; c < 8; ++c) { float f[8]; unpack8(*(const u32x4*)(QKVG + km * GCOLS + 1024 + h * 64 + 8 * c), f);
#pragma unroll
            for (int i = 0; i < 8; ++i) { dot += q[8 * c + i] * f[i]; sk2 += f[i] * f[i]; } }
        const float bias = rel_bias[t5_bucket(pos[km] - pq) * 48 + g * 16 + h] * LOG2E;
        const float sc = dot / sqrtf(sk2 * (1.0f / 64) + EPS) + bias;
        if (sc > mx) { const float al = exp2f(mx - sc); l *= al;
#pragma unroll
            for (int i = 0; i < 64; ++i) o[i] *= al;
            mx = sc; }
        const float p = exp2f(sc - mx); l += p;
#pragma unroll
        for (int c = 0; c < 8; ++c) { float f[8]; unpack8(*(const u32x4*)(QKVG + km * GCOLS + 2048 + h * 64 + 8 * c), f);
#pragma unroll
            for (int i = 0; i < 8; ++i) o[8 * c + i] += p * f[i]; }
    }
    float lse = mx + log2f(l); float wn = 1.0f / l, wo = 0.f;
    if (g > 0) { const float lo = LSE[m * 16 + h]; const float mm = fmaxf(lo, lse); const float ea = exp2f(lo - mm), eb = exp2f(lse - mm); const float nl = mm + log2f(ea + eb);
        wo = exp2f(lo - nl); wn = exp2f(lse - nl) / l; lse = nl; }
    LSE[m * 16 + h] = lse;
#pragma unroll
    for (int c = 0; c < 8; ++c) { float f[8], old[8];
        if (g > 0) unpack8(*(const u32x4*)(O2 + m * DM + h * 64 + 8 * c), old);
#pragma unroll
        for (int i = 0; i < 8; ++i) f[i] = o[8 * c + i] * wn + (g > 0 ? old[i] * wo : 0.f);
        *(u32x4*)(O2 + m * DM + h * 64 + 8 * c) = pack8(f); }
}
constexpr int NWAVES = 8;
constexpr int RING_BYTES = 131072;
constexpr int LDSCTL_OFF = RING_BYTES, MISC_OFF = LDSCTL_OFF + 320;
constexpr int LDS_BYTES = 147456;
constexpr int CW_BAR = 4096;
constexpr size_t CTL_ZERO_BYTES = 256 * 1024;
static_assert((CW_BAR + 12 * XCD_BAR_WORDS) * 4 <= (int)CTL_ZERO_BYTES, "barrier words inside the memset region");

template <class E> struct EpiAd {
    static constexpr bool PERM = (E::NV == 8), AFTER_DRAIN = false; E e;
    __device__ __forceinline__ void operator()(const pg8::f32x4 (&acc)[2][2][4][2], const pg8::Unit& u, int wr, int wc, int fr, int fq) const {
#pragma unroll
        for (int ai = 0; ai < 2; ++ai)
#pragma unroll
            for (int m = 0; m < 4; ++m) { const int row = u.pm * 256 + ai * 128 + wr * 64 + m * 16 + fr;
#pragma unroll
                for (int bj = 0; bj < 2; ++bj) {
                    if constexpr (PERM) { const int col = u.pn * 256 + bj * 128 + wc * 32 + 8 * fq;
                        const float v[8] = {acc[ai][bj][m][0][0], acc[ai][bj][m][0][1], acc[ai][bj][m][0][2], acc[ai][bj][m][0][3], acc[ai][bj][m][1][0], acc[ai][bj][m][1][1], acc[ai][bj][m][1][2], acc[ai][bj][m][1][3]};
                        e.store(row, col, v); }
                    else {
#pragma unroll
                        for (int n = 0; n < 2; ++n) { const int col = u.pn * 256 + bj * 128 + wc * 32 + 16 * n + 4 * fq;
                            const float v[4] = {acc[ai][bj][m][n][0], acc[ai][bj][m][n][1], acc[ai][bj][m][n][2], acc[ai][bj][m][n][3]};
                            e.store(row, col, v); } } }
                if (m & 1) asm volatile("" ::: "memory"); }
    }
};
template <class E> __device__ __forceinline__ void run_gemm(LAS unsigned char* lds, const void* A, const void* Bt, int N, int K, const E& e) {
    pg8::Gemm g{(const bf16_t*)A, (const bf16_t*)Bt, MTOK, N, K}; pg8::StaticOrder S; S.init(MTOK, N, (int)gridDim.x, (int)blockIdx.x);
    EpiAd<E> ad{e};
    pg8::gemm_phase<EpiAd<E>, pg8::StaticOrder, true, true>(lds, g, S, ad);
}

struct Args { Ptrs P; int ph_lo, ph_hi, li, pad; };
__device__ __forceinline__ const Ptrs& kargs() { const Ptrs* p = (const Ptrs*)__builtin_amdgcn_kernarg_segment_ptr(); asm volatile("" : "+s"(p)); return *p; }
#define KA kargs()
#define MOD0 ((const float*)(KA.ws + WS_MOD))
#define MOD1 (MOD0 + 8 * MODW)
#define HB ((bf16_t*)(KA.ws + WS_H))
constexpr int NPHASE = 22;
#ifndef HYBRID
#define HYBRID 0
#endif
__global__ void __launch_bounds__(NWAVES * 64, 2) mega_fwd(Args args) {
    extern __shared__ __attribute__((aligned(16))) unsigned char lds_raw[];
    LAS unsigned char* lds = (LAS unsigned char*)lds_raw;
    volatile LAS unsigned* MISC = (volatile LAS unsigned*)(lds + MISC_OFF);
    const int tid = threadIdx.x, lane = tid & 63, wave = __builtin_amdgcn_readfirstlane(tid >> 6);
    const int G = gridDim.x, bx = blockIdx.x, gw = bx * NWAVES + wave, ngw = G * NWAVES;
    const int vcu = (G % 8 == 0) ? (bx % 8) * (G / 8) + bx / 8 : bx;
    for (int u = tid; u < (LDS_BYTES - LDSCTL_OFF) / 4; u += NWAVES * 64) ((LAS unsigned*)(lds + LDSCTL_OFF))[u] = 0u;
    __syncthreads();
    XcdBarrier bar = xcd_barrier_post((unsigned*)(args.P.ws + WS_CTL) + CW_BAR + args.li * XCD_BAR_WORDS, MISC + 8);
    const int lo = args.ph_lo, hi = args.ph_hi;
#define IN(k) (lo <= (k) && (k) < hi)
#define SEAM(k) do { if (IN(k) && IN((k) + 1)) xcd_barrier(bar); } while (0)

    if (IN(0)) {
        p0_weights(KA, (LAS float*)lds + wave * (64 * 33), gw, ngw, lane);
        p0_cs(KA, bx * 512 + tid, G * 512);
        __syncthreads();
        p0_mod(KA, (LAS float*)lds, bx, G, tid, NWAVES);
    }
    SEAM(0);
    if (IN(1)) lnmod_rows(KA.x, KA.norm_mix, MOD0, 0, 1, HB, gw, ngw, lane);
    SEAM(1);
    if (IN(2)) run_gemm(lds, KA.ws + WS_H, KA.ws + WS_WIN0, MLA_INP, DM, EpiF32{(float*)(KA.ws + WS_PROJ), MLA_INP, 0});
    SEAM(2);
    if (IN(3)) mla_prep_rows(KA, gw, ngw, lane);
    SEAM(3);
    if (IN(4)) {
        run_gemm(lds, KA.ws + WS_QA, KA.ws + WS_WQB, 1536, QLORA, EpiBf16{(bf16_t*)(KA.ws + WS_Q), 1536, 0});
        run_gemm(lds, KA.ws + WS_KVA, KA.ws + WS_WKVB, 2048, KVLORA, EpiBf16{(bf16_t*)(KA.ws + WS_KV), 2048, 0});
    }
    SEAM(4);
    if (IN(5)) mla_final_rows(KA, gw, ngw, lane);
    SEAM(5);
    if (IN(6)) att::for_units(NBATCH * NH * 8, vcu, G, [&](int u) { att::mla_unit((const bf16_t*)(KA.ws + WS_Q), (const bf16_t*)(KA.ws + WS_KV), (const bf16_t*)(KA.ws + WS_KROPE), HB, lds, u >> 7, (u >> 3) & 15, u & 7); });
    SEAM(6);
    if (IN(7)) run_gemm(lds, KA.ws + WS_H, KA.ws + WS_WO0, DM, DM, EpiResGate{KA.x, KA.out, MOD0 + 2 * DM});
    SEAM(7);
    if (IN(8)) lnmod_rows(KA.out, KA.norm_mlp, MOD0, 3, 4, HB, gw, ngw, lane);
    SEAM(8);
    if (IN(9)) run_gemm(lds, KA.ws + WS_H, KA.ws + WS_W1_0, DFF, DM, EpiSqRelu{(bf16_t*)(KA.ws + WS_U), DFF, 0});
    SEAM(9);
    if (IN(10)) run_gemm(lds, KA.ws + WS_U, KA.ws + WS_W2_0, DM, DFF, EpiResGate{KA.out, KA.out, MOD0 + 5 * DM});
    SEAM(10);
    if (IN(11)) lnmod_rows(KA.out, KA.norm_mix + DM, MOD1, 0, 1, HB, gw, ngw, lane);
    SEAM(11);
#pragma unroll 1
    for (int g = 0; g < 3; ++g) {
        if (IN(12 + 2 * g)) run_gemm(lds, KA.ws + WS_H, KA.ws + WS_WIN1 + (size_t)g * GCOLS * DM * 2, GCOLS, DM, EpiBf16{(bf16_t*)(KA.ws + WS_QKVG), GCOLS, 0});
        SEAM(12 + 2 * g);
        if (IN(13 + 2 * g)) att::for_units(NBATCH * NH * 8, vcu, G, [&](int u) { att::dil_unit((const bf16_t*)(KA.ws + WS_QKVG), KA.pos, KA.dil_g_q, KA.dil_g_k, KA.rel_bias, g, (bf16_t*)(KA.ws + WS_O2), (float*)(KA.ws + WS_LSE), lds, u >> 7, (u >> 3) & 15, u & 7); });
        SEAM(13 + 2 * g);
    }
    if (IN(18)) run_gemm(lds, KA.ws + WS_O2, KA.ws + WS_WO1, DM, DM, EpiResGate{KA.out, KA.out, MOD1 + 2 * DM});
    SEAM(18);
    if (IN(19)) lnmod_rows(KA.out, KA.norm_mlp + DM, MOD1, 3, 4, HB, gw, ngw, lane);
    SEAM(19);
    if (IN(20)) run_gemm(lds, KA.ws + WS_H, KA.ws + WS_W1_1, DFF, DM, EpiSqRelu{(bf16_t*)(KA.ws + WS_U), DFF, 0});
    SEAM(20);
    if (IN(21)) run_gemm(lds, KA.ws + WS_U, KA.ws + WS_W2_1, DM, DFF, EpiResGate{KA.out, KA.out, MOD1 + 5 * DM});
#undef IN
#undef SEAM
}

extern "C" void kernel_launch(void* const* d_in, const int* in_sizes, int n_in, void* d_out, int out_size, void* d_ws, size_t ws_size, hipStream_t stream) {
    static int grid = 0;
    if (grid == 0) {
        if (n_in != 22 || ws_size < WS_END || out_size != MTOK * DM) { fprintf(stderr, "kernel_launch: unexpected n_in %d / ws %zu / out %d\n", n_in, ws_size, out_size); grid = -1; return; }
        int dev = 0, cus = 0, per_cu = 0;
        if (hipGetDevice(&dev) != hipSuccess || hipDeviceGetAttribute(&cus, hipDeviceAttributeMultiprocessorCount, dev) != hipSuccess) { grid = -1; return; }
        if (hipFuncSetAttribute((const void*)mega_fwd, hipFuncAttributeMaxDynamicSharedMemorySize, LDS_BYTES) != hipSuccess) { fprintf(stderr, "kernel_launch: hipFuncSetAttribute failed\n"); grid = -1; return; }
        if (hipOccupancyMaxActiveBlocksPerMultiprocessor(&per_cu, (const void*)mega_fwd, NWAVES * 64, LDS_BYTES) != hipSuccess || per_cu < 1) { fprintf(stderr, "kernel_launch: occupancy query says %d blocks per CU\n", per_cu); (void)hipGetLastError(); grid = -1; return; }
        if (per_cu > 1) per_cu = 1;
        grid = cus * per_cu;
    }
    if (grid < 0) return;
    if (hipMemsetAsync((char*)d_ws + WS_CTL, 0, CTL_ZERO_BYTES, stream) != hipSuccess) return;
    Args a{};
    Ptrs& P = a.P;
    P.x = (const float*)d_in[0]; P.c = (const float*)d_in[1]; P.pos = (const int*)d_in[2]; P.ada_w = (const float*)d_in[3]; P.ada_b = (const float*)d_in[4];
    P.norm_mix = (const float*)d_in[5]; P.norm_mlp = (const float*)d_in[6]; P.mlp_w1 = (const float*)d_in[7]; P.mlp_w2 = (const float*)d_in[8];
    P.mla_w_in = (const float*)d_in[9]; P.mla_g_qa = (const float*)d_in[10]; P.mla_w_qb = (const float*)d_in[11]; P.mla_g_kva = (const float*)d_in[12];
    P.mla_w_kvb = (const float*)d_in[13]; P.mla_g_q = (const float*)d_in[14]; P.mla_g_k = (const float*)d_in[15]; P.mla_w_o = (const float*)d_in[16];
    P.dil_w_in = (const float*)d_in[17]; P.dil_g_q = (const float*)d_in[18]; P.dil_g_k = (const float*)d_in[19]; P.dil_w_o = (const float*)d_in[20]; P.rel_bias = (const float*)d_in[21];
    P.out = (float*)d_out; P.ws = (unsigned char*)d_ws;
    unsigned char* ws = P.ws;
    int li = 0;
    auto launch = [&](int lo, int hi) { a.ph_lo = lo; a.ph_hi = hi; a.li = li++; hipLaunchKernelGGL(mega_fwd, dim3(grid), dim3(NWAVES * 64), LDS_BYTES, stream, a); };
#if HYBRID
#if HYBRID == 1
    launch(0, 6);
    naive_mla_attn<<<NBATCH * NH * 8, 256, 0, stream>>>((const bf16_t*)(ws + WS_Q), (const bf16_t*)(ws + WS_KV), (const bf16_t*)(ws + WS_KROPE), (bf16_t*)(ws + WS_H));
    launch(7, 13);
#else
    launch(0, 13);
#endif
    naive_dil_attn<<<NBATCH * NH * 8, 256, 0, stream>>>((const bf16_t*)(ws + WS_QKVG), P.pos, P.dil_g_q, P.dil_g_k, P.rel_bias, 0, 1, (bf16_t*)(ws + WS_O2), (float*)(ws + WS_LSE));
    launch(14, 15);
    naive_dil_attn<<<NBATCH * NH * 8, 256, 0, stream>>>((const bf16_t*)(ws + WS_QKVG), P.pos, P.dil_g_q, P.dil_g_k, P.rel_bias, 1, 4, (bf16_t*)(ws + WS_O2), (float*)(ws + WS_LSE));
    launch(16, 17);
    naive_dil_attn<<<NBATCH * NH * 8, 256, 0, stream>>>((const bf16_t*)(ws + WS_QKVG), P.pos, P.dil_g_q, P.dil_g_k, P.rel_bias, 2, 16, (bf16_t*)(ws + WS_O2), (float*)(ws + WS_LSE));
    launch(18, 22);
#else
    launch(0, NPHASE);
#endif
}
```

```cpp
#include <hip/hip_runtime.h>
#include <cstdint>
#include <cstdio>

#define LAS __attribute__((address_space(3)))
typedef unsigned short bf16_t;
typedef float f32x4 __attribute__((ext_vector_type(4)));
typedef float f32x2 __attribute__((ext_vector_type(2)));
typedef unsigned u32x4 __attribute__((ext_vector_type(4)));
typedef unsigned u32x2 __attribute__((ext_vector_type(2)));
typedef __bf16 bf16x2_t __attribute__((ext_vector_type(2)));

constexpr int DM = 1024, NBATCH = 8, SEQ = 2048, MTOK = NBATCH * SEQ;
constexpr int DFF = 4096, MODW = 6 * DM;
constexpr int QLORA = 384, KVLORA = 256, ROPE = 32, MLA_IN = 672, MLA_INP = 768;
constexpr int NH = 16, QKD = 96, NOPE = 64, VD = 64;
constexpr int DIL_IN = 9216, GCOLS = 3072, NBKT = 32;
constexpr float EPS = 1e-6f;
constexpr float LOG2E = 1.4426950408889634f;
constexpr float MLA_C2 = 0.10206207261596575f * LOG2E;
constexpr float DIL_C2 = 0.125f * LOG2E;

constexpr size_t MiB = 1u << 20;
constexpr size_t WS_CTL = 0, WS_MOD = 1 * MiB, WS_CS = 2 * MiB;
constexpr size_t WS_WIN0 = 4 * MiB, WS_WQB = 5 * MiB + 512 * 1024, WS_WKVB = 7 * MiB, WS_WO0 = 8 * MiB, WS_W1_0 = 10 * MiB, WS_W2_0 = 18 * MiB;
constexpr size_t WS_WIN1 = 26 * MiB, WS_WO1 = 44 * MiB, WS_W1_1 = 46 * MiB, WS_W2_1 = 54 * MiB;
constexpr size_t WS_H = 64 * MiB;
constexpr size_t WS_R = 96 * MiB;
constexpr size_t WS_PROJ = WS_R;
constexpr size_t WS_Q = WS_R;
constexpr size_t WS_KV = WS_R + 48 * MiB;
constexpr size_t WS_KROPE = WS_R + 112 * MiB;
constexpr size_t WS_QA = WS_R + 128 * MiB;
constexpr size_t WS_KVA = WS_R + 140 * MiB;
constexpr size_t WS_KR = WS_R + 148 * MiB;
constexpr size_t WS_U = WS_R;
constexpr size_t WS_QKVG = WS_R;
constexpr size_t WS_O2 = WS_R + 96 * MiB;
constexpr size_t WS_LSE = WS_R + 128 * MiB;
constexpr size_t WS_END = 256 * MiB;

__device__ __forceinline__ float bf2f(unsigned h) { return __uint_as_float(h << 16); }
__device__ __forceinline__ unsigned pk2(float lo, float hi) { f32x2 v = {lo, hi}; bf16x2_t b = __builtin_convertvector(v, bf16x2_t); return __builtin_bit_cast(unsigned, b); }
__device__ __forceinline__ float wave_sum(float v) {
#pragma unroll
    for (int o = 1; o < 64; o <<= 1) v += __shfl_xor(v, o);
    return v;
}
__device__ __forceinline__ void unpack8(u32x4 w, float (&f)[8]) {
    f[0] = bf2f(w.x & 0xffffu); f[1] = bf2f(w.x >> 16); f[2] = bf2f(w.y & 0xffffu); f[3] = bf2f(w.y >> 16);
    f[4] = bf2f(w.z & 0xffffu); f[5] = bf2f(w.z >> 16); f[6] = bf2f(w.w & 0xffffu); f[7] = bf2f(w.w >> 16);
}
__device__ __forceinline__ u32x4 pack8(const float (&f)[8]) { u32x4 w; w.x = pk2(f[0], f[1]); w.y = pk2(f[2], f[3]); w.z = pk2(f[4], f[5]); w.w = pk2(f[6], f[7]); return w; }
#define LDS_WAIT() asm volatile("s_waitcnt lgkmcnt(0)" ::: "memory")

__device__ __forceinline__ int t5_bucket(int rel) {
    const int n = rel < 0 ? -rel : rel;
    int b = n;
    if (n >= 8) b = 8 + (n >= 15) + (n >= 27) + (n >= 50) + (n >= 91) + (n >= 166) + (n >= 305) + (n >= 559);
    return b + (rel > 0 ? 16 : 0);
}

__device__ __forceinline__ void transpose_item(const float* W, int K, int ldn, int N, bf16_t* WT, int row_off, LAS float* scr, int item, int lane) {
    const int nblk = N / 32, kb = item / nblk, nb = item % nblk, k0 = 64 * kb, n0 = 32 * nb;
#pragma unroll 8
    for (int i = 0; i < 32; ++i) { const int kk = 2 * i + (lane >> 5); scr[kk * 33 + (lane & 31)] = W[(size_t)(k0 + kk) * ldn + n0 + (lane & 31)]; }
    LDS_WAIT();
    const int c = lane & 7;
#pragma unroll
    for (int j = 0; j < 4; ++j) { const int n = (lane >> 3) + 8 * j; const LAS float* s = scr + (8 * c) * 33 + n;
        u32x4 o; o.x = pk2(s[0 * 33], s[1 * 33]); o.y = pk2(s[2 * 33], s[3 * 33]); o.z = pk2(s[4 * 33], s[5 * 33]); o.w = pk2(s[6 * 33], s[7 * 33]);
        *(u32x4*)(WT + (size_t)(row_off + n0 + n) * K + k0 + 8 * c) = o; }
    LDS_WAIT();
}

struct Ptrs {
    const float *x, *c; const int* pos; const float *ada_w, *ada_b, *norm_mix, *norm_mlp, *mlp_w1, *mlp_w2;
    const float *mla_w_in, *mla_g_qa, *mla_w_qb, *mla_g_kva, *mla_w_kvb, *mla_g_q, *mla_g_k, *mla_w_o;
    const float *dil_w_in, *dil_g_q, *dil_g_k, *dil_w_o, *rel_bias;
    float* out; unsigned char* ws;
};

__device__ __forceinline__ void p0_weights(const Ptrs& P, LAS float* scr, int gw, int ngw, int lane) {
    unsigned char* ws = P.ws;
    constexpr int I_IN0 = (DM / 64) * (MLA_IN / 32), I_QB = (QLORA / 64) * (1536 / 32), I_KVB = (KVLORA / 64) * (2048 / 32), I_O = (DM / 64) * (DM / 32);
    constexpr int I_1 = (DM / 64) * (DFF / 32), I_2 = (DFF / 64) * (DM / 32), I_IN1 = (DM / 64) * (DIL_IN / 32);
    constexpr int NITEMS = I_IN0 + I_QB + I_KVB + I_O + 2 * I_1 + 2 * I_2 + I_IN1 + I_O;
    for (int it = gw; it < NITEMS; it += ngw) {
        int r = it;
        if (r < I_IN0) { transpose_item(P.mla_w_in, DM, MLA_IN, MLA_IN, (bf16_t*)(ws + WS_WIN0), 0, scr, r, lane); continue; } r -= I_IN0;
        if (r < I_QB) { transpose_item(P.mla_w_qb, QLORA, 1536, 1536, (bf16_t*)(ws + WS_WQB), 0, scr, r, lane); continue; } r -= I_QB;
        if (r < I_KVB) { transpose_item(P.mla_w_kvb, KVLORA, 2048, 2048, (bf16_t*)(ws + WS_WKVB), 0, scr, r, lane); continue; } r -= I_KVB;
        if (r < I_O) { transpose_item(P.mla_w_o, DM, DM, DM, (bf16_t*)(ws + WS_WO0), 0, scr, r, lane); continue; } r -= I_O;
        if (r < I_1) { transpose_item(P.mlp_w1, DM, DFF, DFF, (bf16_t*)(ws + WS_W1_0), 0, scr, r, lane); continue; } r -= I_1;
        if (r < I_1) { transpose_item(P.mlp_w1 + (size_t)DM * DFF, DM, DFF, DFF, (bf16_t*)(ws + WS_W1_1), 0, scr, r, lane); continue; } r -= I_1;
        if (r < I_2) { transpose_item(P.mlp_w2, DFF, DM, DM, (bf16_t*)(ws + WS_W2_0), 0, scr, r, lane); continue; } r -= I_2;
        if (r < I_2) { transpose_item(P.mlp_w2 + (size_t)DFF * DM, DFF, DM, DM, (bf16_t*)(ws + WS_W2_1), 0, scr, r, lane); continue; } r -= I_2;
        if (r < I_IN1) { transpose_item(P.dil_w_in, DM, DIL_IN, DIL_IN, (bf16_t*)(ws + WS_WIN1), 0, scr, r, lane); continue; } r -= I_IN1;
        transpose_item(P.dil_w_o, DM, DM, DM, (bf16_t*)(ws + WS_WO1), 0, scr, r, lane);
    }
    u32x4* z = (u32x4*)(ws + WS_WIN0 + (size_t)MLA_IN * DM * 2);
    for (int i = gw * 64 + lane; i < 12288; i += ngw * 64) z[i] = (u32x4){0u, 0u, 0u, 0u};
}
__device__ __forceinline__ void p0_cs(const Ptrs& P, int gtid, int nthr) {
    float* cs = (float*)(P.ws + WS_CS);
    for (int i = gtid; i < MTOK * 16; i += nthr) { const int m = i >> 4, f = i & 15;
        const float inv = 1.0f / powf(10000.0f, (float)f * 0.0625f); const float ang = (float)P.pos[m] * inv;
        cs[m * 32 + f] = cosf(ang); cs[m * 32 + 16 + f] = sinf(ang); }
}
__device__ __forceinline__ void p0_mod(const Ptrs& P, LAS float* lds, int bid, int nblk, int tid, int nwaves) {
    LAS float* cond = lds; LAS float* red = lds + 8 * DM;
    float* mod = (float*)(P.ws + WS_MOD);
    for (int i = tid; i < 8 * DM; i += nwaves * 64) { const float v = P.c[i]; cond[i] = v / (1.0f + expf(-v)); }
    __syncthreads();
    const int w = tid >> 6, lane = tid & 63, col = lane & 31, kp = lane >> 5, kper = DM / nwaves;
    for (int item = bid; item < 2 * (MODW / 32); item += nblk) {
        const int l = item / (MODW / 32), n0 = (item % (MODW / 32)) * 32;
        float acc[8];
#pragma unroll
        for (int b = 0; b < 8; ++b) acc[b] = 0.f;
        const float* wp = P.ada_w + (size_t)l * DM * MODW + n0 + col;
#pragma unroll 8
        for (int kk = 0; kk < kper / 2; ++kk) { const int k = w * kper + 2 * kk + kp; const float wv = wp[(size_t)k * MODW];
#pragma unroll
            for (int b = 0; b < 8; ++b) acc[b] += cond[b * DM + k] * wv; }
#pragma unroll
        for (int b = 0; b < 8; ++b) { acc[b] += __shfl_xor(acc[b], 32); if (lane < 32) red[(w * 8 + b) * 32 + col] = acc[b]; }
        __syncthreads();
        if (tid < 256) { const int b = tid >> 5, cc = tid & 31; float s = P.ada_b[l * MODW + n0 + cc];
            for (int ww = 0; ww < nwaves; ++ww) s += red[(ww * 8 + b) * 32 + cc];
            mod[(size_t)(l * 8 + b) * MODW + n0 + cc] = s; }
        __syncthreads();
    }
}
__device__ __forceinline__ void lnmod_rows(const float* X, const float* g, const float* modl  , int shift_idx, int scale_idx, bf16_t* H, int gw, int ngw, int lane) {
    for (int m = gw; m < MTOK; m += ngw) {
        const f32x4* xr = (const f32x4*)(X + (size_t)m * DM) + lane;
        f32x4 v[4]; float ss = 0.f;
#pragma unroll
        for (int j = 0; j < 4; ++j) { v[j] = xr[64 * j]; ss += (v[j].x * v[j].x + v[j].y * v[j].y) + (v[j].z * v[j].z + v[j].w * v[j].w); }
        const float rstd = 1.0f / sqrtf(wave_sum(ss) * (1.0f / DM) + EPS);
        const float* mb = modl + (size_t)(m / SEQ) * MODW;
        u32x2* o = (u32x2*)(H + (size_t)m * DM) + lane;
#pragma unroll
        for (int j = 0; j < 4; ++j) { const int col = 4 * (lane + 64 * j);
            const f32x4 gg = *(const f32x4*)(g + col), sc = *(const f32x4*)(mb + scale_idx * DM + col), sh = *(const f32x4*)(mb + shift_idx * DM + col);
            const f32x4 y = v[j] * rstd * gg * (sc + 1.0f) + sh;
            u32x2 w; w.x = pk2(y.x, y.y); w.y = pk2(y.z, y.w); o[64 * j] = w; }
    }
}
__device__ __forceinline__ void mla_prep_rows(const Ptrs& P, int gw, int ngw, int lane) {
    const float* PROJ = (const float*)(P.ws + WS_PROJ); const float* cs = (const float*)(P.ws + WS_CS);
    bf16_t* QA = (bf16_t*)(P.ws + WS_QA); bf16_t* KVA = (bf16_t*)(P.ws + WS_KVA); float* KR = (float*)(P.ws + WS_KR);
    for (int m = gw; m < MTOK; m += ngw) {
        const float* p = PROJ + (size_t)m * MLA_INP;
        float q[8]; float ss = 0.f;
        if (lane < 48) { const f32x4 a = *(const f32x4*)(p + 8 * lane), b = *(const f32x4*)(p + 8 * lane + 4);
            q[0] = a.x; q[1] = a.y; q[2] = a.z; q[3] = a.w; q[4] = b.x; q[5] = b.y; q[6] = b.z; q[7] = b.w;
#pragma unroll
            for (int i = 0; i < 8; ++i) ss += q[i] * q[i]; }
        else {
#pragma unroll
            for (int i = 0; i < 8; ++i) q[i] = 0.f; }
        const float rq = 1.0f / sqrtf(wave_sum(ss) * (1.0f / QLORA) + EPS);
        if (lane < 48) { float o[8];
#pragma unroll
            for (int i = 0; i < 8; ++i) o[i] = q[i] * rq * P.mla_g_qa[8 * lane + i];
            *(u32x4*)(QA + (size_t)m * QLORA + 8 * lane) = pack8(o); }
        float kv[8]; float s2 = 0.f;
        if (lane < 32) { const f32x4 a = *(const f32x4*)(p + QLORA + 8 * lane), b = *(const f32x4*)(p + QLORA + 8 * lane + 4);
            kv[0] = a.x; kv[1] = a.y; kv[2] = a.z; kv[3] = a.w; kv[4] = b.x; kv[5] = b.y; kv[6] = b.z; kv[7] = b.w;
#pragma unroll
            for (int i = 0; i < 8; ++i) s2 += kv[i] * kv[i]; }
        else {
#pragma unroll
            for (int i = 0; i < 8; ++i) kv[i] = 0.f; }
        const float rk = 1.0f / sqrtf(wave_sum(s2) * (1.0f / KVLORA) + EPS);
        if (lane < 32) { float o[8];
#pragma unroll
            for (int i = 0; i < 8; ++i) o[i] = kv[i] * rk * P.mla_g_kva[8 * lane + i];
            *(u32x4*)(KVA + (size_t)m * KVLORA + 8 * lane) = pack8(o); }
        if (lane < 16) { const float x1 = p[QLORA + KVLORA + lane], x2 = p[QLORA + KVLORA + 16 + lane]; const float c = cs[m * 32 + lane], s = cs[m * 32 + 16 + lane];
            KR[m * 32 + lane] = x1 * c - x2 * s; KR[m * 32 + 16 + lane] = x2 * c + x1 * s; }
    }
}
__device__ __forceinline__ void mla_final_rows(const Ptrs& P, int gw, int ngw, int lane) {
    const float* cs = (const float*)(P.ws + WS_CS); const float* KR = (const float*)(P.ws + WS_KR);
    bf16_t* Q = (bf16_t*)(P.ws + WS_Q); bf16_t* KV = (bf16_t*)(P.ws + WS_KV); bf16_t* KROPE = (bf16_t*)(P.ws + WS_KROPE);
    const int h = lane >> 2, sub = lane & 3;
    for (int m = gw; m < MTOK; m += ngw) {
        float c4[4], s4[4];
#pragma unroll
        for (int t = 0; t < 4; ++t) { c4[t] = cs[m * 32 + 4 * sub + t]; s4[t] = cs[m * 32 + 16 + 4 * sub + t]; }
        {
            bf16_t* qb = Q + (size_t)m * 1536 + h * QKD;
            float a[8], b[8]; unpack8(*(const u32x4*)(qb + 16 * sub), a); unpack8(*(const u32x4*)(qb + 16 * sub + 8), b);
            const u32x2 w1 = *(const u32x2*)(qb + NOPE + 4 * sub), w2 = *(const u32x2*)(qb + NOPE + 16 + 4 * sub);
            const float r1[4] = {bf2f(w1.x & 0xffffu), bf2f(w1.x >> 16), bf2f(w1.y & 0xffffu), bf2f(w1.y >> 16)};
            const float r2[4] = {bf2f(w2.x & 0xffffu), bf2f(w2.x >> 16), bf2f(w2.y & 0xffffu), bf2f(w2.y >> 16)};
            float y1[4], y2[4]; float ss = 0.f;
#pragma unroll
            for (int t = 0; t < 4; ++t) { y1[t] = r1[t] * c4[t] - r2[t] * s4[t]; y2[t] = r2[t] * c4[t] + r1[t] * s4[t]; ss += y1[t] * y1[t] + y2[t] * y2[t]; }
#pragma unroll
            for (int i = 0; i < 8; ++i) ss += a[i] * a[i] + b[i] * b[i];
            ss += __shfl_xor(ss, 1); ss += __shfl_xor(ss, 2);
            const float rs = MLA_C2 / sqrtf(ss * (1.0f / QKD) + EPS);
#pragma unroll
            for (int i = 0; i < 8; ++i) { a[i] *= rs * P.mla_g_q[16 * sub + i]; b[i] *= rs * P.mla_g_q[16 * sub + 8 + i]; }
#pragma unroll
            for (int t = 0; t < 4; ++t) { y1[t] *= rs * P.mla_g_q[NOPE + 4 * sub + t]; y2[t] *= rs * P.mla_g_q[NOPE + 16 + 4 * sub + t]; }
            *(u32x4*)(qb + 16 * sub) = pack8(a); *(u32x4*)(qb + 16 * sub + 8) = pack8(b);
            u32x2 o1, o2; o1.x = pk2(y1[0], y1[1]); o1.y = pk2(y1[2], y1[3]); o2.x = pk2(y2[0], y2[1]); o2.y = pk2(y2[2], y2[3]);
            *(u32x2*)(qb + NOPE + 4 * sub) = o1; *(u32x2*)(qb + NOPE + 16 + 4 * sub) = o2;
        }
        {
            bf16_t* kb = KV + (size_t)m * 2048 + h * 128;
            float a[8], b[8]; unpack8(*(const u32x4*)(kb + 16 * sub), a); unpack8(*(const u32x4*)(kb + 16 * sub + 8), b);
            const f32x4 k1 = *(const f32x4*)(KR + m * 32 + 4 * sub), k2 = *(const f32x4*)(KR + m * 32 + 16 + 4 * sub);
            float ss = (k1.x * k1.x + k1.y * k1.y) + (k1.z * k1.z + k1.w * k1.w) + (k2.x * k2.x + k2.y * k2.y) + (k2.z * k2.z + k2.w * k2.w);
#pragma unroll
            for (int i = 0; i < 8; ++i) ss += a[i] * a[i] + b[i] * b[i];
            ss += __shfl_xor(ss, 1); ss += __shfl_xor(ss, 2);
            const float rs = 1.0f / sqrtf(ss * (1.0f / QKD) + EPS);
#pragma unroll
            for (int i = 0; i < 8; ++i) { a[i] *= rs * P.mla_g_k[16 * sub + i]; b[i] *= rs * P.mla_g_k[16 * sub + 8 + i]; }
            *(u32x4*)(kb + 16 * sub) = pack8(a); *(u32x4*)(kb + 16 * sub + 8) = pack8(b);
            const f32x4 g1 = *(const f32x4*)(P.mla_g_k + NOPE + 4 * sub), g2 = *(const f32x4*)(P.mla_g_k + NOPE + 16 + 4 * sub);
            u32x2 o1, o2; o1.x = pk2(k1.x * rs * g1.x, k1.y * rs * g1.y); o1.y = pk2(k1.z * rs * g1.z, k1.w * rs * g1.w);
            o2.x = pk2(k2.x * rs * g2.x, k2.y * rs * g2.y); o2.y = pk2(k2.z * rs * g2.z, k2.w * rs * g2.w);
            bf16_t* kr = KROPE + (size_t)m * 512 + h * 32;
            *(u32x2*)(kr + 4 * sub) = o1; *(u32x2*)(kr + 16 + 4 * sub) = o2;
        }
    }
}

struct EpiF32 { static constexpr int NV = 4; float* C; int ldc, pad;
    __device__ __forceinline__ void store(int row, int col, const float* v) const { *(f32x4*)(C + (size_t)row * ldc + col) = (f32x4){v[0], v[1], v[2], v[3]}; } };
struct EpiBf16 { static constexpr int NV = 8; bf16_t* C; int ldc, pad;
    __device__ __forceinline__ void store(int row, int col, const float* v) const { u32x4 w; w.x = pk2(v[0], v[1]); w.y = pk2(v[2], v[3]); w.z = pk2(v[4], v[5]); w.w = pk2(v[6], v[7]);
        *(u32x4*)(C + (size_t)row * ldc + col) = w; } };
struct EpiSqRelu { static constexpr int NV = 8; bf16_t* C; int ldc, pad;
    __device__ __forceinline__ void store(int row, int col, const float* v) const { float r[8];
#pragma unroll
        for (int i = 0; i < 8; ++i) { const float t = fmaxf(v[i], 0.f); r[i] = t * t; }
        u32x4 w; w.x = pk2(r[0], r[1]); w.y = pk2(r[2], r[3]); w.z = pk2(r[4], r[5]); w.w = pk2(r[6], r[7]);
        *(u32x4*)(C + (size_t)row * ldc + col) = w; } };
struct EpiResGate { static constexpr int NV = 4; const float* base; float* out; const float* gate  ;
    __device__ __forceinline__ void store(int row, int col, const float* v) const {
        const f32x4 b = *(const f32x4*)(base + (size_t)row * DM + col), g = *(const f32x4*)(gate + (size_t)(row / SEQ) * MODW + col);
        *(f32x4*)(out + (size_t)row * DM + col) = b + g * (f32x4){v[0], v[1], v[2], v[3]}; } };

namespace pg8 {
#define PG8_LAS __attribute__((address_space(3)))
typedef unsigned short bf16_t;
typedef short bf16x8 __attribute__((ext_vector_type(8)));
typedef float f32x4 __attribute__((ext_vector_type(4)));
typedef unsigned u32x4 __attribute__((ext_vector_type(4)));
constexpr int BM = 256, BK = 64, HALF = 128, HTB = HALF * BK * 2  , STAGE_BYTES = 8 * HTB, NXCD = 8, WGM = 8;

__host__ __device__ __forceinline__ int lds_byte(int r, int c) { const int st = (r >> 4) * 2 + (c >> 5), rr = r & 15, cc = c & 31, ob = rr * 64 + cc * 2; return st * 1024 + (ob ^ (((ob >> 9) & 1) << 5)); }
__host__ __device__ __forceinline__ void stage_rc(int b, int& R, int& C) { const int st = b / 1024, sb = b % 1024, swz = sb ^ (((sb >> 9) & 1) << 5); R = (st >> 1) * 16 + swz / 64; C = (st & 1) * 32 + (swz % 64) / 2; }
__host__ __device__ __forceinline__ int perm32(int rho) { const int n = rho >> 4, i = rho & 15; return 8 * (i >> 2) + 4 * n + (i & 3); }

struct Unit { int pm, pn; };
struct Gemm { const bf16_t* A; const bf16_t* Bt; int M, N, K; };

struct StaticOrder {
    int nM, nN, nwg, G, c;
    __host__ __device__ void init(int M, int N, int G_, int c_) { nM = M / BM; nN = N / BM; nwg = nM * nN; G = G_; c = c_; }
    __host__ __device__ bool next(int i, Unit& u) const {
        const long L = (long)i * G + c; if (L >= nwg) return false;
        int wgid = (int)L; { const int q = nwg / NXCD, r = nwg % NXCD, xcd = wgid % NXCD, off = wgid / NXCD; wgid = (xcd < r ? xcd * (q + 1) : r * (q + 1) + (xcd - r) * q) + off; }
        const int nig = WGM * nN, gid = wgid / nig, fm = gid * WGM, gsz = (nM - fm) < WGM ? (nM - fm) : WGM;
        u.pm = fm + ((wgid % nig) % gsz); u.pn = (wgid % nig) / gsz; return true;
    }
    __device__ __forceinline__ void a_ready(const Unit&) const {}
    __device__ __forceinline__ void done(const Unit&) const {}
};

template <class Epi, class Sched, bool ALIGN_EPI = false, bool SP2 = false>
__device__ __forceinline__ void gemm_phase(PG8_LAS unsigned char* lds, const Gemm g, const Sched& S, const Epi& E) {
    int tid_ = threadIdx.x; asm volatile("" : "+v"(tid_));
    const int tid = tid_, wid = __builtin_amdgcn_readfirstlane(tid >> 6), lane = tid & 63, wr = wid >> 2, wc = wid & 3, fr = lane & 15, fq = lane >> 4;
    const int K = g.K, nt = K / BK;
    unsigned voffA[2], voffB[2];
#pragma unroll
    for (int i = 0; i < 2; ++i) { int R, C; stage_rc(tid * 16 + i * 8192, R, C); const int Rb = Epi::PERM ? ((R & ~31) + perm32(R & 31)) : R;
        voffA[i] = (unsigned)(R * K + C) * 2u; voffB[i] = (unsigned)(Rb * K + C) * 2u; }
    const size_t kstep = (size_t)(BK * 2);
    const size_t hstep = (size_t)HALF * K * 2;
    const size_t tstep = 2 * hstep;
    const unsigned ldsw = (unsigned)wid * 1024u;
    const int aoff = lds_byte(wr * 64 + fr, fq * 8), boff = lds_byte(wc * 32 + fr, fq * 8);
#define PG8_SA(b, h) (((b) * 2 + (h)) * HTB)
#define PG8_SB(b, h) ((4 + (b) * 2 + (h)) * HTB)
#define PG8_STAGE(bufoff, gbase, voff) do { _Pragma("unroll") for (int _i = 0; _i < 2; ++_i) \
        __builtin_amdgcn_global_load_lds((const unsigned*)((const char*)(gbase) + (voff)[_i]), (PG8_LAS unsigned*)(lds + (bufoff) + ldsw + _i * 8192), 16, 0, 0); } while (0)
#define PG8_LDA(dst, b, h) do { _Pragma("unroll") for (int m = 0; m < 4; ++m) _Pragma("unroll") for (int k = 0; k < 2; ++k) dst[m][k] = *(const PG8_LAS bf16x8*)(lds + PG8_SA(b, h) + aoff + m * 2048 + k * 1024); } while (0)
#define PG8_LDB(dst, b, h) do { _Pragma("unroll") for (int n = 0; n < 2; ++n) _Pragma("unroll") for (int k = 0; k < 2; ++k) dst[n][k] = *(const PG8_LAS bf16x8*)(lds + PG8_SB(b, h) + boff + n * 2048 + k * 1024); } while (0)
#define PG8_MMA(ai, bj, At, Bt) do { __builtin_amdgcn_s_setprio(1); _Pragma("unroll") for (int m = 0; m < 4; ++m) _Pragma("unroll") for (int n = 0; n < 2; ++n) _Pragma("unroll") for (int k = 0; k < 2; ++k) \
        acc[ai][bj][m][n] = __builtin_amdgcn_mfma_f32_16x16x32_bf16(Bt[n][k], At[m][k], acc[ai][bj][m][n], 0, 0, 0); __builtin_amdgcn_s_setprio(0); } while (0)
#define PG8_WAIT_V(n) asm volatile("s_waitcnt vmcnt(" #n ")" ::: "memory")
#define PG8_WAIT_L(n) asm volatile("s_waitcnt lgkmcnt(" #n ")" ::: "memory")
#define PG8_BAR __builtin_amdgcn_s_barrier()
#define PG8_SCHED __builtin_amdgcn_sched_barrier(0)
    Unit cur, nxt; int ui = 0;
    if (!S.next(0, cur)) return;
    f32x4 acc[2][2][4][2];
#pragma unroll
    for (int a = 0; a < 2; ++a)
#pragma unroll
        for (int b = 0; b < 2; ++b)
#pragma unroll
            for (int m = 0; m < 4; ++m)
#pragma unroll
                for (int n = 0; n < 2; ++n) acc[a][b][m][n] = (f32x4){0.f, 0.f, 0.f, 0.f};
    bf16x8 At[4][2], B0[2][2], B1[2][2];
    const char* cA = (const char*)g.A + (size_t)cur.pm * tstep; const char* cB = (const char*)g.Bt + (size_t)cur.pn * tstep;
    S.a_ready(cur);
    if constexpr (SP2) {
        PG8_STAGE(PG8_SB(0, 0), cB, voffB); PG8_STAGE(PG8_SB(0, 1), cB + hstep, voffB); PG8_STAGE(PG8_SA(0, 0), cA, voffA); PG8_STAGE(PG8_SA(0, 1), cA + hstep, voffA);
        if (wr == 1) PG8_BAR;
        PG8_WAIT_V(2); PG8_BAR;
        PG8_STAGE(PG8_SB(1, 0), cB + kstep, voffB); PG8_STAGE(PG8_SA(1, 0), cA + kstep, voffA); PG8_STAGE(PG8_SB(1, 1), cB + hstep + kstep, voffB);
        PG8_WAIT_V(6); PG8_BAR;
    } else {
        PG8_STAGE(PG8_SB(0, 0), cB, voffB); PG8_STAGE(PG8_SA(0, 0), cA, voffA); PG8_STAGE(PG8_SB(0, 1), cB + hstep, voffB); PG8_STAGE(PG8_SA(0, 1), cA + hstep, voffA);
        if (wr == 1) PG8_BAR;
        PG8_WAIT_V(4); PG8_BAR;
        PG8_STAGE(PG8_SB(1, 0), cB + kstep, voffB); PG8_STAGE(PG8_SA(1, 0), cA + kstep, voffA); PG8_STAGE(PG8_SB(1, 1), cB + hstep + kstep, voffB);
        PG8_WAIT_V(6); PG8_BAR;
    }
    for (;;) {
        const bool has_next = S.next(ui + 1, nxt);
        const char* nA = has_next ? (const char*)g.A + (size_t)nxt.pm * tstep : cA; const char* nB = has_next ? (const char*)g.Bt + (size_t)nxt.pn * tstep : cB;
        for (int t = 0; t < nt; t += 2) {
            const bool last = (t == nt - 2);
            const char* a1 = cA + (size_t)(t + 1) * kstep;
            const char* a2 = last ? nA : cA + (size_t)(t + 2) * kstep; const char* b2 = last ? nB : cB + (size_t)(t + 2) * kstep;
            const char* a3 = a2 + kstep; const char* b3 = b2 + kstep;
            if (last && has_next) S.a_ready(nxt);
            if constexpr (SP2) {
            PG8_LDB(B0, 0, 0); PG8_LDB(B1, 0, 1); PG8_SCHED; PG8_LDA(At, 0, 0); PG8_STAGE(PG8_SA(1, 1), a1 + hstep, voffA);
            PG8_WAIT_V(8); PG8_WAIT_L(0); PG8_BAR; PG8_MMA(0, 0, At, B0); PG8_MMA(0, 1, At, B1); PG8_BAR; PG8_SCHED;
            PG8_LDA(At, 0, 1); PG8_STAGE(PG8_SB(0, 0), b2, voffB); PG8_STAGE(PG8_SB(0, 1), b2 + hstep, voffB); PG8_STAGE(PG8_SA(0, 0), a2, voffA);
            PG8_WAIT_V(8); PG8_WAIT_L(0); PG8_BAR; PG8_MMA(1, 0, At, B0); PG8_MMA(1, 1, At, B1); PG8_BAR; PG8_SCHED;
            PG8_LDB(B0, 1, 0); PG8_LDB(B1, 1, 1); PG8_SCHED; PG8_LDA(At, 1, 0); PG8_STAGE(PG8_SA(0, 1), a2 + hstep, voffA);
            PG8_WAIT_V(8); PG8_WAIT_L(0); PG8_BAR; PG8_MMA(0, 0, At, B0); PG8_MMA(0, 1, At, B1); PG8_BAR; PG8_SCHED;
            PG8_LDA(At, 1, 1); PG8_STAGE(PG8_SB(1, 0), b3, voffB); PG8_STAGE(PG8_SB(1, 1), b3 + hstep, voffB); PG8_STAGE(PG8_SA(1, 0), a3, voffA);
            PG8_WAIT_V(8); PG8_WAIT_L(0); PG8_BAR; PG8_MMA(1, 0, At, B0); PG8_MMA(1, 1, At, B1); PG8_BAR; PG8_SCHED;
            } else {
            PG8_LDB(B0, 0, 0); PG8_SCHED; PG8_LDA(At, 0, 0); PG8_STAGE(PG8_SA(1, 1), a1 + hstep, voffA);
            PG8_WAIT_L(8); PG8_BAR; PG8_WAIT_L(0); PG8_MMA(0, 0, At, B0); PG8_BAR; PG8_SCHED;
            PG8_LDB(B1, 0, 1); PG8_STAGE(PG8_SB(0, 0), b2, voffB);
            PG8_BAR; PG8_WAIT_L(0); PG8_MMA(0, 1, At, B1); PG8_BAR;
            PG8_LDA(At, 0, 1); PG8_STAGE(PG8_SA(0, 0), a2, voffA);
            PG8_BAR; PG8_WAIT_L(0); PG8_MMA(1, 0, At, B0); PG8_BAR; PG8_SCHED;
            PG8_STAGE(PG8_SB(0, 1), b2 + hstep, voffB);
            PG8_WAIT_V(6); PG8_BAR; PG8_MMA(1, 1, At, B1); PG8_BAR;
            PG8_LDB(B0, 1, 0); PG8_SCHED; PG8_LDA(At, 1, 0); PG8_STAGE(PG8_SA(0, 1), a2 + hstep, voffA);
            PG8_WAIT_L(8); PG8_BAR; PG8_WAIT_L(0); PG8_MMA(0, 0, At, B0); PG8_BAR; PG8_SCHED;
            PG8_LDB(B1, 1, 1); PG8_STAGE(PG8_SB(1, 0), b3, voffB);
            PG8_BAR; PG8_WAIT_L(0); PG8_MMA(0, 1, At, B1); PG8_BAR;
            PG8_LDA(At, 1, 1); PG8_STAGE(PG8_SA(1, 0), a3, voffA);
            PG8_BAR; PG8_WAIT_L(0); PG8_MMA(1, 0, At, B0); PG8_BAR; PG8_SCHED;
            PG8_STAGE(PG8_SB(1, 1), b3 + hstep, voffB);
            PG8_WAIT_V(6); PG8_BAR; PG8_MMA(1, 1, At, B1); PG8_BAR;
            }
        }
        if constexpr (ALIGN_EPI) { if (wr == 0) PG8_BAR; }
        if constexpr (!Epi::AFTER_DRAIN) { E(acc, cur, wr, wc, fr, fq); S.done(cur); }
        if (!has_next) break;
#pragma unroll
        for (int a = 0; a < 2; ++a)
#pragma unroll
            for (int b = 0; b < 2; ++b)
#pragma unroll
                for (int m = 0; m < 4; ++m)
#pragma unroll
                    for (int n = 0; n < 2; ++n) acc[a][b][m][n] = (f32x4){0.f, 0.f, 0.f, 0.f};
        cur = nxt; cA = nA; cB = nB; ++ui;
        if constexpr (ALIGN_EPI) { if (wr == 1) PG8_BAR; }
    }
    PG8_WAIT_V(0);
    if constexpr (!ALIGN_EPI) { if (wr == 0) PG8_BAR; }
    PG8_BAR;
    if constexpr (Epi::AFTER_DRAIN) { E.fused(acc, cur, wr, wc, fr, fq, lds, wid, lane); S.done(cur); }
#undef PG8_SA
#undef PG8_SB
#undef PG8_STAGE
#undef PG8_LDA
#undef PG8_LDB
#undef PG8_MMA
#undef PG8_WAIT_V
#undef PG8_WAIT_L
#undef PG8_BAR
#undef PG8_SCHED
}
}
#define XB_TMO      128
#define XB_XCNT(j)  (256  + 64 * (j))
#define XB_XSUB(j)  (1280 + 64 * (j))
#define XB_XGEN(j)  (2304 + 64 * (j))
#define XB_TOP      3328
#define XB_TOPGEN   3392
#define XCD_BAR_WORDS 3456
#define XB_SPIN_CAP (1u << 18)

__device__ __forceinline__ unsigned xb_ld(unsigned* p)              { return __hip_atomic_load(p, __ATOMIC_RELAXED, __HIP_MEMORY_SCOPE_AGENT); }
__device__ __forceinline__ unsigned xb_add(unsigned* p, unsigned v) { return __hip_atomic_fetch_add(p, v, __ATOMIC_RELAXED, __HIP_MEMORY_SCOPE_AGENT); }
__device__ __forceinline__ unsigned xb_xcc_id() { return (unsigned)__builtin_amdgcn_s_getreg((3 << 11) | 20) & 0xFu; }
#define XB_SPIN(cond, bar) do { unsigned _sp = 0; while (cond) { __builtin_amdgcn_s_sleep(1); \
    if ((++_sp & 255u) == 0u) { if (xb_ld(&(bar)[XB_TMO])) break; if (_sp > XB_SPIN_CAP) { atomicAdd(&(bar)[XB_TMO], 1u); break; } } } } while (0)

struct XcdBarrier {
    unsigned* bar; unsigned x;
    volatile LAS unsigned* st;
};

__device__ __forceinline__ XcdBarrier xcd_barrier_post(unsigned* bar, volatile LAS unsigned* st) {
    XcdBarrier b; b.bar = bar; b.x = xb_xcc_id(); b.st = st;
    if (threadIdx.x == 0) (void)xb_add(&bar[XB_XCNT(b.x)], 1u);
    return b;
}
__device__ __forceinline__ void xcd_barrier_complete(unsigned* bar, unsigned x, unsigned& nloc, unsigned& nx) {
    const unsigned G = gridDim.x * gridDim.y * gridDim.z;
    unsigned sum, cnt, mine, sp = 0u;
    for (;;) {
        sum = 0u; cnt = 0u; mine = 0u;
#pragma unroll
        for (unsigned j = 0; j < 16; ++j) { const unsigned c = xb_ld(&bar[XB_XCNT(j)]); sum += c; cnt += (c > 0u) ? 1u : 0u; mine = (j == x) ? c : mine; }
        if (sum == G) break;
        __builtin_amdgcn_s_sleep(1);
        if ((++sp & 255u) == 0u) { if (xb_ld(&bar[XB_TMO])) break; if (sp > XB_SPIN_CAP) { atomicAdd(&bar[XB_TMO], 1u); break; } }
    }
    nloc = mine > 0u ? mine : 1u; nx = cnt > 0u ? cnt : 1u;
}

__device__ __forceinline__ void xcd_barrier(const XcdBarrier& b) {
    asm volatile("s_waitcnt vmcnt(0)" ::: "memory");
    __syncthreads();
    if (threadIdx.x == 0) {
        unsigned* bar = b.bar;
        __builtin_amdgcn_s_waitcnt(0);
        unsigned nloc = b.st[0], nx = b.st[1];
        if (nloc == 0u) { xcd_barrier_complete(bar, b.x, nloc, nx); b.st[0] = nloc; b.st[1] = nx; }
        const unsigned old = xb_add(&bar[XB_XSUB(b.x)], 1u);
        const unsigned gen = old / nloc;
        if (old + 1u == (gen + 1u) * nloc) {
            __builtin_amdgcn_fence(__ATOMIC_RELEASE, "agent");
            asm volatile("s_waitcnt vmcnt(0)" ::: "memory");
            const unsigned og = xb_add(&bar[XB_TOP], 1u);
            const unsigned tg = og / nx;
            if (og + 1u == (tg + 1u) * nx) xb_add(&bar[XB_TOPGEN], 1u);
            else XB_SPIN(xb_ld(&bar[XB_TOPGEN]) == tg, bar);
            __builtin_amdgcn_fence(__ATOMIC_ACQUIRE, "agent");
            xb_add(&bar[XB_XGEN(b.x)], 1u);
            asm volatile("s_waitcnt vmcnt(0)" ::: "memory");
        } else {
            XB_SPIN(xb_ld(&bar[XB_XGEN(b.x)]) == gen, bar);
            __builtin_amdgcn_fence(__ATOMIC_ACQUIRE, "agent");
            asm volatile("s_waitcnt vmcnt(0)" ::: "memory");
        }
    }
    __syncthreads();
}
namespace att {
typedef short bf16x8 __attribute__((ext_vector_type(8)));
typedef short s16x4 __attribute__((ext_vector_type(4)));
typedef float f32x16 __attribute__((ext_vector_type(16)));
__device__ __forceinline__ int crow(int r, int hi) { return (r & 3) + 8 * (r >> 2) + 4 * hi; }
template <int NCB> __device__ __forceinline__ int v_st(int k, int c) { const int kk = (k & ~0xC) | ((k & 4) << 1) | ((k & 8) >> 1); return ((kk >> 3) * NCB + (c >> 5)) * 512 + ((kk & 7) * 32 + (c & 31)) * 2; }
__device__ __forceinline__ int v_rd_base(int lane) { return ((lane & 3) << 3) | (((lane >> 2) & 3) << 6) | (((lane >> 4) & 1) << 5) | (((lane >> 5) & 1) << 8); }
__device__ __forceinline__ s16x4 vtr(const LAS unsigned char* p) { typedef short v4i16_t __attribute__((ext_vector_type(4)));
    return __builtin_bit_cast(s16x4, __builtin_amdgcn_ds_read_tr16_b64_v4i16((LAS v4i16_t*)p)); }
__device__ __forceinline__ float swap_max(float v) { auto rr = __builtin_amdgcn_permlane32_swap(__float_as_uint(v), __float_as_uint(v), false, false); return fmaxf(__uint_as_float(rr[0]), __uint_as_float(rr[1])); }
__device__ __forceinline__ float swap_add(float v) { auto rr = __builtin_amdgcn_permlane32_swap(__float_as_uint(v), __float_as_uint(v), false, false); return __uint_as_float(rr[0]) + __uint_as_float(rr[1]); }
#define ATT_PK4(P, BASE, OUT) do { const unsigned a0_ = pk2(P[BASE + 0], P[BASE + 1]), a1_ = pk2(P[BASE + 2], P[BASE + 3]); \
    const unsigned b0_ = pk2(P[BASE + 4], P[BASE + 5]), b1_ = pk2(P[BASE + 6], P[BASE + 7]); \
    auto r0_ = __builtin_amdgcn_permlane32_swap(a0_, b0_, false, false); auto r1_ = __builtin_amdgcn_permlane32_swap(a1_, b1_, false, false); \
    u32x4 w_ = {r0_[0], r1_[0], r0_[1], r1_[1]}; OUT = __builtin_bit_cast(bf16x8, w_); } while (0)

constexpr int KPITCH = 208, KTILE = 64 * KPITCH, VTILE = 64 * 64 * 2;
constexpr int OFF_K = 0, OFF_V = 2 * KTILE, OFF_WS = OFF_V + 2 * VTILE, MLA_LDS = OFF_WS + 8 * 64 * 4;
static_assert(MLA_LDS <= 131072 && (OFF_V % 16) == 0 && (KTILE % 16) == 0, "MLA attention LDS map");

__device__ __forceinline__ void mla_unit(const bf16_t* Q, const bf16_t* KV, const bf16_t* KROPE, bf16_t* O, LAS unsigned char* lds, int b, int h, int qb) {
    int tid_ = threadIdx.x; asm volatile("" : "+v"(tid_));
    const int tid = tid_, lane = tid & 63, r32 = lane & 31, hi = lane >> 5, wid = __builtin_amdgcn_readfirstlane(tid >> 6);
    const size_t row0 = (size_t)b * SEQ;
    const bf16_t* ksrc = KV + (row0 + (tid >> 3)) * 2048 + h * 128 + (tid & 7) * 8;
    const bf16_t* rsrc = KROPE + (row0 + (tid >> 2)) * 512 + h * 32 + (tid & 3) * 8;
    const int kdst = OFF_K + (tid >> 3) * KPITCH + (tid & 7) * 16;
    const int rdst = OFF_K + (tid >> 2) * KPITCH + 128 + (tid & 3) * 16;
    const int vdst = OFF_V + v_st<2>(tid >> 3, (tid & 7) * 8);
    const bool has_r = wid < 4;
    const bf16_t* qp = Q + (row0 + qb * 256 + wid * 32 + r32) * 1536 + h * QKD + hi * 8;
    bf16x8 qr[6];
#pragma unroll
    for (int d0 = 0; d0 < 6; ++d0) qr[d0] = *(const bf16x8*)(qp + 16 * d0);
    f32x16 o0, o1;
#pragma unroll
    for (int r = 0; r < 16; ++r) { o0[r] = 0.f; o1[r] = 0.f; }
    float m = -1e30f, l = 0.f;
    LAS float* wsf = (LAS float*)(lds + OFF_WS) + wid * 64;
    u32x4 kreg, rreg = {0u, 0u, 0u, 0u}, vreg;
#define ATT_LOAD(t) do { kreg = *(const u32x4*)(ksrc + (size_t)(t) * 64 * 2048); vreg = *(const u32x4*)(ksrc + (size_t)(t) * 64 * 2048 + 64); if (has_r) rreg = *(const u32x4*)(rsrc + (size_t)(t) * 64 * 512); } while (0)
#define ATT_WRITE(buf) do { *(LAS u32x4*)(lds + kdst + (buf) * KTILE) = kreg; *(LAS u32x4*)(lds + vdst + (buf) * VTILE) = vreg; if (has_r) *(LAS u32x4*)(lds + rdst + (buf) * KTILE) = rreg; } while (0)
    ATT_LOAD(0); ATT_WRITE(0); ATT_LOAD(1);
    const int NT = SEQ / 64;
#pragma unroll 1
    for (int t = 0; t < NT; ++t) {
        __syncthreads();
        const int cur = t & 1;
        if (t + 1 < NT) { ATT_WRITE(cur ^ 1); if (t + 2 < NT) ATT_LOAD(t + 2); }
        f32x16 p0, p1;
#pragma unroll
        for (int r = 0; r < 16; ++r) { p0[r] = 0.f; p1[r] = 0.f; }
        const LAS unsigned char* kb = lds + OFF_K + cur * KTILE + r32 * KPITCH + hi * 16;
#pragma unroll
        for (int d0 = 0; d0 < 6; ++d0) {
            const bf16x8 a0 = *(const LAS bf16x8*)(kb + d0 * 32), a1 = *(const LAS bf16x8*)(kb + 32 * KPITCH + d0 * 32);
            p0 = __builtin_amdgcn_mfma_f32_32x32x16_bf16(a0, qr[d0], p0, 0, 0, 0);
            p1 = __builtin_amdgcn_mfma_f32_32x32x16_bf16(a1, qr[d0], p1, 0, 0, 0); }
        float pmax = fmaxf(p0[0], p1[0]);
#pragma unroll
        for (int r = 1; r < 16; ++r) pmax = fmaxf(pmax, fmaxf(p0[r], p1[r]));
        pmax = swap_max(pmax);
        const float mn = fmaxf(m, pmax), alpha = __builtin_amdgcn_exp2f(m - mn); m = mn;
        float ps = 0.f;
#pragma unroll
        for (int r = 0; r < 16; ++r) { p0[r] = __builtin_amdgcn_exp2f(p0[r] - mn); p1[r] = __builtin_amdgcn_exp2f(p1[r] - mn); ps += p0[r] + p1[r]; }
        ps = swap_add(ps);
        l = l * alpha + ps;
        if (hi == 0) wsf[r32] = alpha;
#pragma unroll
        for (int r = 0; r < 16; ++r) { const float a = wsf[crow(r, hi)]; o0[r] *= a; o1[r] *= a; }
        bf16x8 pa0, pa1, pa2, pa3;
        ATT_PK4(p0, 0, pa0); ATT_PK4(p0, 8, pa1); ATT_PK4(p1, 0, pa2); ATT_PK4(p1, 8, pa3);
        const LAS unsigned char* vb = lds + OFF_V + cur * VTILE + v_rd_base(lane);
#define ATT_VF(d0, ks) ({ const s16x4 lo_ = vtr(vb + (d0) * 512 + (ks) * 2048), hi_ = vtr(vb + (d0) * 512 + (ks) * 2048 + 1024); (bf16x8){lo_[0], lo_[1], lo_[2], lo_[3], hi_[0], hi_[1], hi_[2], hi_[3]}; })
        o0 = __builtin_amdgcn_mfma_f32_32x32x16_bf16(pa0, ATT_VF(0, 0), o0, 0, 0, 0); o1 = __builtin_amdgcn_mfma_f32_32x32x16_bf16(pa0, ATT_VF(1, 0), o1, 0, 0, 0);
        o0 = __builtin_amdgcn_mfma_f32_32x32x16_bf16(pa1, ATT_VF(0, 1), o0, 0, 0, 0); o1 = __builtin_amdgcn_mfma_f32_32x32x16_bf16(pa1, ATT_VF(1, 1), o1, 0, 0, 0);
        o0 = __builtin_amdgcn_mfma_f32_32x32x16_bf16(pa2, ATT_VF(0, 2), o0, 0, 0, 0); o1 = __builtin_amdgcn_mfma_f32_32x32x16_bf16(pa2, ATT_VF(1, 2), o1, 0, 0, 0);
        o0 = __builtin_amdgcn_mfma_f32_32x32x16_bf16(pa3, ATT_VF(0, 3), o0, 0, 0, 0); o1 = __builtin_amdgcn_mfma_f32_32x32x16_bf16(pa3, ATT_VF(1, 3), o1, 0, 0, 0);
    }
    if (hi == 0) wsf[32 + r32] = l;
    bf16_t* op = O + (row0 + qb * 256 + wid * 32) * DM + h * VD + r32;
#pragma unroll
    for (int r = 0; r < 16; ++r) { const float rl = 1.0f / wsf[32 + crow(r, hi)]; const unsigned w = pk2(o0[r] * rl, o1[r] * rl);
        op[(size_t)crow(r, hi) * DM] = (bf16_t)(w & 0xffffu); op[(size_t)crow(r, hi) * DM + 32] = (bf16_t)(w >> 16); }
#undef ATT_LOAD
#undef ATT_WRITE
#undef ATT_VF
}
template <class F> __device__ __forceinline__ void for_units(int nunits, int vcu, int G, F f) {
    if (nunits % G == 0) { const int per = nunits / G; for (int i = 0; i < per; ++i) f(vcu * per + i); }
    else for (int u = vcu; u < nunits; u += G) f(u);
}
}
namespace att {
constexpr int DK_PITCH = 144, DROWS = 384;
constexpr int DOFF_K = 0, DOFF_V = DROWS * DK_PITCH  , DOFF_POS = DOFF_V + (DROWS / 16) * 2048  , DOFF_LUT = DOFF_POS + DROWS * 4  , DOFF_WS = DOFF_LUT + 4864  , DIL_LDS = DOFF_WS + 8 * 96 * 4;
static_assert(DIL_LDS <= 131072 && (DOFF_V % 16) == 0 && (DOFF_WS % 16) == 0, "dilated attention LDS map");
constexpr int LUT_R = 600;

__device__ __forceinline__ void dil_unit(const bf16_t* QKVG, const int* pos, const float* g_q, const float* g_k, const float* rel_bias, int g, bf16_t* O2, float* LSE, LAS unsigned char* lds, int b, int h, int j) {
    int tid_ = threadIdx.x; asm volatile("" : "+v"(tid_));
    const int tid = tid_, lane = tid & 63, r32 = lane & 31, hi = lane >> 5, wid = __builtin_amdgcn_readfirstlane(tid >> 6);
    const int lgD = 2 * g, lgL = 11 - lgD, Lm1 = (1 << lgL) - 1;
    const size_t row0 = (size_t)b * SEQ; const int u0 = 256 * j;
    LAS float* lut = (LAS float*)(lds + DOFF_LUT); LAS int* posk = (LAS int*)(lds + DOFF_POS);
    for (int idx = tid; idx <= 2 * LUT_R; idx += 512) lut[idx] = rel_bias[t5_bucket(idx - LUT_R) * 48 + g * 16 + h] * LOG2E;
    if (tid < DROWS) { const int u = u0 - 64 + tid; const bool ok = (u >= 0) && (u < SEQ); const int s = ((u & Lm1) << lgD) + (u >> lgL); posk[tid] = ok ? pos[row0 + s] : 0; }
    const int ch = tid & 7;
    float gk[8];
#pragma unroll
    for (int i = 0; i < 8; ++i) gk[i] = g_k[g * 64 + ch * 8 + i];
#pragma unroll
    for (int k = 0; k < 6; ++k) {
        const int i = (tid >> 3) + 64 * k; const int u = u0 - 64 + i; const bool ok = (u >= 0) && (u < SEQ);
        const int s = ((u & Lm1) << lgD) + (u >> lgL);
        const bf16_t* src = QKVG + (row0 + (ok ? s : 0)) * GCOLS + 1024 + h * 64 + ch * 8;
        u32x4 kw = *(const u32x4*)src, vw = *(const u32x4*)(src + 1024);
        float f[8]; unpack8(kw, f); float ss = 0.f;
#pragma unroll
        for (int e = 0; e < 8; ++e) ss += f[e] * f[e];
        ss += __shfl_xor(ss, 1); ss += __shfl_xor(ss, 2); ss += __shfl_xor(ss, 4);
        const float rs = 1.0f / sqrtf(ss * (1.0f / 64) + EPS);
#pragma unroll
        for (int e = 0; e < 8; ++e) f[e] *= rs * gk[e];
        kw = pack8(f);
        if (!ok) { kw = (u32x4){0u, 0u, 0u, 0u}; vw = kw; }
        *(LAS u32x4*)(lds + DOFF_K + i * DK_PITCH + ch * 16) = kw;
        *(LAS u32x4*)(lds + DOFF_V + (i >> 6) * 8192 + v_st<2>(i & 63, ch * 8)) = vw;
    }
    const int uq = u0 + 32 * wid + r32; const int sq = ((uq & Lm1) << lgD) + (uq >> lgL); const size_t grow = row0 + sq;
    const int posq = pos[grow];
    bf16x8 qr[4];
    {   float qf[4][8]; float ss = 0.f;
#pragma unroll
        for (int d0 = 0; d0 < 4; ++d0) { unpack8(*(const u32x4*)(QKVG + grow * GCOLS + h * 64 + 16 * d0 + 8 * hi), qf[d0]);
#pragma unroll
            for (int e = 0; e < 8; ++e) ss += qf[d0][e] * qf[d0][e]; }
        ss = swap_add(ss);
        const float rs = DIL_C2 / sqrtf(ss * (1.0f / 64) + EPS);
#pragma unroll
        for (int d0 = 0; d0 < 4; ++d0) {
#pragma unroll
            for (int e = 0; e < 8; ++e) qf[d0][e] *= rs * g_q[g * 64 + 16 * d0 + 8 * hi + e];
            qr[d0] = __builtin_bit_cast(bf16x8, pack8(qf[d0])); }
    }
    __syncthreads();
    f32x16 p[5];
    const int seqq = uq >> lgL;
#pragma unroll
    for (int ht = 0; ht < 5; ++ht) {
        const int i0 = 32 * (wid + ht);
#pragma unroll
        for (int r = 0; r < 16; ++r) p[ht][r] = 0.f;
        const LAS unsigned char* kb = lds + DOFF_K + (i0 + r32) * DK_PITCH + hi * 16;
#pragma unroll
        for (int d0 = 0; d0 < 4; ++d0) p[ht] = __builtin_amdgcn_mfma_f32_32x32x16_bf16(*(const LAS bf16x8*)(kb + d0 * 32), qr[d0], p[ht], 0, 0, 0);
#pragma unroll
        for (int r = 0; r < 16; ++r) { const int c = crow(r, hi), ik = i0 + c, uk = u0 - 64 + ik, delta = 32 * ht + c - 64 - r32;
            const bool valid = ((uk >> lgL) == seqq) && (delta >= -64) && (delta <= 64);
            int rel = posk[ik] - posq; rel = rel < -LUT_R ? -LUT_R : (rel > LUT_R ? LUT_R : rel);
            p[ht][r] = valid ? p[ht][r] + lut[rel + LUT_R] : -INFINITY; }
    }
    float mx = p[0][0];
#pragma unroll
    for (int ht = 0; ht < 5; ++ht)
#pragma unroll
        for (int r = 0; r < 16; ++r) mx = fmaxf(mx, p[ht][r]);
    mx = swap_max(mx);
    float l = 0.f;
#pragma unroll
    for (int ht = 0; ht < 5; ++ht)
#pragma unroll
        for (int r = 0; r < 16; ++r) { p[ht][r] = __builtin_amdgcn_exp2f(p[ht][r] - mx); l += p[ht][r]; }
    l = swap_add(l);
    f32x16 o0, o1;
#pragma unroll
    for (int r = 0; r < 16; ++r) { o0[r] = 0.f; o1[r] = 0.f; }
    const LAS unsigned char* vb = lds + DOFF_V + v_rd_base(lane);
#pragma unroll
    for (int ht = 0; ht < 5; ++ht) {
        bf16x8 pa0, pa1; ATT_PK4(p[ht], 0, pa0); ATT_PK4(p[ht], 8, pa1);
        const LAS unsigned char* vk = vb + 2 * (wid + ht) * 2048;
#define DIL_VF(d0, ks) ({ const s16x4 lo_ = vtr(vk + (d0) * 512 + (ks) * 2048), hi_ = vtr(vk + (d0) * 512 + (ks) * 2048 + 1024); (bf16x8){lo_[0], lo_[1], lo_[2], lo_[3], hi_[0], hi_[1], hi_[2], hi_[3]}; })
        o0 = __builtin_amdgcn_mfma_f32_32x32x16_bf16(pa0, DIL_VF(0, 0), o0, 0, 0, 0); o1 = __builtin_amdgcn_mfma_f32_32x32x16_bf16(pa0, DIL_VF(1, 0), o1, 0, 0, 0);
        o0 = __builtin_amdgcn_mfma_f32_32x32x16_bf16(pa1, DIL_VF(0, 1), o0, 0, 0, 0); o1 = __builtin_amdgcn_mfma_f32_32x32x16_bf16(pa1, DIL_VF(1, 1), o1, 0, 0, 0);
#undef DIL_VF
    }
    float lse = mx + log2f(l), wn = 1.0f / l, wo = 0.f;
    if (g > 0) { const float lo = LSE[grow * 16 + h]; const float mm = fmaxf(lo, lse); const float nl = mm + log2f(__builtin_amdgcn_exp2f(lo - mm) + __builtin_amdgcn_exp2f(lse - mm));
        wo = __builtin_amdgcn_exp2f(lo - nl); wn = __builtin_amdgcn_exp2f(lse - nl) / l; lse = nl; }
    LAS float* wsf = (LAS float*)(lds + DOFF_WS) + wid * 96;
    if (hi == 0) { LSE[grow * 16 + h] = lse; wsf[r32] = wn; wsf[32 + r32] = wo; ((LAS int*)wsf)[64 + r32] = (int)grow; }
#pragma unroll
    for (int r = 0; r < 16; ++r) { const int c = crow(r, hi); const float a = wsf[c], bo = wsf[32 + c]; const int gr = ((LAS int*)wsf)[64 + c];
        bf16_t* op = O2 + (size_t)gr * DM + h * 64 + r32;
        float v0 = o0[r] * a, v1 = o1[r] * a;
        if (g > 0) { v0 += bf2f(op[0]) * bo; v1 += bf2f(op[32]) * bo; }
        const unsigned w = pk2(v0, v1); op[0] = (bf16_t)(w & 0xffffu); op[32] = (bf16_t)(w >> 16); }
    __syncthreads();
}
}
namespace att {
__device__ __forceinline__ void mla_unit_fast(const bf16_t* Q, const bf16_t* KV, const bf16_t* KROPE, bf16_t* O, LAS unsigned char* lds, int b, int h, int qb, float KN) {
    int tid_ = threadIdx.x; asm volatile("" : "+v"(tid_));
    const int tid = tid_, lane = tid & 63, r32 = lane & 31, hi = lane >> 5, wid = __builtin_amdgcn_readfirstlane(tid >> 6);
    const size_t row0 = (size_t)b * SEQ;
    const bf16_t* ksrc = KV + (row0 + (tid >> 3)) * 2048 + h * 128 + (tid & 7) * 8;
    const bf16_t* rsrc = KROPE + (row0 + ((tid & 255) >> 2)) * 512 + h * 32 + (tid & 3) * 8;
    const int kdst = OFF_K + (tid >> 3) * KPITCH + (tid & 7) * 16;
    const int rdst = OFF_K + ((tid & 255) >> 2) * KPITCH + 128 + (tid & 3) * 16;
    const int vdst = OFF_V + v_st<2>(tid >> 3, (tid & 7) * 8);
    const bf16_t* qp = Q + (row0 + qb * 256 + wid * 32 + r32) * 1536 + h * QKD + hi * 8;
    bf16x8 qr[6]; float qn2 = 0.f;
#pragma unroll
    for (int d0 = 0; d0 < 6; ++d0) { const u32x4 w = *(const u32x4*)(qp + 16 * d0); qr[d0] = __builtin_bit_cast(bf16x8, w); float f[8]; unpack8(w, f);
#pragma unroll
        for (int e = 0; e < 8; ++e) qn2 += f[e] * f[e]; }
    qn2 = swap_add(qn2);
    const float negB = -(sqrtf(qn2) * KN);
    f32x16 o0, o1;
#pragma unroll
    for (int r = 0; r < 16; ++r) { o0[r] = 0.f; o1[r] = 0.f; }
    float lsum = 0.f;
    u32x4 kreg, rreg = {0u, 0u, 0u, 0u}, vreg;
#define F_LOADK(t) do { kreg = *(const u32x4*)(ksrc + (size_t)(t) * 64 * 2048); rreg = *(const u32x4*)(rsrc + (size_t)(t) * 64 * 512); } while (0)
#define F_LOADV(t) do { vreg = *(const u32x4*)(ksrc + (size_t)(t) * 64 * 2048 + 64); } while (0)
#define F_WRITEK(buf) do { *(LAS u32x4*)(lds + kdst + (buf) * KTILE) = kreg; *(LAS u32x4*)(lds + rdst + (buf) * KTILE) = rreg; } while (0)
#define F_WRITEV(buf) do { *(LAS u32x4*)(lds + vdst + (buf) * VTILE) = vreg; } while (0)
#define F_QK(P0, P1, buf) do { const LAS unsigned char* kb_ = lds + OFF_K + (buf) * KTILE + r32 * KPITCH + hi * 16; { float nb_ = negB; asm volatile("" : "+v"(nb_)); _Pragma("unroll") for (int r = 0; r < 16; ++r) { P0[r] = nb_; P1[r] = nb_; } } \
        _Pragma("unroll") for (int d0 = 0; d0 < 6; ++d0) { const bf16x8 a0_ = *(const LAS bf16x8*)(kb_ + d0 * 32), a1_ = *(const LAS bf16x8*)(kb_ + 32 * KPITCH + d0 * 32); \
            P0 = __builtin_amdgcn_mfma_f32_32x32x16_bf16(a0_, qr[d0], P0, 0, 0, 0); P1 = __builtin_amdgcn_mfma_f32_32x32x16_bf16(a1_, qr[d0], P1, 0, 0, 0); } } while (0)
#define F_VF(vb_, d0, ks) ({ const s16x4 lo_ = vtr(vb_ + (d0) * 512 + (ks) * 2048), hi_ = vtr(vb_ + (d0) * 512 + (ks) * 2048 + 1024); (bf16x8){lo_[0], lo_[1], lo_[2], lo_[3], hi_[0], hi_[1], hi_[2], hi_[3]}; })
    const int NT = SEQ / 64;
#define F_SMPV(C0, C1, t) do { \
        float ps_ = 0.f; \
        _Pragma("unroll") for (int r = 0; r < 16; ++r) { C0[r] = __builtin_amdgcn_exp2f(C0[r]); C1[r] = __builtin_amdgcn_exp2f(C1[r]); ps_ += C0[r] + C1[r]; } \
        lsum += ps_; \
        bf16x8 pa0_, pa1_, pa2_, pa3_; ATT_PK4(C0, 0, pa0_); ATT_PK4(C0, 8, pa1_); ATT_PK4(C1, 0, pa2_); ATT_PK4(C1, 8, pa3_); \
        const LAS unsigned char* vb_ = lds + OFF_V + ((t) & 1) * VTILE + v_rd_base(lane); \
        o0 = __builtin_amdgcn_mfma_f32_32x32x16_bf16(pa0_, F_VF(vb_, 0, 0), o0, 0, 0, 0); o1 = __builtin_amdgcn_mfma_f32_32x32x16_bf16(pa0_, F_VF(vb_, 1, 0), o1, 0, 0, 0); \
        o0 = __builtin_amdgcn_mfma_f32_32x32x16_bf16(pa1_, F_VF(vb_, 0, 1), o0, 0, 0, 0); o1 = __builtin_amdgcn_mfma_f32_32x32x16_bf16(pa1_, F_VF(vb_, 1, 1), o1, 0, 0, 0); \
        o0 = __builtin_amdgcn_mfma_f32_32x32x16_bf16(pa2_, F_VF(vb_, 0, 2), o0, 0, 0, 0); o1 = __builtin_amdgcn_mfma_f32_32x32x16_bf16(pa2_, F_VF(vb_, 1, 2), o1, 0, 0, 0); \
        o0 = __builtin_amdgcn_mfma_f32_32x32x16_bf16(pa3_, F_VF(vb_, 0, 3), o0, 0, 0, 0); o1 = __builtin_amdgcn_mfma_f32_32x32x16_bf16(pa3_, F_VF(vb_, 1, 3), o1, 0, 0, 0); \
    } while (0)
#define F_STEP(C0, C1, N0, N1, t, LEAD, WK, WV, LK, LV, DOQK) do { \
        __syncthreads(); \
        if (WK) { F_WRITEK((t) & 1); } if (WV) { F_WRITEV(((t) + 1) & 1); } \
        if (LK) { F_LOADK((t) + 3); } if (LV) { F_LOADV((t) + 2); } \
        __builtin_amdgcn_sched_barrier(0); \
        if (LEAD) { if (DOQK) { F_QK(N0, N1, ((t) + 1) & 1); } __builtin_amdgcn_sched_barrier(0); F_SMPV(C0, C1, t); } \
        else { F_SMPV(C0, C1, t); __builtin_amdgcn_sched_barrier(0); if (DOQK) { F_QK(N0, N1, ((t) + 1) & 1); } } \
        __builtin_amdgcn_sched_barrier(0); \
    } while (0)
#define F_LOOP(LEAD) do { \
        _Pragma("unroll 1") for (int t = 0; t < NT - 4; t += 2) { F_STEP(pA0, pA1, pB0, pB1, t, LEAD, true, true, true, true, true); F_STEP(pB0, pB1, pA0, pA1, t + 1, LEAD, true, true, true, true, true); } \
        F_STEP(pA0, pA1, pB0, pB1, NT - 4, LEAD, true, true, false, true, true); \
        F_STEP(pB0, pB1, pA0, pA1, NT - 3, LEAD, true, true, false, false, true); \
        F_STEP(pA0, pA1, pB0, pB1, NT - 2, LEAD, false, true, false, false, true); \
        F_STEP(pB0, pB1, pA0, pA1, NT - 1, LEAD, false, false, false, false, false); \
    } while (0)
    F_LOADK(0); F_LOADV(0); F_WRITEK(0); F_WRITEV(0); F_LOADK(1); F_WRITEK(1); F_LOADK(2); F_LOADV(1);
    __syncthreads();
    f32x16 pA0, pA1, pB0, pB1;
    F_QK(pA0, pA1, 0);
    if (wid < 4) F_LOOP(true); else F_LOOP(false);
    const float l = swap_add(lsum);
    LAS float* wsf = (LAS float*)(lds + OFF_WS) + wid * 64;
    if (hi == 0) wsf[32 + r32] = l;
    bf16_t* op = O + (row0 + qb * 256 + wid * 32) * DM + h * VD + r32;
#pragma unroll
    for (int r = 0; r < 16; ++r) { const float rl = 1.0f / wsf[32 + crow(r, hi)]; const unsigned w = pk2(o0[r] * rl, o1[r] * rl);
        op[(size_t)crow(r, hi) * DM] = (bf16_t)(w & 0xffffu); op[(size_t)crow(r, hi) * DM + 32] = (bf16_t)(w >> 16); }
    __syncthreads();
#undef F_LOADK
#undef F_LOADV
#undef F_WRITEK
#undef F_WRITEV
#undef F_QK
#undef F_VF
#undef F_STEP
#undef F_LOOP
#undef F_SMPV
}
__device__ __forceinline__ float wave_absmax(const float* g, int n, int lane) {
    float v = lane < n ? fabsf(g[lane]) : 0.f; if (lane + 64 < n) v = fmaxf(v, fabsf(g[lane + 64]));
#pragma unroll
    for (int o = 1; o < 64; o <<= 1) v = fmaxf(v, __shfl_xor(v, o));
    return v;
}
}

__global__ void __launch_bounds__(256) naive_mla_attn(const bf16_t* Q, const bf16_t* KV, const bf16_t* KROPE, bf16_t* O) {
    __shared__ float Ks[32][QKD]; __shared__ float Vs[32][VD];
    const int tid = threadIdx.x, qb = blockIdx.x & 7, h = (blockIdx.x >> 3) & 15, b = blockIdx.x >> 7;
    const size_t m = (size_t)b * SEQ + qb * 256 + tid;
    float q[QKD];
#pragma unroll
    for (int c = 0; c < 12; ++c) { float f[8]; unpack8(*(const u32x4*)(Q + m * 1536 + h * QKD + 8 * c), f);
#pragma unroll
        for (int i = 0; i < 8; ++i) q[8 * c + i] = f[i]; }
    float o[VD];
#pragma unroll
    for (int i = 0; i < VD; ++i) o[i] = 0.f;
    float mx = -INFINITY, l = 0.f;
    for (int t = 0; t < SEQ / 32; ++t) {
        __syncthreads();
        {
            for (int c = tid; c < 640; c += 256) { const int key = c / 20, ch = c % 20; const size_t km = (size_t)b * SEQ + t * 32 + key; float f[8];
                if (ch < 8) { unpack8(*(const u32x4*)(KV + km * 2048 + h * 128 + 8 * ch), f);
#pragma unroll
                    for (int i = 0; i < 8; ++i) Ks[key][8 * ch + i] = f[i]; }
                else if (ch < 12) { unpack8(*(const u32x4*)(KROPE + km * 512 + h * 32 + 8 * (ch - 8)), f);
#pragma unroll
                    for (int i = 0; i < 8; ++i) Ks[key][NOPE + 8 * (ch - 8) + i] = f[i]; }
                else { unpack8(*(const u32x4*)(KV + km * 2048 + h * 128 + 64 + 8 * (ch - 12)), f);
#pragma unroll
                    for (int i = 0; i < 8; ++i) Vs[key][8 * (ch - 12) + i] = f[i]; } }
        }
        __syncthreads();
        for (int key = 0; key < 32; ++key) {
            float s = 0.f;
#pragma unroll
            for (int d = 0; d < QKD; d += 4) { const f32x4 kk = *(const f32x4*)&Ks[key][d]; s += q[d] * kk.x + q[d + 1] * kk.y + q[d + 2] * kk.z + q[d + 3] * kk.w; }
            if (s > mx) { const float al = exp2f(mx - s); l *= al;
#pragma unroll
                for (int i = 0; i < VD; ++i) o[i] *= al;
                mx = s; }
            const float p = exp2f(s - mx); l += p;
#pragma unroll
            for (int d = 0; d < VD; d += 4) { const f32x4 vv = *(const f32x4*)&Vs[key][d]; o[d] += p * vv.x; o[d + 1] += p * vv.y; o[d + 2] += p * vv.z; o[d + 3] += p * vv.w; }
        }
    }
    const float rl = 1.0f / l;
#pragma unroll
    for (int c = 0; c < 8; ++c) { float f[8];
#pragma unroll
        for (int i = 0; i < 8; ++i) f[i] = o[8 * c + i] * rl;
        *(u32x4*)(O + m * DM + h * VD + 8 * c) = pack8(f); }
}

__global__ void __launch_bounds__(256) naive_dil_attn(const bf16_t* QKVG, const int* pos, const float* g_q, const float* g_k, const float* rel_bias, int g, int dil, bf16_t* O2, float* LSE) {
    const int tid = threadIdx.x, sb = blockIdx.x & 7, h = (blockIdx.x >> 3) & 15, b = blockIdx.x >> 7;
    const int s = sb * 256 + tid; const size_t m = (size_t)b * SEQ + s;
    float q[64]; float ss = 0.f;
#pragma unroll
    for (int c = 0; c < 8; ++c) { float f[8]; unpack8(*(const u32x4*)(QKVG + m * GCOLS + h * 64 + 8 * c), f);
#pragma unroll
        for (int i = 0; i < 8; ++i) { q[8 * c + i] = f[i]; ss += f[i] * f[i]; } }
    const float rq = DIL_C2 / sqrtf(ss * (1.0f / 64) + EPS);
#pragma unroll
    for (int i = 0; i < 64; ++i) q[i] *= rq * g_q[g * 64 + i] * g_k[g * 64 + i];
    float o[64];
#pragma unroll
    for (int i = 0; i < 64; ++i) o[i] = 0.f;
    float mx = -INFINITY, l = 0.f; const int pq = pos[m];
    for (int j = -64; j <= 64; ++j) {
        const int sk = s + j * dil; if (sk < 0 || sk >= SEQ) continue;
        const size_t km = (size_t)b * SEQ + sk;
        float dot = 0.f, sk2 = 0.f;
#pragma unroll
        for (int c = 0; c < 8; ++c) { float f[8]; unpack8(*(const u32x4*)(QKVG + km * GCOLS + 1024 + h * 64 + 8 * c), f);
#pragma unroll
            for (int i = 0; i < 8; ++i) { dot += q[8 * c + i] * f[i]; sk2 += f[i] * f[i]; } }
        const float bias = rel_bias[t5_bucket(pos[km] - pq) * 48 + g * 16 + h] * LOG2E;
        const float sc = dot / sqrtf(sk2 * (1.0f / 64) + EPS) + bias;
        if (sc > mx) { const float al = exp2f(mx - sc); l *= al;
#pragma unroll
            for (int i = 0; i < 64; ++i) o[i] *= al;
            mx = sc; }
        const float p = exp2f(sc - mx); l += p;
#pragma unroll
        for (int c = 0; c < 8; ++c) { float f[8]; unpack8(*(const u32x4*)(QKVG + km * GCOLS + 2048 + h * 64 + 8 * c), f);
#pragma unroll
            for (int i = 0; i < 8; ++i) o[8 * c + i] += p * f[i]; }
    }
    float lse = mx + log2f(l); float wn = 1.0f / l, wo = 0.f;
    if (g > 0) { const float lo = LSE[m * 16 + h]; const float mm = fmaxf(lo, lse); const float ea = exp2f(lo - mm), eb = exp2f(lse - mm); const float nl = mm + log2f(ea + eb);
        wo = exp2f(lo - nl); wn = exp2f(lse - nl) / l; lse = nl; }
    LSE[m * 16 + h] = lse;
#pragma unroll
    for (int c = 0; c < 8; ++c) { float f[8], old[8];
        if (g > 0) unpack8(*(const u32x4*)(O2 + m * DM + h * 64 + 8 * c), old);
#pragma unroll
        for (int i = 0; i < 8; ++i) f[i] = o[8 * c + i] * wn + (g > 0 ? old[i] * wo : 0.f);
        *(u32x4*)(O2 + m * DM + h * 64 + 8 * c) = pack8(f); }
}
constexpr int NWAVES = 8;
constexpr int RING_BYTES = 131072;
constexpr int LDSCTL_OFF = RING_BYTES, MISC_OFF = LDSCTL_OFF + 320;
constexpr int LDS_BYTES = 147456;
constexpr int CW_BAR = 4096;
constexpr size_t CTL_ZERO_BYTES = 256 * 1024;
static_assert((CW_BAR + 12 * XCD_BAR_WORDS) * 4 <= (int)CTL_ZERO_BYTES, "barrier words inside the memset region");

template <class E> struct EpiAd {
    static constexpr bool PERM = (E::NV == 8), AFTER_DRAIN = false; E e;
    __device__ __forceinline__ void operator()(const pg8::f32x4 (&acc)[2][2][4][2], const pg8::Unit& u, int wr, int wc, int fr, int fq) const {
#pragma unroll
        for (int ai = 0; ai < 2; ++ai)
#pragma unroll
            for (int m = 0; m < 4; ++m) { const int row = u.pm * 256 + ai * 128 + wr * 64 + m * 16 + fr;
#pragma unroll
                for (int bj = 0; bj < 2; ++bj) {
                    if constexpr (PERM) { const int col = u.pn * 256 + bj * 128 + wc * 32 + 8 * fq;
                        const float v[8] = {acc[ai][bj][m][0][0], acc[ai][bj][m][0][1], acc[ai][bj][m][0][2], acc[ai][bj][m][0][3], acc[ai][bj][m][1][0], acc[ai][bj][m][1][1], acc[ai][bj][m][1][2], acc[ai][bj][m][1][3]};
                        e.store(row, col, v); }
                    else {
#pragma unroll
                        for (int n = 0; n < 2; ++n) { const int col = u.pn * 256 + bj * 128 + wc * 32 + 16 * n + 4 * fq;
                            const float v[4] = {acc[ai][bj][m][n][0], acc[ai][bj][m][n][1], acc[ai][bj][m][n][2], acc[ai][bj][m][n][3]};
                            e.store(row, col, v); } } }
                if (m & 1) asm volatile("" ::: "memory"); }
    }
};
template <class E> __device__ __forceinline__ void run_gemm(LAS unsigned char* lds, const void* A, const void* Bt, int N, int K, const E& e) {
    pg8::Gemm g{(const bf16_t*)A, (const bf16_t*)Bt, MTOK, N, K}; pg8::StaticOrder S; S.init(MTOK, N, (int)gridDim.x, (int)blockIdx.x);
    EpiAd<E> ad{e};
    pg8::gemm_phase<EpiAd<E>, pg8::StaticOrder, true, true>(lds, g, S, ad);
}

struct Args { Ptrs P; int ph_lo, ph_hi, li, pad; };
#define GASP __attribute__((address_space(1)))
struct GPtrs {
    const GASP float *x, *c; const GASP int* pos; const GASP float *ada_w, *ada_b, *norm_mix, *norm_mlp, *mlp_w1, *mlp_w2;
    const GASP float *mla_w_in, *mla_g_qa, *mla_w_qb, *mla_g_kva, *mla_w_kvb, *mla_g_q, *mla_g_k, *mla_w_o;
    const GASP float *dil_w_in, *dil_g_q, *dil_g_k, *dil_w_o, *rel_bias;
    GASP float* out; GASP unsigned char* ws;
};
static_assert(sizeof(GPtrs) == sizeof(Ptrs), "GPtrs mirrors Ptrs");
typedef const __attribute__((address_space(4))) GPtrs* kargp_t;
__device__ __forceinline__ kargp_t kargs() { kargp_t p = (kargp_t)__builtin_amdgcn_kernarg_segment_ptr(); asm volatile("" : "+s"(p)); return p; }
__device__ __forceinline__ Ptrs kptrs() { kargp_t g = kargs(); Ptrs P;
    P.x = (const float*)g->x; P.c = (const float*)g->c; P.pos = (const int*)g->pos; P.ada_w = (const float*)g->ada_w; P.ada_b = (const float*)g->ada_b; P.norm_mix = (const float*)g->norm_mix; P.norm_mlp = (const float*)g->norm_mlp;
    P.mlp_w1 = (const float*)g->mlp_w1; P.mlp_w2 = (const float*)g->mlp_w2; P.mla_w_in = (const float*)g->mla_w_in; P.mla_g_qa = (const float*)g->mla_g_qa; P.mla_w_qb = (const float*)g->mla_w_qb; P.mla_g_kva = (const float*)g->mla_g_kva;
    P.mla_w_kvb = (const float*)g->mla_w_kvb; P.mla_g_q = (const float*)g->mla_g_q; P.mla_g_k = (const float*)g->mla_g_k; P.mla_w_o = (const float*)g->mla_w_o; P.dil_w_in = (const float*)g->dil_w_in; P.dil_g_q = (const float*)g->dil_g_q;
    P.dil_g_k = (const float*)g->dil_g_k; P.dil_w_o = (const float*)g->dil_w_o; P.rel_bias = (const float*)g->rel_bias; P.out = (float*)g->out; P.ws = (unsigned char*)g->ws; return P; }
#define KA kptrs()
#define MOD0 ((const float*)(KA.ws + WS_MOD))
#define MOD1 (MOD0 + 8 * MODW)
#define HB ((bf16_t*)(KA.ws + WS_H))
constexpr int NPHASE = 22;
#ifndef HYBRID
#define HYBRID 0
#endif
__global__ void __launch_bounds__(NWAVES * 64, 2) mega_fwd(Args args) {
    extern __shared__ __attribute__((aligned(16))) unsigned char lds_raw[];
    LAS unsigned char* lds = (LAS unsigned char*)lds_raw;
    volatile LAS unsigned* MISC = (volatile LAS unsigned*)(lds + MISC_OFF);
    const int tid = threadIdx.x, lane = tid & 63, wave = __builtin_amdgcn_readfirstlane(tid >> 6);
    const int G = gridDim.x, bx = blockIdx.x, gw = bx * NWAVES + wave, ngw = G * NWAVES;
    const int vcu = (G % 8 == 0) ? (bx % 8) * (G / 8) + bx / 8 : bx;
    for (int u = tid; u < (LDS_BYTES - LDSCTL_OFF) / 4; u += NWAVES * 64) ((LAS unsigned*)(lds + LDSCTL_OFF))[u] = 0u;
    __syncthreads();
    XcdBarrier bar = xcd_barrier_post((unsigned*)(args.P.ws + WS_CTL) + CW_BAR + args.li * XCD_BAR_WORDS, MISC + 8);
    const int lo = args.ph_lo, hi = args.ph_hi;
#ifdef TS_A
    unsigned long long* tsbuf = (unsigned long long*)(args.P.ws + WS_CTL + 512 * 1024);
#endif
#define IN(k) (lo <= (k) && (k) < hi)
#ifdef TS_A
#define STAMP(i) do { if (bx == 0 && tid == 0) tsbuf[i] = __builtin_amdgcn_s_memrealtime(); } while (0)
#else
#define STAMP(i) do { } while (0)
#endif
#define SEAM(k) do { if (IN(k) && IN((k) + 1)) xcd_barrier(bar); STAMP((k) + 1); } while (0)
#ifndef REP_MASK
#define REP_MASK 0u
#endif
#ifndef EXTRA_BARS
#define EXTRA_BARS 0
#endif
#define REPEAT(k) for (int rep_ = 0; rep_ < (((REP_MASK) >> (k)) & 1u ? 2 : 1); ++rep_, (((REP_MASK) >> (k)) & 1u) && rep_ < 2 ? (xcd_barrier(bar), 0) : 0)

    STAMP(0);
    if (IN(0)) REPEAT(0) {
        p0_weights(KA, (LAS float*)lds + wave * (64 * 33), gw, ngw, lane);
        p0_cs(KA, bx * 512 + tid, G * 512);
        __syncthreads();
        p0_mod(KA, (LAS float*)lds, bx, G, tid, NWAVES);
    }
    SEAM(0);
    for (int eb_ = 0; eb_ < EXTRA_BARS; ++eb_) xcd_barrier(bar);
    if (IN(1)) REPEAT(1) lnmod_rows(KA.x, KA.norm_mix, MOD0, 0, 1, HB, gw, ngw, lane);
    SEAM(1);
    if (IN(2)) REPEAT(2) run_gemm(lds, KA.ws + WS_H, KA.ws + WS_WIN0, MLA_INP, DM, EpiF32{(float*)(KA.ws + WS_PROJ), MLA_INP, 0});
    SEAM(2);
    if (IN(3)) REPEAT(3) mla_prep_rows(KA, gw, ngw, lane);
    SEAM(3);
    if (IN(4)) REPEAT(4) {
        run_gemm(lds, KA.ws + WS_QA, KA.ws + WS_WQB, 1536, QLORA, EpiBf16{(bf16_t*)(KA.ws + WS_Q), 1536, 0});
        run_gemm(lds, KA.ws + WS_KVA, KA.ws + WS_WKVB, 2048, KVLORA, EpiBf16{(bf16_t*)(KA.ws + WS_KV), 2048, 0});
    }
    SEAM(4);
    if (IN(5)) REPEAT(5) mla_final_rows(KA, gw, ngw, lane);
    SEAM(5);
    if (IN(6)) REPEAT(6) {
        const float gqm = att::wave_absmax(KA.mla_g_q, QKD, lane), gkm = att::wave_absmax(KA.mla_g_k, QKD, lane);
        const float KN = __builtin_bit_cast(float, __builtin_amdgcn_readfirstlane(__builtin_bit_cast(int, 9.797958971f * gkm * 1.00391f)));
        const bool fast = __builtin_amdgcn_readfirstlane((int)(1.4427f * 9.798f * 1.008f * gqm * gkm <= 40.0f)) != 0;
        if (fast) att::for_units(NBATCH * NH * 8, vcu, G, [&](int u) { att::mla_unit_fast((const bf16_t*)(KA.ws + WS_Q), (const bf16_t*)(KA.ws + WS_KV), (const bf16_t*)(KA.ws + WS_KROPE), HB, lds, u >> 7, (u >> 3) & 15, u & 7, KN); });
        else att::for_units(NBATCH * NH * 8, vcu, G, [&](int u) { att::mla_unit((const bf16_t*)(KA.ws + WS_Q), (const bf16_t*)(KA.ws + WS_KV), (const bf16_t*)(KA.ws + WS_KROPE), HB, lds, u >> 7, (u >> 3) & 15, u & 7); });
    }
    SEAM(6);
    if (IN(7)) REPEAT(7) run_gemm(lds, KA.ws + WS_H, KA.ws + WS_WO0, DM, DM, EpiResGate{KA.x, KA.out, MOD0 + 2 * DM});
    SEAM(7);
    if (IN(8)) REPEAT(8) lnmod_rows(KA.out, KA.norm_mlp, MOD0, 3, 4, HB, gw, ngw, lane);
    SEAM(8);
    if (IN(9)) REPEAT(9) run_gemm(lds, KA.ws + WS_H, KA.ws + WS_W1_0, DFF, DM, EpiSqRelu{(bf16_t*)(KA.ws + WS_U), DFF, 0});
    SEAM(9);
    if (IN(10)) REPEAT(10) run_gemm(lds, KA.ws + WS_U, KA.ws + WS_W2_0, DM, DFF, EpiResGate{KA.out, KA.out, MOD0 + 5 * DM});
    SEAM(10);
    if (IN(11)) REPEAT(11) lnmod_rows(KA.out, KA.norm_mix + DM, MOD1, 0, 1, HB, gw, ngw, lane);
    SEAM(11);
#pragma unroll 1
    for (int g = 0; g < 3; ++g) {
        if (IN(12 + 2 * g)) REPEAT(12 + 2 * g) run_gemm(lds, KA.ws + WS_H, KA.ws + WS_WIN1 + (size_t)g * GCOLS * DM * 2, GCOLS, DM, EpiBf16{(bf16_t*)(KA.ws + WS_QKVG), GCOLS, 0});
        SEAM(12 + 2 * g);
        if (IN(13 + 2 * g)) REPEAT(13 + 2 * g) att::for_units(NBATCH * NH * 8, vcu, G, [&](int u) { att::dil_unit((const bf16_t*)(KA.ws + WS_QKVG), KA.pos, KA.dil_g_q, KA.dil_g_k, KA.rel_bias, g, (bf16_t*)(KA.ws + WS_O2), (float*)(KA.ws + WS_LSE), lds, u >> 7, (u >> 3) & 15, u & 7); });
        SEAM(13 + 2 * g);
    }
    if (IN(18)) REPEAT(18) run_gemm(lds, KA.ws + WS_O2, KA.ws + WS_WO1, DM, DM, EpiResGate{KA.out, KA.out, MOD1 + 2 * DM});
    SEAM(18);
    if (IN(19)) REPEAT(19) lnmod_rows(KA.out, KA.norm_mlp + DM, MOD1, 3, 4, HB, gw, ngw, lane);
    SEAM(19);
    if (IN(20)) REPEAT(20) run_gemm(lds, KA.ws + WS_H, KA.ws + WS_W1_1, DFF, DM, EpiSqRelu{(bf16_t*)(KA.ws + WS_U), DFF, 0});
    SEAM(20);
    if (IN(21)) REPEAT(21) run_gemm(lds, KA.ws + WS_U, KA.ws + WS_W2_1, DM, DFF, EpiResGate{KA.out, KA.out, MOD1 + 5 * DM});
#ifdef TS_A
    xcd_barrier(bar); STAMP(22);
    if (bx == 0 && tid == 0) { __threadfence(); KA.out[0] += (float)(long long)(tsbuf[TS_B] - tsbuf[TS_A]) * 0.01f; }
#endif
#undef IN
#undef SEAM
}

extern "C" void kernel_launch(void* const* d_in, const int* in_sizes, int n_in, void* d_out, int out_size, void* d_ws, size_t ws_size, hipStream_t stream) {
    static int grid = 0;
    if (grid == 0) {
        if (n_in != 22 || ws_size < WS_END || out_size != MTOK * DM) { fprintf(stderr, "kernel_launch: unexpected n_in %d / ws %zu / out %d\n", n_in, ws_size, out_size); grid = -1; return; }
        int dev = 0, cus = 0, per_cu = 0;
        if (hipGetDevice(&dev) != hipSuccess || hipDeviceGetAttribute(&cus, hipDeviceAttributeMultiprocessorCount, dev) != hipSuccess) { grid = -1; return; }
        if (hipFuncSetAttribute((const void*)mega_fwd, hipFuncAttributeMaxDynamicSharedMemorySize, LDS_BYTES) != hipSuccess) { fprintf(stderr, "kernel_launch: hipFuncSetAttribute failed\n"); grid = -1; return; }
        if (hipOccupancyMaxActiveBlocksPerMultiprocessor(&per_cu, (const void*)mega_fwd, NWAVES * 64, LDS_BYTES) != hipSuccess || per_cu < 1) { fprintf(stderr, "kernel_launch: occupancy query says %d blocks per CU\n", per_cu); (void)hipGetLastError(); grid = -1; return; }
        if (per_cu > 1) per_cu = 1;
        grid = cus * per_cu;
    }
    if (grid < 0) return;
    if (hipMemsetAsync((char*)d_ws + WS_CTL, 0, CTL_ZERO_BYTES, stream) != hipSuccess) return;
    Args a{};
    Ptrs& P = a.P;
    P.x = (const float*)d_in[0]; P.c = (const float*)d_in[1]; P.pos = (const int*)d_in[2]; P.ada_w = (const float*)d_in[3]; P.ada_b = (const float*)d_in[4];
    P.norm_mix = (const float*)d_in[5]; P.norm_mlp = (const float*)d_in[6]; P.mlp_w1 = (const float*)d_in[7]; P.mlp_w2 = (const float*)d_in[8];
    P.mla_w_in = (const float*)d_in[9]; P.mla_g_qa = (const float*)d_in[10]; P.mla_w_qb = (const float*)d_in[11]; P.mla_g_kva = (const float*)d_in[12];
    P.mla_w_kvb = (const float*)d_in[13]; P.mla_g_q = (const float*)d_in[14]; P.mla_g_k = (const float*)d_in[15]; P.mla_w_o = (const float*)d_in[16];
    P.dil_w_in = (const float*)d_in[17]; P.dil_g_q = (const float*)d_in[18]; P.dil_g_k = (const float*)d_in[19]; P.dil_w_o = (const float*)d_in[20]; P.rel_bias = (const float*)d_in[21];
    P.out = (float*)d_out; P.ws = (unsigned char*)d_ws;
    unsigned char* ws = P.ws;
    int li = 0;
    auto launch = [&](int lo, int hi) { a.ph_lo = lo; a.ph_hi = hi; a.li = li++; hipLaunchKernelGGL(mega_fwd, dim3(grid), dim3(NWAVES * 64), LDS_BYTES, stream, a); };
#if HYBRID
#if HYBRID == 1
    launch(0, 6);
    naive_mla_attn<<<NBATCH * NH * 8, 256, 0, stream>>>((const bf16_t*)(ws + WS_Q), (const bf16_t*)(ws + WS_KV), (const bf16_t*)(ws + WS_KROPE), (bf16_t*)(ws + WS_H));
    launch(7, 13);
#else
    launch(0, 13);
#endif
    naive_dil_attn<<<NBATCH * NH * 8, 256, 0, stream>>>((const bf16_t*)(ws + WS_QKVG), P.pos, P.dil_g_q, P.dil_g_k, P.rel_bias, 0, 1, (bf16_t*)(ws + WS_O2), (float*)(ws + WS_LSE));
    launch(14, 15);
    naive_dil_attn<<<NBATCH * NH * 8, 256, 0, stream>>>((const bf16_t*)(ws + WS_QKVG), P.pos, P.dil_g_q, P.dil_g_k, P.rel_bias, 1, 4, (bf16_t*)(ws + WS_O2), (float*)(ws + WS_LSE));
    launch(16, 17);
    naive_dil_attn<<<NBATCH * NH * 8, 256, 0, stream>>>((const bf16_t*)(ws + WS_QKVG), P.pos, P.dil_g_q, P.dil_g_k, P.rel_bias, 2, 16, (bf16_t*)(ws + WS_O2), (float*)(ws + WS_LSE));
    launch(18, 22);
#else
    launch(0, NPHASE);
#endif
}
```

```cpp
#include <hip/hip_runtime.h>
#include <cstdint>
#include <cstdio>

#define LAS __attribute__((address_space(3)))
typedef unsigned short bf16_t;
typedef float f32x4 __attribute__((ext_vector_type(4)));
typedef float f32x2 __attribute__((ext_vector_type(2)));
typedef unsigned u32x4 __attribute__((ext_vector_type(4)));
typedef unsigned u32x2 __attribute__((ext_vector_type(2)));
typedef __bf16 bf16x2_t __attribute__((ext_vector_type(2)));

constexpr int DM = 1024, NBATCH = 8, SEQ = 2048, MTOK = NBATCH * SEQ;
constexpr int DFF = 4096, MODW = 6 * DM;
constexpr int QLORA = 384, KVLORA = 256, ROPE = 32, MLA_IN = 672, MLA_INP = 768;
constexpr int NH = 16, QKD = 96, NOPE = 64, VD = 64;
constexpr int DIL_IN = 9216, GCOLS = 3072, NBKT = 32;
constexpr float EPS = 1e-6f;
constexpr float LOG2E = 1.4426950408889634f;
constexpr float MLA_C2 = 0.10206207261596575f * LOG2E;
constexpr float DIL_C2 = 0.125f * LOG2E;

constexpr size_t MiB = 1u << 20;
constexpr size_t WS_CTL = 0, WS_MOD = 1 * MiB, WS_CS = 2 * MiB;
constexpr size_t WS_WIN0 = 4 * MiB, WS_WQB = 5 * MiB + 512 * 1024, WS_WKVB = 7 * MiB, WS_WO0 = 8 * MiB, WS_W1_0 = 10 * MiB, WS_W2_0 = 18 * MiB;
constexpr size_t WS_WIN1 = 26 * MiB, WS_WO1 = 44 * MiB, WS_W1_1 = 46 * MiB, WS_W2_1 = 54 * MiB;
constexpr size_t WS_H = 64 * MiB;
constexpr size_t WS_R = 96 * MiB;
constexpr size_t WS_PROJ = WS_R;
constexpr size_t WS_Q = WS_R;
constexpr size_t WS_KV = WS_R + 48 * MiB;
constexpr size_t WS_KROPE = WS_R + 112 * MiB;
constexpr size_t WS_QA = WS_R + 128 * MiB;
constexpr size_t WS_KVA = WS_R + 140 * MiB;
constexpr size_t WS_KR = WS_R + 148 * MiB;
constexpr size_t WS_U = WS_R;
constexpr size_t WS_QKVG = WS_R;
constexpr size_t WS_O2 = WS_R + 96 * MiB;
constexpr size_t WS_LSE = WS_R + 128 * MiB;
constexpr size_t WS_END = 256 * MiB;

__device__ __forceinline__ float bf2f(unsigned h) { return __uint_as_float(h << 16); }
__device__ __forceinline__ unsigned pk2(float lo, float hi) { f32x2 v = {lo, hi}; bf16x2_t b = __builtin_convertvector(v, bf16x2_t); return __builtin_bit_cast(unsigned, b); }
__device__ __forceinline__ float wave_sum(float v) {
#pragma unroll
    for (int o = 1; o < 64; o <<= 1) v += __shfl_xor(v, o);
    return v;
}
__device__ __forceinline__ void unpack8(u32x4 w, float (&f)[8]) {
    f[0] = bf2f(w.x & 0xffffu); f[1] = bf2f(w.x >> 16); f[2] = bf2f(w.y & 0xffffu); f[3] = bf2f(w.y >> 16);
    f[4] = bf2f(w.z & 0xffffu); f[5] = bf2f(w.z >> 16); f[6] = bf2f(w.w & 0xffffu); f[7] = bf2f(w.w >> 16);
}
__device__ __forceinline__ u32x4 pack8(const float (&f)[8]) { u32x4 w; w.x = pk2(f[0], f[1]); w.y = pk2(f[2], f[3]); w.z = pk2(f[4], f[5]); w.w = pk2(f[6], f[7]); return w; }
#define LDS_WAIT() asm volatile("s_waitcnt lgkmcnt(0)" ::: "memory")

__device__ __forceinline__ int t5_bucket(int rel) {
    const int n = rel < 0 ? -rel : rel;
    int b = n;
    if (n >= 8) b = 8 + (n >= 15) + (n >= 27) + (n >= 50) + (n >= 91) + (n >= 166) + (n >= 305) + (n >= 559);
    return b + (rel > 0 ? 16 : 0);
}

template <int VPERM = 0> __device__ __forceinline__ void transpose_item(const float* W, int K, int ldn, int N, bf16_t* WT, int row_off, LAS float* scr, int item, int lane) {
    const int nblk = N / 32, kb = item / nblk, nb = item % nblk, k0 = 64 * kb, n0 = 32 * nb;
    const int kr = lane >> 3, c4 = (lane & 7) * 4;
    f32x4 v[8];
#pragma unroll
    for (int i = 0; i < 8; ++i) v[i] = *(const f32x4*)(W + (size_t)(k0 + 8 * i + kr) * ldn + n0 + c4);
#pragma unroll
    for (int i = 0; i < 8; ++i) { LAS float* d = scr + (8 * i + kr) * 33 + c4; d[0] = v[i].x; d[1] = v[i].y; d[2] = v[i].z; d[3] = v[i].w; }
    LDS_WAIT();
    const int c = lane & 7;
#pragma unroll
    for (int j = 0; j < 4; ++j) { const int n = (lane >> 3) + 8 * j; const LAS float* s = scr + (8 * c) * 33 + n;
        u32x4 o; o.x = pk2(s[0 * 33], s[1 * 33]); o.y = pk2(s[2 * 33], s[3 * 33]); o.z = pk2(s[4 * 33], s[5 * 33]); o.w = pk2(s[6 * 33], s[7 * 33]);
        int nn = n0 + n;
        if (VPERM == 1) {
            int pos_ = nn & 63; const int hh_ = (nn >> 6) & 3;
            if ((nn % 3072) >= 2048) pos_ = (pos_ & 1) ? 32 + (pos_ >> 1) : (pos_ >> 1);
            nn = (nn & ~255) + 128 * (pos_ >> 5) + 32 * hh_ + (pos_ & 31); }
        if (VPERM == 2) { if (nn & 64) { const int p_ = nn & 63; nn = (nn & ~63) + ((p_ & 1) ? 32 + (p_ >> 1) : (p_ >> 1)); } }
        *(u32x4*)(WT + (size_t)(row_off + nn) * K + k0 + 8 * c) = o; }
    LDS_WAIT();
}

struct Ptrs {
    const float *x, *c; const int* pos; const float *ada_w, *ada_b, *norm_mix, *norm_mlp, *mlp_w1, *mlp_w2;
    const float *mla_w_in, *mla_g_qa, *mla_w_qb, *mla_g_kva, *mla_w_kvb, *mla_g_q, *mla_g_k, *mla_w_o;
    const float *dil_w_in, *dil_g_q, *dil_g_k, *dil_w_o, *rel_bias;
    float* out; unsigned char* ws;
};

__device__ __forceinline__ void p0_weights(const Ptrs& P, LAS float* scr, int gw, int ngw, int lane) {
    unsigned char* ws = P.ws;
    constexpr int I_IN0 = (DM / 64) * (MLA_IN / 32), I_QB = (QLORA / 64) * (1536 / 32), I_KVB = (KVLORA / 64) * (2048 / 32), I_O = (DM / 64) * (DM / 32);
    constexpr int I_1 = (DM / 64) * (DFF / 32), I_2 = (DFF / 64) * (DM / 32), I_IN1 = (DM / 64) * (DIL_IN / 32);
    constexpr int NITEMS = I_IN0 + I_QB + I_KVB + I_O + 2 * I_1 + 2 * I_2 + I_IN1 + I_O;
    for (int it = gw; it < NITEMS; it += ngw) {
        int r = it;
        if (r < I_IN0) { transpose_item(P.mla_w_in, DM, MLA_IN, MLA_IN, (bf16_t*)(ws + WS_WIN0), 0, scr, r, lane); continue; } r -= I_IN0;
        if (r < I_QB) { transpose_item(P.mla_w_qb, QLORA, 1536, 1536, (bf16_t*)(ws + WS_WQB), 0, scr, r, lane); continue; } r -= I_QB;
        if (r < I_KVB) { transpose_item(P.mla_w_kvb, KVLORA, 2048, 2048, (bf16_t*)(ws + WS_WKVB), 0, scr, r, lane); continue; } r -= I_KVB;
        if (r < I_O) { transpose_item(P.mla_w_o, DM, DM, DM, (bf16_t*)(ws + WS_WO0), 0, scr, r, lane); continue; } r -= I_O;
        if (r < I_1) { transpose_item(P.mlp_w1, DM, DFF, DFF, (bf16_t*)(ws + WS_W1_0), 0, scr, r, lane); continue; } r -= I_1;
        if (r < I_1) { transpose_item(P.mlp_w1 + (size_t)DM * DFF, DM, DFF, DFF, (bf16_t*)(ws + WS_W1_1), 0, scr, r, lane); continue; } r -= I_1;
        if (r < I_2) { transpose_item(P.mlp_w2, DFF, DM, DM, (bf16_t*)(ws + WS_W2_0), 0, scr, r, lane); continue; } r -= I_2;
        if (r < I_2) { transpose_item(P.mlp_w2 + (size_t)DFF * DM, DFF, DM, DM, (bf16_t*)(ws + WS_W2_1), 0, scr, r, lane); continue; } r -= I_2;
        if (r < I_IN1) { transpose_item<1>(P.dil_w_in, DM, DIL_IN, DIL_IN, (bf16_t*)(ws + WS_WIN1), 0, scr, r, lane); continue; } r -= I_IN1;
        transpose_item(P.dil_w_o, DM, DM, DM, (bf16_t*)(ws + WS_WO1), 0, scr, r, lane);
    }
    u32x4* z = (u32x4*)(ws + WS_WIN0 + (size_t)MLA_IN * DM * 2);
    for (int i = gw * 64 + lane; i < 12288; i += ngw * 64) z[i] = (u32x4){0u, 0u, 0u, 0u};
}
__device__ __forceinline__ void p0_cs(const Ptrs& P, int gtid, int nthr) {
    float* cs = (float*)(P.ws + WS_CS);
    for (int i = gtid; i < MTOK * 16; i += nthr) { const int m = i >> 4, f = i & 15;
        const float inv = 1.0f / powf(10000.0f, (float)f * 0.0625f); const float ang = (float)P.pos[m] * inv;
        cs[m * 32 + f] = cosf(ang); cs[m * 32 + 16 + f] = sinf(ang); }
}
__device__ __forceinline__ void p0_mod(const Ptrs& P, LAS float* lds, int bid, int nblk, int tid, int nwaves) {
    LAS float* cond = lds; LAS float* red = lds + 8 * DM;
    float* mod = (float*)(P.ws + WS_MOD);
    for (int i = tid; i < 8 * DM; i += nwaves * 64) { const float v = P.c[i]; cond[i] = v / (1.0f + expf(-v)); }
    __syncthreads();
    const int w = tid >> 6, lane = tid & 63, ks = lane >> 3, c4 = (lane & 7) * 4, kper = DM / nwaves;
    for (int item = bid; item < 2 * (MODW / 32); item += nblk) {
        const int l = item / (MODW / 32), n0 = (item % (MODW / 32)) * 32;
        f32x4 acc[8];
#pragma unroll
        for (int b = 0; b < 8; ++b) acc[b] = (f32x4){0.f, 0.f, 0.f, 0.f};
        const float* wp = P.ada_w + (size_t)l * DM * MODW + n0 + c4;
#pragma unroll 2
        for (int kk = 0; kk < kper / 8; kk += 8) {
            f32x4 wv[8];
#pragma unroll
            for (int i = 0; i < 8; ++i) wv[i] = *(const f32x4*)(wp + (size_t)(w * kper + 8 * (kk + i) + ks) * MODW);
#pragma unroll
            for (int i = 0; i < 8; ++i) { const int k = w * kper + 8 * (kk + i) + ks;
#pragma unroll
                for (int b = 0; b < 8; ++b) acc[b] += wv[i] * cond[b * DM + k]; } }
#pragma unroll
        for (int b = 0; b < 8; ++b) {
#pragma unroll
            for (int o = 8; o < 64; o <<= 1) { acc[b].x += __shfl_xor(acc[b].x, o); acc[b].y += __shfl_xor(acc[b].y, o); acc[b].z += __shfl_xor(acc[b].z, o); acc[b].w += __shfl_xor(acc[b].w, o); }
            if (lane < 8) *(LAS f32x4*)(red + (w * 8 + b) * 32 + c4) = acc[b]; }
        __syncthreads();
        if (tid < 256) { const int b = tid >> 5, cc = tid & 31; float s = P.ada_b[l * MODW + n0 + cc];
            for (int ww = 0; ww < nwaves; ++ww) s += red[(ww * 8 + b) * 32 + cc];
            mod[(size_t)(l * 8 + b) * MODW + n0 + cc] = s; }
        __syncthreads();
    }
}
__device__ __forceinline__ void lnmod_rows(const float* X, const float* g, const float* modl  , int shift_idx, int scale_idx, bf16_t* H, int gw, int ngw, int lane) {
    for (int m = gw; m < MTOK; m += ngw) {
        const f32x4* xr = (const f32x4*)(X + (size_t)m * DM) + lane;
        f32x4 v[4]; float ss = 0.f;
#pragma unroll
        for (int j = 0; j < 4; ++j) { v[j] = xr[64 * j]; ss += (v[j].x * v[j].x + v[j].y * v[j].y) + (v[j].z * v[j].z + v[j].w * v[j].w); }
        const float rstd = 1.0f / sqrtf(wave_sum(ss) * (1.0f / DM) + EPS);
        const float* mb = modl + (size_t)(m / SEQ) * MODW;
        u32x2* o = (u32x2*)(H + (size_t)m * DM) + lane;
#pragma unroll
        for (int j = 0; j < 4; ++j) { const int col = 4 * (lane + 64 * j);
            const f32x4 gg = *(const f32x4*)(g + col), sc = *(const f32x4*)(mb + scale_idx * DM + col), sh = *(const f32x4*)(mb + shift_idx * DM + col);
            const f32x4 y = v[j] * rstd * gg * (sc + 1.0f) + sh;
            u32x2 w; w.x = pk2(y.x, y.y); w.y = pk2(y.z, y.w); o[64 * j] = w; }
    }
}
__device__ __forceinline__ void mla_prep_rows(const Ptrs& P, int gw, int ngw, int lane) {
    const float* PROJ = (const float*)(P.ws + WS_PROJ); const float* cs = (const float*)(P.ws + WS_CS);
    bf16_t* QA = (bf16_t*)(P.ws + WS_QA); bf16_t* KVA = (bf16_t*)(P.ws + WS_KVA); float* KR = (float*)(P.ws + WS_KR);
    for (int m = gw; m < MTOK; m += ngw) {
        const float* p = PROJ + (size_t)m * MLA_INP;
        float q[8]; float ss = 0.f;
        if (lane < 48) { const f32x4 a = *(const f32x4*)(p + 8 * lane), b = *(const f32x4*)(p + 8 * lane + 4);
            q[0] = a.x; q[1] = a.y; q[2] = a.z; q[3] = a.w; q[4] = b.x; q[5] = b.y; q[6] = b.z; q[7] = b.w;
#pragma unroll
            for (int i = 0; i < 8; ++i) ss += q[i] * q[i]; }
        else {
#pragma unroll
            for (int i = 0; i < 8; ++i) q[i] = 0.f; }
        const float rq = 1.0f / sqrtf(wave_sum(ss) * (1.0f / QLORA) + EPS);
        if (lane < 48) { float o[8];
#pragma unroll
            for (int i = 0; i < 8; ++i) o[i] = q[i] * rq * P.mla_g_qa[8 * lane + i];
            *(u32x4*)(QA + (size_t)m * QLORA + 8 * lane) = pack8(o); }
        float kv[8]; float s2 = 0.f;
        if (lane < 32) { const f32x4 a = *(const f32x4*)(p + QLORA + 8 * lane), b = *(const f32x4*)(p + QLORA + 8 * lane + 4);
            kv[0] = a.x; kv[1] = a.y; kv[2] = a.z; kv[3] = a.w; kv[4] = b.x; kv[5] = b.y; kv[6] = b.z; kv[7] = b.w;
#pragma unroll
            for (int i = 0; i < 8; ++i) s2 += kv[i] * kv[i]; }
        else {
#pragma unroll
            for (int i = 0; i < 8; ++i) kv[i] = 0.f; }
        const float rk = 1.0f / sqrtf(wave_sum(s2) * (1.0f / KVLORA) + EPS);
        if (lane < 32) { float o[8];
#pragma unroll
            for (int i = 0; i < 8; ++i) o[i] = kv[i] * rk * P.mla_g_kva[8 * lane + i];
            *(u32x4*)(KVA + (size_t)m * KVLORA + 8 * lane) = pack8(o); }
        if (lane < 16) { const float x1 = p[QLORA + KVLORA + lane], x2 = p[QLORA + KVLORA + 16 + lane]; const float c = cs[m * 32 + lane], s = cs[m * 32 + 16 + lane];
            KR[m * 32 + lane] = x1 * c - x2 * s; KR[m * 32 + 16 + lane] = x2 * c + x1 * s; }
    }
}
__device__ __forceinline__ void mla_final_rows(const Ptrs& P, int gw, int ngw, int lane) {
    const float* cs = (const float*)(P.ws + WS_CS); const float* KR = (const float*)(P.ws + WS_KR);
    bf16_t* Q = (bf16_t*)(P.ws + WS_Q); bf16_t* KV = (bf16_t*)(P.ws + WS_KV); bf16_t* KROPE = (bf16_t*)(P.ws + WS_KROPE);
    const int h = lane >> 2, sub = lane & 3;
    for (int m = gw; m < MTOK; m += ngw) {
        float c4[4], s4[4];
#pragma unroll
        for (int t = 0; t < 4; ++t) { c4[t] = cs[m * 32 + 4 * sub + t]; s4[t] = cs[m * 32 + 16 + 4 * sub + t]; }
        {
            bf16_t* qb = Q + (size_t)m * 1536 + h * QKD;
            float a[8], b[8]; unpack8(*(const u32x4*)(qb + 16 * sub), a); unpack8(*(const u32x4*)(qb + 16 * sub + 8), b);
            const u32x2 w1 = *(const u32x2*)(qb + NOPE + 4 * sub), w2 = *(const u32x2*)(qb + NOPE + 16 + 4 * sub);
            const float r1[4] = {bf2f(w1.x & 0xffffu), bf2f(w1.x >> 16), bf2f(w1.y & 0xffffu), bf2f(w1.y >> 16)};
            const float r2[4] = {bf2f(w2.x & 0xffffu), bf2f(w2.x >> 16), bf2f(w2.y & 0xffffu), bf2f(w2.y >> 16)};
            float y1[4], y2[4]; float ss = 0.f;
#pragma unroll
            for (int t = 0; t < 4; ++t) { y1[t] = r1[t] * c4[t] - r2[t] * s4[t]; y2[t] = r2[t] * c4[t] + r1[t] * s4[t]; ss += y1[t] * y1[t] + y2[t] * y2[t]; }
#pragma unroll
            for (int i = 0; i < 8; ++i) ss += a[i] * a[i] + b[i] * b[i];
            ss += __shfl_xor(ss, 1); ss += __shfl_xor(ss, 2);
            const float rs = MLA_C2 / sqrtf(ss * (1.0f / QKD) + EPS);
#pragma unroll
            for (int i = 0; i < 8; ++i) { a[i] *= rs * P.mla_g_q[16 * sub + i]; b[i] *= rs * P.mla_g_q[16 * sub + 8 + i]; }
#pragma unroll
            for (int t = 0; t < 4; ++t) { y1[t] *= rs * P.mla_g_q[NOPE + 4 * sub + t]; y2[t] *= rs * P.mla_g_q[NOPE + 16 + 4 * sub + t]; }
            *(u32x4*)(qb + 16 * sub) = pack8(a); *(u32x4*)(qb + 16 * sub + 8) = pack8(b);
            u32x2 o1, o2; o1.x = pk2(y1[0], y1[1]); o1.y = pk2(y1[2], y1[3]); o2.x = pk2(y2[0], y2[1]); o2.y = pk2(y2[2], y2[3]);
            *(u32x2*)(qb + NOPE + 4 * sub) = o1; *(u32x2*)(qb + NOPE + 16 + 4 * sub) = o2;
        }
        {
            bf16_t* kb = KV + (size_t)m * 2048 + h * 128;
            float a[8], b[8]; unpack8(*(const u32x4*)(kb + 16 * sub), a); unpack8(*(const u32x4*)(kb + 16 * sub + 8), b);
            const f32x4 k1 = *(const f32x4*)(KR + m * 32 + 4 * sub), k2 = *(const f32x4*)(KR + m * 32 + 16 + 4 * sub);
            float ss = (k1.x * k1.x + k1.y * k1.y) + (k1.z * k1.z + k1.w * k1.w) + (k2.x * k2.x + k2.y * k2.y) + (k2.z * k2.z + k2.w * k2.w);
#pragma unroll
            for (int i = 0; i < 8; ++i) ss += a[i] * a[i] + b[i] * b[i];
            ss += __shfl_xor(ss, 1); ss += __shfl_xor(ss, 2);
            const float rs = 1.0f / sqrtf(ss * (1.0f / QKD) + EPS);
#pragma unroll
            for (int i = 0; i < 8; ++i) { a[i] *= rs * P.mla_g_k[16 * sub + i]; b[i] *= rs * P.mla_g_k[16 * sub + 8 + i]; }
            *(u32x4*)(kb + 16 * sub) = pack8(a); *(u32x4*)(kb + 16 * sub + 8) = pack8(b);
            const f32x4 g1 = *(const f32x4*)(P.mla_g_k + NOPE + 4 * sub), g2 = *(const f32x4*)(P.mla_g_k + NOPE + 16 + 4 * sub);
            u32x2 o1, o2; o1.x = pk2(k1.x * rs * g1.x, k1.y * rs * g1.y); o1.y = pk2(k1.z * rs * g1.z, k1.w * rs * g1.w);
            o2.x = pk2(k2.x * rs * g2.x, k2.y * rs * g2.y); o2.y = pk2(k2.z * rs * g2.z, k2.w * rs * g2.w);
            bf16_t* kr = KROPE + (size_t)m * 512 + h * 32;
            *(u32x2*)(kr + 4 * sub) = o1; *(u32x2*)(kr + 16 + 4 * sub) = o2;
        }
    }
}

struct EpiF32 { static constexpr int NV = 4; float* C; int ldc, pad;
    __device__ __forceinline__ void store(int row, int col, const float* v) const { *(f32x4*)(C + (size_t)row * ldc + col) = (f32x4){v[0], v[1], v[2], v[3]}; } };
struct EpiBf16 { static constexpr int NV = 8; bf16_t* C; int ldc, pad;
    __device__ __forceinline__ void store(int row, int col, const float* v) const { u32x4 w; w.x = pk2(v[0], v[1]); w.y = pk2(v[2], v[3]); w.z = pk2(v[4], v[5]); w.w = pk2(v[6], v[7]);
        *(u32x4*)(C + (size_t)row * ldc + col) = w; } };
struct EpiDilQKV { static constexpr int NV = 8; bf16_t* C; int lgD, pad;
    __device__ __forceinline__ void store(int row, int col, const float* v) const { const int b = row >> 11, s = row & 2047, u = ((s & ((1 << lgD) - 1)) << (11 - lgD)) + (s >> lgD);
        const int t = col >> 10, h = (col >> 6) & 15, d = col & 63;
        u32x4 w; w.x = pk2(v[0], v[1]); w.y = pk2(v[2], v[3]); w.z = pk2(v[4], v[5]); w.w = pk2(v[6], v[7]);
        *(u32x4*)(C + ((size_t)((t * NBATCH + b) * NH + h) * SEQ + u) * 64 + d) = w; } };
struct EpiSqRelu { static constexpr int NV = 8; bf16_t* C; int ldc, pad;
    __device__ __forceinline__ void store(int row, int col, const float* v) const { float r[8];
#pragma unroll
        for (int i = 0; i < 8; ++i) { const float t = fmaxf(v[i], 0.f); r[i] = t * t; }
        u32x4 w; w.x = pk2(r[0], r[1]); w.y = pk2(r[2], r[3]); w.z = pk2(r[4], r[5]); w.w = pk2(r[6], r[7]);
        *(u32x4*)(C + (size_t)row * ldc + col) = w; } };
struct EpiResGate { static constexpr int NV = 4; const float* base; float* out; const float* gate  ;
    __device__ __forceinline__ void store(int row, int col, const float* v) const {
        const f32x4 b = *(const f32x4*)(base + (size_t)row * DM + col), g = *(const f32x4*)(gate + (size_t)(row / SEQ) * MODW + col);
        *(f32x4*)(out + (size_t)row * DM + col) = b + g * (f32x4){v[0], v[1], v[2], v[3]}; } };

namespace pg8 {
#define PG8_LAS __attribute__((address_space(3)))
typedef unsigned short bf16_t;
typedef short bf16x8 __attribute__((ext_vector_type(8)));
typedef float f32x4 __attribute__((ext_vector_type(4)));
typedef unsigned u32x4 __attribute__((ext_vector_type(4)));
constexpr int BM = 256, BK = 64, HALF = 128, HTB = HALF * BK * 2  , STAGE_BYTES = 8 * HTB, NXCD = 8, WGM = 8;

__host__ __device__ __forceinline__ int lds_byte(int r, int c) { const int st = (r >> 4) * 2 + (c >> 5), rr = r & 15, cc = c & 31, ob = rr * 64 + cc * 2; return st * 1024 + (ob ^ (((ob >> 9) & 1) << 5)); }
__host__ __device__ __forceinline__ void stage_rc(int b, int& R, int& C) { const int st = b / 1024, sb = b % 1024, swz = sb ^ (((sb >> 9) & 1) << 5); R = (st >> 1) * 16 + swz / 64; C = (st & 1) * 32 + (swz % 64) / 2; }
__host__ __device__ __forceinline__ int perm32(int rho) { const int n = rho >> 4, i = rho & 15; return 8 * (i >> 2) + 4 * n + (i & 3); }

struct Unit { int pm, pn; };
struct Gemm { const bf16_t* A; const bf16_t* Bt; int M, N, K; };

struct StaticOrder {
    int nM, nN, nwg, G, c;
    __host__ __device__ void init(int M, int N, int G_, int c_) { nM = M / BM; nN = N / BM; nwg = nM * nN; G = G_; c = c_; }
    __host__ __device__ bool next(int i, Unit& u) const {
        const long L = (long)i * G + c; if (L >= nwg) return false;
        int wgid = (int)L; { const int q = nwg / NXCD, r = nwg % NXCD, xcd = wgid % NXCD, off = wgid / NXCD; wgid = (xcd < r ? xcd * (q + 1) : r * (q + 1) + (xcd - r) * q) + off; }
        const int nig = WGM * nN, gid = wgid / nig, fm = gid * WGM, gsz = (nM - fm) < WGM ? (nM - fm) : WGM;
        u.pm = fm + ((wgid % nig) % gsz); u.pn = (wgid % nig) / gsz; return true;
    }
    __device__ __forceinline__ void a_ready(const Unit&) const {}
    __device__ __forceinline__ void done(const Unit&) const {}
};

template <class Epi, class Sched, bool ALIGN_EPI = false, bool SP2 = false>
__device__ __forceinline__ void gemm_phase(PG8_LAS unsigned char* lds, const Gemm g, const Sched& S, const Epi& E) {
    int tid_ = threadIdx.x; asm volatile("" : "+v"(tid_));
    const int tid = tid_, wid = __builtin_amdgcn_readfirstlane(tid >> 6), lane = tid & 63, wr = wid >> 2, wc = wid & 3, fr = lane & 15, fq = lane >> 4;
    const int K = g.K, nt = K / BK;
    unsigned voffA[2], voffB[2];
#pragma unroll
    for (int i = 0; i < 2; ++i) { int R, C; stage_rc(tid * 16 + i * 8192, R, C); const int Rb = Epi::PERM ? ((R & ~31) + perm32(R & 31)) : R;
        voffA[i] = (unsigned)(R * K + C) * 2u; voffB[i] = (unsigned)(Rb * K + C) * 2u; }
    const size_t kstep = (size_t)(BK * 2);
    const size_t hstep = (size_t)HALF * K * 2;
    const size_t tstep = 2 * hstep;
    const unsigned ldsw = (unsigned)wid * 1024u;
    const int aoff = lds_byte(wr * 64 + fr, fq * 8), boff = lds_byte(wc * 32 + fr, fq * 8);
#define PG8_SA(b, h) (((b) * 2 + (h)) * HTB)
#define PG8_SB(b, h) ((4 + (b) * 2 + (h)) * HTB)
#define PG8_STAGE(bufoff, gbase, voff) do { _Pragma("unroll") for (int _i = 0; _i < 2; ++_i) \
        __builtin_amdgcn_global_load_lds((const unsigned*)((const char*)(gbase) + (voff)[_i]), (PG8_LAS unsigned*)(lds + (bufoff) + ldsw + _i * 8192), 16, 0, 0); } while (0)
#define PG8_LDA(dst, b, h) do { _Pragma("unroll") for (int m = 0; m < 4; ++m) _Pragma("unroll") for (int k = 0; k < 2; ++k) dst[m][k] = *(const PG8_LAS bf16x8*)(lds + PG8_SA(b, h) + aoff + m * 2048 + k * 1024); } while (0)
#define PG8_LDB(dst, b, h) do { _Pragma("unroll") for (int n = 0; n < 2; ++n) _Pragma("unroll") for (int k = 0; k < 2; ++k) dst[n][k] = *(const PG8_LAS bf16x8*)(lds + PG8_SB(b, h) + boff + n * 2048 + k * 1024); } while (0)
#define PG8_MMA(ai, bj, At, Bt) do { __builtin_amdgcn_s_setprio(1); _Pragma("unroll") for (int m = 0; m < 4; ++m) _Pragma("unroll") for (int n = 0; n < 2; ++n) _Pragma("unroll") for (int k = 0; k < 2; ++k) \
        acc[ai][bj][m][n] = __builtin_amdgcn_mfma_f32_16x16x32_bf16(Bt[n][k], At[m][k], acc[ai][bj][m][n], 0, 0, 0); __builtin_amdgcn_s_setprio(0); } while (0)
#define PG8_WAIT_V(n) asm volatile("s_waitcnt vmcnt(" #n ")" ::: "memory")
#define PG8_WAIT_L(n) asm volatile("s_waitcnt lgkmcnt(" #n ")" ::: "memory")
#define PG8_BAR __builtin_amdgcn_s_barrier()
#define PG8_SCHED __builtin_amdgcn_sched_barrier(0)
    Unit cur, nxt; int ui = 0;
    if (!S.next(0, cur)) return;
    f32x4 acc[2][2][4][2];
#pragma unroll
    for (int a = 0; a < 2; ++a)
#pragma unroll
        for (int b = 0; b < 2; ++b)
#pragma unroll
            for (int m = 0; m < 4; ++m)
#pragma unroll
                for (int n = 0; n < 2; ++n) acc[a][b][m][n] = (f32x4){0.f, 0.f, 0.f, 0.f};
    bf16x8 At[4][2], B0[2][2], B1[2][2];
    const char* cA = (const char*)g.A + (size_t)cur.pm * tstep; const char* cB = (const char*)g.Bt + (size_t)cur.pn * tstep;
    S.a_ready(cur);
    if constexpr (SP2) {
        PG8_STAGE(PG8_SB(0, 0), cB, voffB); PG8_STAGE(PG8_SB(0, 1), cB + hstep, voffB); PG8_STAGE(PG8_SA(0, 0), cA, voffA); PG8_STAGE(PG8_SA(0, 1), cA + hstep, voffA);
        if (wr == 1) PG8_BAR;
        PG8_WAIT_V(2); PG8_BAR;
        PG8_STAGE(PG8_SB(1, 0), cB + kstep, voffB); PG8_STAGE(PG8_SA(1, 0), cA + kstep, voffA); PG8_STAGE(PG8_SB(1, 1), cB + hstep + kstep, voffB);
        PG8_WAIT_V(6); PG8_BAR;
    } else {
        PG8_STAGE(PG8_SB(0, 0), cB, voffB); PG8_STAGE(PG8_SA(0, 0), cA, voffA); PG8_STAGE(PG8_SB(0, 1), cB + hstep, voffB); PG8_STAGE(PG8_SA(0, 1), cA + hstep, voffA);
        if (wr == 1) PG8_BAR;
        PG8_WAIT_V(4); PG8_BAR;
        PG8_STAGE(PG8_SB(1, 0), cB + kstep, voffB); PG8_STAGE(PG8_SA(1, 0), cA + kstep, voffA); PG8_STAGE(PG8_SB(1, 1), cB + hstep + kstep, voffB);
        PG8_WAIT_V(6); PG8_BAR;
    }
    for (;;) {
        const bool has_next = S.next(ui + 1, nxt);
        const char* nA = has_next ? (const char*)g.A + (size_t)nxt.pm * tstep : cA; const char* nB = has_next ? (const char*)g.Bt + (size_t)nxt.pn * tstep : cB;
        for (int t = 0; t < nt; t += 2) {
            const bool last = (t == nt - 2);
            const char* a1 = cA + (size_t)(t + 1) * kstep;
            const char* a2 = last ? nA : cA + (size_t)(t + 2) * kstep; const char* b2 = last ? nB : cB + (size_t)(t + 2) * kstep;
            const char* a3 = a2 + kstep; const char* b3 = b2 + kstep;
            if (last && has_next) S.a_ready(nxt);
            if constexpr (SP2) {
            PG8_LDB(B0, 0, 0); PG8_LDB(B1, 0, 1); PG8_SCHED; PG8_LDA(At, 0, 0); PG8_STAGE(PG8_SA(1, 1), a1 + hstep, voffA);
            PG8_WAIT_V(8); PG8_WAIT_L(0); PG8_BAR; PG8_MMA(0, 0, At, B0); PG8_MMA(0, 1, At, B1); PG8_BAR; PG8_SCHED;
            PG8_LDA(At, 0, 1); PG8_STAGE(PG8_SB(0, 0), b2, voffB); PG8_STAGE(PG8_SB(0, 1), b2 + hstep, voffB); PG8_STAGE(PG8_SA(0, 0), a2, voffA);
            PG8_WAIT_V(8); PG8_WAIT_L(0); PG8_BAR; PG8_MMA(1, 0, At, B0); PG8_MMA(1, 1, At, B1); PG8_BAR; PG8_SCHED;
            PG8_LDB(B0, 1, 0); PG8_LDB(B1, 1, 1); PG8_SCHED; PG8_LDA(At, 1, 0); PG8_STAGE(PG8_SA(0, 1), a2 + hstep, voffA);
            PG8_WAIT_V(8); PG8_WAIT_L(0); PG8_BAR; PG8_MMA(0, 0, At, B0); PG8_MMA(0, 1, At, B1); PG8_BAR; PG8_SCHED;
            PG8_LDA(At, 1, 1); PG8_STAGE(PG8_SB(1, 0), b3, voffB); PG8_STAGE(PG8_SB(1, 1), b3 + hstep, voffB); PG8_STAGE(PG8_SA(1, 0), a3, voffA);
            PG8_WAIT_V(8); PG8_WAIT_L(0); PG8_BAR; PG8_MMA(1, 0, At, B0); PG8_MMA(1, 1, At, B1); PG8_BAR; PG8_SCHED;
            } else {
            PG8_LDB(B0, 0, 0); PG8_SCHED; PG8_LDA(At, 0, 0); PG8_STAGE(PG8_SA(1, 1), a1 + hstep, voffA);
            PG8_WAIT_L(8); PG8_BAR; PG8_WAIT_L(0); PG8_MMA(0, 0, At, B0); PG8_BAR; PG8_SCHED;
            PG8_LDB(B1, 0, 1); PG8_STAGE(PG8_SB(0, 0), b2, voffB);
            PG8_BAR; PG8_WAIT_L(0); PG8_MMA(0, 1, At, B1); PG8_BAR;
            PG8_LDA(At, 0, 1); PG8_STAGE(PG8_SA(0, 0), a2, voffA);
            PG8_BAR; PG8_WAIT_L(0); PG8_MMA(1, 0, At, B0); PG8_BAR; PG8_SCHED;
            PG8_STAGE(PG8_SB(0, 1), b2 + hstep, voffB);
            PG8_WAIT_V(6); PG8_BAR; PG8_MMA(1, 1, At, B1); PG8_BAR;
            PG8_LDB(B0, 1, 0); PG8_SCHED; PG8_LDA(At, 1, 0); PG8_STAGE(PG8_SA(0, 1), a2 + hstep, voffA);
            PG8_WAIT_L(8); PG8_BAR; PG8_WAIT_L(0); PG8_MMA(0, 0, At, B0); PG8_BAR; PG8_SCHED;
            PG8_LDB(B1, 1, 1); PG8_STAGE(PG8_SB(1, 0), b3, voffB);
            PG8_BAR; PG8_WAIT_L(0); PG8_MMA(0, 1, At, B1); PG8_BAR;
            PG8_LDA(At, 1, 1); PG8_STAGE(PG8_SA(1, 0), a3, voffA);
            PG8_BAR; PG8_WAIT_L(0); PG8_MMA(1, 0, At, B0); PG8_BAR; PG8_SCHED;
            PG8_STAGE(PG8_SB(1, 1), b3 + hstep, voffB);
            PG8_WAIT_V(6); PG8_BAR; PG8_MMA(1, 1, At, B1); PG8_BAR;
            }
        }
        if constexpr (ALIGN_EPI) { if (wr == 0) PG8_BAR; }
        if constexpr (!Epi::AFTER_DRAIN) { E(acc, cur, wr, wc, fr, fq); S.done(cur); }
        if (!has_next) break;
#pragma unroll
        for (int a = 0; a < 2; ++a)
#pragma unroll
            for (int b = 0; b < 2; ++b)
#pragma unroll
                for (int m = 0; m < 4; ++m)
#pragma unroll
                    for (int n = 0; n < 2; ++n) acc[a][b][m][n] = (f32x4){0.f, 0.f, 0.f, 0.f};
        cur = nxt; cA = nA; cB = nB; ++ui;
        if constexpr (ALIGN_EPI) { if (wr == 1) PG8_BAR; }
    }
    PG8_WAIT_V(0);
    if constexpr (!ALIGN_EPI) { if (wr == 0) PG8_BAR; }
    PG8_BAR;
    if constexpr (Epi::AFTER_DRAIN) { E.fused(acc, cur, wr, wc, fr, fq, lds, wid, lane); S.done(cur); }
#undef PG8_SA
#undef PG8_SB
#undef PG8_STAGE
#undef PG8_LDA
#undef PG8_LDB
#undef PG8_MMA
#undef PG8_WAIT_V
#undef PG8_WAIT_L
#undef PG8_BAR
#undef PG8_SCHED
}
}
#define XB_TMO      128
#define XB_XCNT(j)  (256  + 64 * (j))
#define XB_XSUB(j)  (1280 + 64 * (j))
#define XB_XGEN(j)  (2304 + 64 * (j))
#define XB_TOP      3328
#define XB_TOPGEN   3392
#define XCD_BAR_WORDS 3456
#define XB_SPIN_CAP (1u << 18)

__device__ __forceinline__ unsigned xb_ld(unsigned* p)              { return __hip_atomic_load(p, __ATOMIC_RELAXED, __HIP_MEMORY_SCOPE_AGENT); }
__device__ __forceinline__ unsigned xb_add(unsigned* p, unsigned v) { return __hip_atomic_fetch_add(p, v, __ATOMIC_RELAXED, __HIP_MEMORY_SCOPE_AGENT); }
__device__ __forceinline__ unsigned xb_xcc_id() { return (unsigned)__builtin_amdgcn_s_getreg((3 << 11) | 20) & 0xFu; }
#define XB_SPIN(cond, bar) do { unsigned _sp = 0; while (cond) { __builtin_amdgcn_s_sleep(1); \
    if ((++_sp & 255u) == 0u) { if (xb_ld(&(bar)[XB_TMO])) break; if (_sp > XB_SPIN_CAP) { atomicAdd(&(bar)[XB_TMO], 1u); break; } } } } while (0)

struct XcdBarrier {
    unsigned* bar; unsigned x;
    volatile LAS unsigned* st;
};

__device__ __forceinline__ XcdBarrier xcd_barrier_post(unsigned* bar, volatile LAS unsigned* st) {
    XcdBarrier b; b.bar = bar; b.x = xb_xcc_id(); b.st = st;
    if (threadIdx.x == 0) (void)xb_add(&bar[XB_XCNT(b.x)], 1u);
    return b;
}
__device__ __forceinline__ void xcd_barrier_complete(unsigned* bar, unsigned x, unsigned& nloc, unsigned& nx) {
    const unsigned G = gridDim.x * gridDim.y * gridDim.z;
    unsigned sum, cnt, mine, sp = 0u;
    for (;;) {
        sum = 0u; cnt = 0u; mine = 0u;
#pragma unroll
        for (unsigned j = 0; j < 16; ++j) { const unsigned c = xb_ld(&bar[XB_XCNT(j)]); sum += c; cnt += (c > 0u) ? 1u : 0u; mine = (j == x) ? c : mine; }
        if (sum == G) break;
        __builtin_amdgcn_s_sleep(1);
        if ((++sp & 255u) == 0u) { if (xb_ld(&bar[XB_TMO])) break; if (sp > XB_SPIN_CAP) { atomicAdd(&bar[XB_TMO], 1u); break; } }
    }
    nloc = mine > 0u ? mine : 1u; nx = cnt > 0u ? cnt : 1u;
}

__device__ __forceinline__ void xcd_barrier(const XcdBarrier& b) {
    asm volatile("s_waitcnt vmcnt(0)" ::: "memory");
    __syncthreads();
    if (threadIdx.x == 0) {
        unsigned* bar = b.bar;
        __builtin_amdgcn_s_waitcnt(0);
        unsigned nloc = b.st[0], nx = b.st[1];
        if (nloc == 0u) { xcd_barrier_complete(bar, b.x, nloc, nx); b.st[0] = nloc; b.st[1] = nx; }
        const unsigned old = xb_add(&bar[XB_XSUB(b.x)], 1u);
        const unsigned gen = old / nloc;
        if (old + 1u == (gen + 1u) * nloc) {
            __builtin_amdgcn_fence(__ATOMIC_RELEASE, "agent");
            asm volatile("s_waitcnt vmcnt(0)" ::: "memory");
            const unsigned og = xb_add(&bar[XB_TOP], 1u);
            const unsigned tg = og / nx;
            if (og + 1u == (tg + 1u) * nx) xb_add(&bar[XB_TOPGEN], 1u);
            else XB_SPIN(xb_ld(&bar[XB_TOPGEN]) == tg, bar);
            __builtin_amdgcn_fence(__ATOMIC_ACQUIRE, "agent");
            xb_add(&bar[XB_XGEN(b.x)], 1u);
            asm volatile("s_waitcnt vmcnt(0)" ::: "memory");
        } else {
            XB_SPIN(xb_ld(&bar[XB_XGEN(b.x)]) == gen, bar);
            __builtin_amdgcn_fence(__ATOMIC_ACQUIRE, "agent");
            asm volatile("s_waitcnt vmcnt(0)" ::: "memory");
        }
    }
    __syncthreads();
}
namespace att {
typedef short bf16x8 __attribute__((ext_vector_type(8)));
typedef short s16x4 __attribute__((ext_vector_type(4)));
typedef float f32x16 __attribute__((ext_vector_type(16)));
__device__ __forceinline__ int crow(int r, int hi) { return (r & 3) + 8 * (r >> 2) + 4 * hi; }
template <int NCB> __device__ __forceinline__ int v_st(int k, int c) { const int kk = (k & ~0xC) | ((k & 4) << 1) | ((k & 8) >> 1); return ((kk >> 3) * NCB + (c >> 5)) * 512 + ((kk & 7) * 32 + (c & 31)) * 2; }
__device__ __forceinline__ int v_rd_base(int lane) { return ((lane & 3) << 3) | (((lane >> 2) & 3) << 6) | (((lane >> 4) & 1) << 5) | (((lane >> 5) & 1) << 8); }
__device__ __forceinline__ s16x4 vtr(const LAS unsigned char* p) { typedef short v4i16_t __attribute__((ext_vector_type(4)));
    return __builtin_bit_cast(s16x4, __builtin_amdgcn_ds_read_tr16_b64_v4i16((LAS v4i16_t*)p)); }
__device__ __forceinline__ float swap_max(float v) { auto rr = __builtin_amdgcn_permlane32_swap(__float_as_uint(v), __float_as_uint(v), false, false); return fmaxf(__uint_as_float(rr[0]), __uint_as_float(rr[1])); }
__device__ __forceinline__ float swap_add(float v) { auto rr = __builtin_amdgcn_permlane32_swap(__float_as_uint(v), __float_as_uint(v), false, false); return __uint_as_float(rr[0]) + __uint_as_float(rr[1]); }
#define ATT_PK4(P, BASE, OUT) do { const unsigned a0_ = pk2(P[BASE + 0], P[BASE + 1]), a1_ = pk2(P[BASE + 2], P[BASE + 3]); \
    const unsigned b0_ = pk2(P[BASE + 4], P[BASE + 5]), b1_ = pk2(P[BASE + 6], P[BASE + 7]); \
    auto r0_ = __builtin_amdgcn_permlane32_swap(a0_, b0_, false, false); auto r1_ = __builtin_amdgcn_permlane32_swap(a1_, b1_, false, false); \
    u32x4 w_ = {r0_[0], r1_[0], r0_[1], r1_[1]}; OUT = __builtin_bit_cast(bf16x8, w_); } while (0)

constexpr int KPITCH = 208, KTILE = 64 * KPITCH, VTILE = 64 * 64 * 2;
constexpr int OFF_K = 0, OFF_V = 2 * KTILE, OFF_WS = OFF_V + 2 * VTILE, MLA_LDS = OFF_WS + 8 * 64 * 4;
static_assert(MLA_LDS <= 131072 && (OFF_V % 16) == 0 && (KTILE % 16) == 0, "MLA attention LDS map");

__device__ __forceinline__ void mla_unit(const bf16_t* Q, const bf16_t* KV, const bf16_t* KROPE, bf16_t* O, LAS unsigned char* lds, int b, int h, int qb) {
    int tid_ = threadIdx.x; asm volatile("" : "+v"(tid_));
    const int tid = tid_, lane = tid & 63, r32 = lane & 31, hi = lane >> 5, wid = __builtin_amdgcn_readfirstlane(tid >> 6);
    const size_t row0 = (size_t)b * SEQ;
    const bf16_t* ksrc = KV + (row0 + (tid >> 3)) * 2048 + h * 128 + (tid & 7) * 8;
    const bf16_t* rsrc = KROPE + (row0 + (tid >> 2)) * 512 + h * 32 + (tid & 3) * 8;
    const int kdst = OFF_K + (tid >> 3) * KPITCH + (tid & 7) * 16;
    const int rdst = OFF_K + (tid >> 2) * KPITCH + 128 + (tid & 3) * 16;
    const int vdst = OFF_V + v_st<2>(tid >> 3, (tid & 7) * 8);
    const bool has_r = wid < 4;
    const bf16_t* qp = Q + (row0 + qb * 256 + wid * 32 + r32) * 1536 + h * QKD + hi * 8;
    bf16x8 qr[6];
#pragma unroll
    for (int d0 = 0; d0 < 6; ++d0) qr[d0] = *(const bf16x8*)(qp + 16 * d0);
    f32x16 o0, o1;
#pragma unroll
    for (int r = 0; r < 16; ++r) { o0[r] = 0.f; o1[r] = 0.f; }
    float m = -1e30f, l = 0.f;
    LAS float* wsf = (LAS float*)(lds + OFF_WS) + wid * 64;
    u32x4 kreg, rreg = {0u, 0u, 0u, 0u}, vreg;
#define ATT_LOAD(t) do { kreg = *(const u32x4*)(ksrc + (size_t)(t) * 64 * 2048); vreg = *(const u32x4*)(ksrc + (size_t)(t) * 64 * 2048 + 64); if (has_r) rreg = *(const u32x4*)(rsrc + (size_t)(t) * 64 * 512); } while (0)
#define ATT_WRITE(buf) do { *(LAS u32x4*)(lds + kdst + (buf) * KTILE) = kreg; *(LAS u32x4*)(lds + vdst + (buf) * VTILE) = vreg; if (has_r) *(LAS u32x4*)(lds + rdst + (buf) * KTILE) = rreg; } while (0)
    ATT_LOAD(0); ATT_WRITE(0); ATT_LOAD(1);
    const int NT = SEQ / 64;
#pragma unroll 1
    for (int t = 0; t < NT; ++t) {
        __syncthreads();
        const int cur = t & 1;
        if (t + 1 < NT) { ATT_WRITE(cur ^ 1); if (t + 2 < NT) ATT_LOAD(t + 2); }
        f32x16 p0, p1;
#pragma unroll
        for (int r = 0; r < 16; ++r) { p0[r] = 0.f; p1[r] = 0.f; }
        const LAS unsigned char* kb = lds + OFF_K + cur * KTILE + r32 * KPITCH + hi * 16;
#pragma unroll
        for (int d0 = 0; d0 < 6; ++d0) {
            const bf16x8 a0 = *(const LAS bf16x8*)(kb + d0 * 32), a1 = *(const LAS bf16x8*)(kb + 32 * KPITCH + d0 * 32);
            p0 = __builtin_amdgcn_mfma_f32_32x32x16_bf16(a0, qr[d0], p0, 0, 0, 0);
            p1 = __builtin_amdgcn_mfma_f32_32x32x16_bf16(a1, qr[d0], p1, 0, 0, 0); }
        float pmax = fmaxf(p0[0], p1[0]);
#pragma unroll
        for (int r = 1; r < 16; ++r) pmax = fmaxf(pmax, fmaxf(p0[r], p1[r]));
        pmax = swap_max(pmax);
        const float mn = fmaxf(m, pmax), alpha = __builtin_amdgcn_exp2f(m - mn); m = mn;
        float ps = 0.f;
#pragma unroll
        for (int r = 0; r < 16; ++r) { p0[r] = __builtin_amdgcn_exp2f(p0[r] - mn); p1[r] = __builtin_amdgcn_exp2f(p1[r] - mn); ps += p0[r] + p1[r]; }
        ps = swap_add(ps);
        l = l * alpha + ps;
        if (hi == 0) wsf[r32] = alpha;
#pragma unroll
        for (int r = 0; r < 16; ++r) { const float a = wsf[crow(r, hi)]; o0[r] *= a; o1[r] *= a; }
        bf16x8 pa0, pa1, pa2, pa3;
        ATT_PK4(p0, 0, pa0); ATT_PK4(p0, 8, pa1); ATT_PK4(p1, 0, pa2); ATT_PK4(p1, 8, pa3);
        const LAS unsigned char* vb = lds + OFF_V + cur * VTILE + v_rd_base(lane);
#define ATT_VF(d0, ks) ({ const s16x4 lo_ = vtr(vb + (d0) * 512 + (ks) * 2048), hi_ = vtr(vb + (d0) * 512 + (ks) * 2048 + 1024); (bf16x8){lo_[0], lo_[1], lo_[2], lo_[3], hi_[0], hi_[1], hi_[2], hi_[3]}; })
        o0 = __builtin_amdgcn_mfma_f32_32x32x16_bf16(pa0, ATT_VF(0, 0), o0, 0, 0, 0); o1 = __builtin_amdgcn_mfma_f32_32x32x16_bf16(pa0, ATT_VF(1, 0), o1, 0, 0, 0);
        o0 = __builtin_amdgcn_mfma_f32_32x32x16_bf16(pa1, ATT_VF(0, 1), o0, 0, 0, 0); o1 = __builtin_amdgcn_mfma_f32_32x32x16_bf16(pa1, ATT_VF(1, 1), o1, 0, 0, 0);
        o0 = __builtin_amdgcn_mfma_f32_32x32x16_bf16(pa2, ATT_VF(0, 2), o0, 0, 0, 0); o1 = __builtin_amdgcn_mfma_f32_32x32x16_bf16(pa2, ATT_VF(1, 2), o1, 0, 0, 0);
        o0 = __builtin_amdgcn_mfma_f32_32x32x16_bf16(pa3, ATT_VF(0, 3), o0, 0, 0, 0); o1 = __builtin_amdgcn_mfma_f32_32x32x16_bf16(pa3, ATT_VF(1, 3), o1, 0, 0, 0);
    }
    if (hi == 0) wsf[32 + r32] = l;
    bf16_t* op = O + (row0 + qb * 256 + wid * 32) * DM + h * VD + r32;
#pragma unroll
    for (int r = 0; r < 16; ++r) { const float rl = 1.0f / wsf[32 + crow(r, hi)]; const unsigned w = pk2(o0[r] * rl, o1[r] * rl);
        op[(size_t)crow(r, hi) * DM] = (bf16_t)(w & 0xffffu); op[(size_t)crow(r, hi) * DM + 32] = (bf16_t)(w >> 16); }
#undef ATT_LOAD
#undef ATT_WRITE
#undef ATT_VF
}
template <class F> __device__ __forceinline__ void for_units(int nunits, int vcu, int G, F f) {
    if (nunits % G == 0) { const int per = nunits / G; for (int i = 0; i < per; ++i) f(vcu * per + i); }
    else for (int u = vcu; u < nunits; u += G) f(u);
}
}
namespace att {
constexpr int DK_PITCH = 144, DROWS = 384;
constexpr int DOFF_K = 0, DOFF_V = DROWS * DK_PITCH  , DOFF_POS = DOFF_V + (DROWS / 16) * 2048  , DOFF_LUT = DOFF_POS + DROWS * 4  , DOFF_WS = DOFF_LUT + 4864  , DIL_LDS = DOFF_WS + 8 * 96 * 4;
static_assert(DIL_LDS <= 131072 && (DOFF_V % 16) == 0 && (DOFF_WS % 16) == 0, "dilated attention LDS map");
constexpr int LUT_R = 600;

struct DilRegs { u32x4 kw[6], vw[6]; int pk; };
__device__ __forceinline__ void dil_prefetch(DilRegs& R, const bf16_t* QKVG, const int* pos, int g, int b, int h, int j, int tid) {
    const int lgD = 2 * g, lgL = 11 - lgD, Lm1 = (1 << lgL) - 1; const size_t row0 = (size_t)b * SEQ; const int u0 = 256 * j, ch = tid & 7;
    const bf16_t* kbase = QKVG + ((size_t)((NBATCH + b) * NH + h) * SEQ) * 64 + ch * 8;
#pragma unroll
    for (int k = 0; k < 6; ++k) { const int i = (tid >> 3) + 64 * k, u = u0 - 64 + i; const bool ok = (u >= 0) && (u < SEQ);
        const bf16_t* src = kbase + (size_t)(ok ? u : 0) * 64;
        R.kw[k] = *(const u32x4*)src; R.vw[k] = *(const u32x4*)(src + (size_t)NBATCH * NH * SEQ * 64); }
    { const int u = u0 - 64 + (tid < DROWS ? tid : 0); const bool ok = (u >= 0) && (u < SEQ); const int s = ((u & Lm1) << lgD) + (u >> lgL); R.pk = pos[row0 + (ok ? s : 0)]; }
}
__device__ __forceinline__ void dil_unit(DilRegs& R, int un, const bf16_t* QKVG, const int* pos, int g, bf16_t* O2, float* LSE, LAS unsigned char* lds, int b, int h, int j, int tid) {
    const int lane = tid & 63, r32 = lane & 31, hi = lane >> 5, wid = __builtin_amdgcn_readfirstlane(tid >> 6);
    const int lgD = 2 * g, lgL = 11 - lgD, Lm1 = (1 << lgL) - 1;
    const size_t row0 = (size_t)b * SEQ; const int u0 = 256 * j;
    LAS float* lut = (LAS float*)(lds + DOFF_LUT); LAS int* posk = (LAS int*)(lds + DOFF_POS);
    if (tid < DROWS) posk[tid] = R.pk;
    const int ch = tid & 7;
#pragma unroll
    for (int k = 0; k < 6; ++k) {
        const int i = (tid >> 3) + 64 * k; const int u = u0 - 64 + i; const bool ok = (u >= 0) && (u < SEQ);
        u32x4 kw = R.kw[k], vw = R.vw[k];
        if (!ok) { kw = (u32x4){0u, 0u, 0u, 0u}; vw = kw; }
        *(LAS u32x4*)(lds + DOFF_K + i * DK_PITCH + ch * 16) = kw;
        *(LAS u32x4*)(lds + DOFF_V + (i >> 6) * 8192 + v_st<2>(i & 63, ch * 8)) = vw;
    }
    if (un >= 0) dil_prefetch(R, QKVG, pos, g, un >> 7, (un >> 3) & 15, un & 7, tid);
    const int uq = u0 + 32 * wid + r32; const int sq = ((uq & Lm1) << lgD) + (uq >> lgL); const size_t grow = row0 + sq;
    const int posq = pos[grow];
    bf16x8 qr[4];
#pragma unroll
    for (int d0 = 0; d0 < 4; ++d0) qr[d0] = *(const bf16x8*)(QKVG + ((size_t)(b * NH + h) * SEQ + uq) * 64 + 16 * d0 + 8 * hi);
    __syncthreads();
    const int seq0 = ((u0 + 32 * wid) >> lgL) << lgL;
    const int klo = seq0 - u0 + 64, khi = klo + (1 << lgL);
    const int a_lo = max(klo, 32 * wid + r32), a_hi = min(khi - 1, 32 * wid + r32 + 128);
    const unsigned a_span = (unsigned)(a_hi - a_lo);
    f32x16 p[5];
#pragma unroll
    for (int ht = 0; ht < 5; ++ht) {
        const int i0 = 32 * (wid + ht);
#pragma unroll
        for (int r = 0; r < 16; ++r) p[ht][r] = 0.f;
        const LAS unsigned char* kb = lds + DOFF_K + (i0 + r32) * DK_PITCH + hi * 16;
#pragma unroll
        for (int d0 = 0; d0 < 4; ++d0) p[ht] = __builtin_amdgcn_mfma_f32_32x32x16_bf16(*(const LAS bf16x8*)(kb + d0 * 32), qr[d0], p[ht], 0, 0, 0);
        float bias[16];
#pragma unroll
        for (int r = 0; r < 16; ++r) { int rel = posk[i0 + crow(r, hi)] - posq; rel = min(max(rel, -LUT_R), LUT_R); bias[r] = lut[rel + LUT_R]; }
#pragma unroll
        for (int r = 0; r < 16; ++r) { const bool valid = (unsigned)(i0 + crow(r, hi) - a_lo) <= a_span; const float sb = p[ht][r] + bias[r]; p[ht][r] = valid ? sb : -INFINITY; }
    }
    float mx = p[0][0];
#pragma unroll
    for (int ht = 0; ht < 5; ++ht)
#pragma unroll
        for (int r = 0; r < 16; ++r) mx = fmaxf(mx, p[ht][r]);
    mx = swap_max(mx);
    float l = 0.f;
#pragma unroll
    for (int ht = 0; ht < 5; ++ht)
#pragma unroll
        for (int r = 0; r < 16; ++r) { p[ht][r] = __builtin_amdgcn_exp2f(p[ht][r] - mx); l += p[ht][r]; }
    l = swap_add(l);
    f32x16 o0, o1;
#pragma unroll
    for (int r = 0; r < 16; ++r) { o0[r] = 0.f; o1[r] = 0.f; }
    const LAS unsigned char* vb = lds + DOFF_V + v_rd_base(lane);
#pragma unroll
    for (int ht = 0; ht < 5; ++ht) {
        bf16x8 pa0, pa1; ATT_PK4(p[ht], 0, pa0); ATT_PK4(p[ht], 8, pa1);
        const LAS unsigned char* vk = vb + 2 * (wid + ht) * 2048;
#define DIL_VF(d0, ks) ({ const s16x4 lo_ = vtr(vk + (d0) * 512 + (ks) * 2048), hi_ = vtr(vk + (d0) * 512 + (ks) * 2048 + 1024); (bf16x8){lo_[0], lo_[1], lo_[2], lo_[3], hi_[0], hi_[1], hi_[2], hi_[3]}; })
        o0 = __builtin_amdgcn_mfma_f32_32x32x16_bf16(pa0, DIL_VF(0, 0), o0, 0, 0, 0); o1 = __builtin_amdgcn_mfma_f32_32x32x16_bf16(pa0, DIL_VF(1, 0), o1, 0, 0, 0);
        o0 = __builtin_amdgcn_mfma_f32_32x32x16_bf16(pa1, DIL_VF(0, 1), o0, 0, 0, 0); o1 = __builtin_amdgcn_mfma_f32_32x32x16_bf16(pa1, DIL_VF(1, 1), o1, 0, 0, 0);
#undef DIL_VF
    }
    float lse = mx + log2f(l), wn = 1.0f / l, wo = 0.f;
    if (g > 0) { const float lo = LSE[grow * 16 + h]; const float mm = fmaxf(lo, lse); const float nl = mm + log2f(__builtin_amdgcn_exp2f(lo - mm) + __builtin_amdgcn_exp2f(lse - mm));
        wo = __builtin_amdgcn_exp2f(lo - nl); wn = __builtin_amdgcn_exp2f(lse - nl) / l; lse = nl; }
    LAS float* wsf = (LAS float*)(lds + DOFF_WS) + wid * 96;
    if (hi == 0) { LSE[grow * 16 + h] = lse; wsf[r32] = wn; wsf[32 + r32] = wo; ((LAS int*)wsf)[64 + r32] = (int)grow; }
    unsigned oldw[16];
    if (g > 0) {
#pragma unroll
        for (int r = 0; r < 16; ++r) { const int gr = ((LAS int*)wsf)[64 + crow(r, hi)]; oldw[r] = *(const unsigned*)(O2 + (size_t)gr * DM + h * 64 + 2 * r32); } }
#pragma unroll
    for (int r = 0; r < 16; ++r) { const int c = crow(r, hi); const float a = wsf[c], bo = wsf[32 + c]; const int gr = ((LAS int*)wsf)[64 + c];
        float v0 = o0[r] * a, v1 = o1[r] * a;
        if (g > 0) { v0 += bf2f(oldw[r] & 0xffffu) * bo; v1 += bf2f(oldw[r] >> 16) * bo; }
        *(unsigned*)(O2 + (size_t)gr * DM + h * 64 + 2 * r32) = pk2(v0, v1); }
    __syncthreads();
}
__device__ __forceinline__ void dil_phase(const bf16_t* QKVG, const int* pos, const float* rel_bias, int g, bf16_t* O2, float* LSE, LAS unsigned char* lds, int vcu, int G) {
    int tid_ = threadIdx.x; asm volatile("" : "+v"(tid_));
    const int tid = tid_;
    const int NU = NBATCH * NH * 8;
    const bool blocked = (NU % G) == 0; const int per = blocked ? NU / G : (NU - vcu + G - 1) / G;
    LAS float* lut = (LAS float*)(lds + DOFF_LUT);
    int hl = -1;
    DilRegs R;
    if (per > 0) { const int u = blocked ? vcu * per : vcu; dil_prefetch(R, QKVG, pos, g, u >> 7, (u >> 3) & 15, u & 7, tid); }
#pragma unroll 1
    for (int i = 0; i < per; ++i) {
        const int u = blocked ? vcu * per + i : vcu + i * G; const int b = u >> 7, h = (u >> 3) & 15, j = u & 7;
        if (h != hl) { for (int idx = tid; idx <= 2 * LUT_R; idx += 512) lut[idx] = rel_bias[t5_bucket(idx - LUT_R) * 48 + g * 16 + h] * LOG2E; hl = h; }
        const int un = (i + 1 < per) ? (blocked ? u + 1 : u + G) : -1;
        dil_unit(R, un, QKVG, pos, g, O2, LSE, lds, b, h, j, tid);
    }
}
}
#ifndef MLA_STAGGER
#define MLA_STAGGER 0
#endif
namespace att {
__device__ __forceinline__ void mla_unit_fast(const bf16_t* Q, const bf16_t* KV, const bf16_t* KROPE, bf16_t* O, LAS unsigned char* lds, int b, int h, int qb, float KN) {
    int tid_ = threadIdx.x; asm volatile("" : "+v"(tid_));
    const int tid = tid_, lane = tid & 63, r32 = lane & 31, hi = lane >> 5, wid = __builtin_amdgcn_readfirstlane(tid >> 6);
    const size_t row0 = (size_t)b * SEQ;
    const bf16_t* ksrc = KV + (row0 + (tid >> 3)) * 2048 + h * 128 + (tid & 7) * 8;
    const bf16_t* rsrc = KROPE + (row0 + ((tid & 255) >> 2)) * 512 + h * 32 + (tid & 3) * 8;
    const int kdst = OFF_K + (tid >> 3) * KPITCH + (tid & 7) * 16;
    const int rdst = OFF_K + ((tid & 255) >> 2) * KPITCH + 128 + (tid & 3) * 16;
    const int vdst = OFF_V + v_st<2>(tid >> 3, (tid & 7) * 8);
    const bf16_t* qp = Q + (row0 + qb * 256 + wid * 32 + r32) * 1536 + h * QKD + hi * 8;
    bf16x8 qr[6]; float qn2 = 0.f;
#pragma unroll
    for (int d0 = 0; d0 < 6; ++d0) { const u32x4 w = *(const u32x4*)(qp + 16 * d0); qr[d0] = __builtin_bit_cast(bf16x8, w); float f[8]; unpack8(w, f);
#pragma unroll
        for (int e = 0; e < 8; ++e) qn2 += f[e] * f[e]; }
    qn2 = swap_add(qn2);
    const float negB = -(sqrtf(qn2) * KN);
    f32x16 o0, o1;
#pragma unroll
    for (int r = 0; r < 16; ++r) { o0[r] = 0.f; o1[r] = 0.f; }
    float lsum = 0.f;
    u32x4 kreg, rreg = {0u, 0u, 0u, 0u}, vreg;
#define F_LOADK(t) do { kreg = *(const u32x4*)(ksrc + (size_t)(t) * 64 * 2048); rreg = *(const u32x4*)(rsrc + (size_t)(t) * 64 * 512); } while (0)
#define F_LOADV(t) do { vreg = *(const u32x4*)(ksrc + (size_t)(t) * 64 * 2048 + 64); } while (0)
#define F_WRITEK(buf) do { *(LAS u32x4*)(lds + kdst + (buf) * KTILE) = kreg; *(LAS u32x4*)(lds + rdst + (buf) * KTILE) = rreg; } while (0)
#define F_WRITEV(buf) do { *(LAS u32x4*)(lds + vdst + (buf) * VTILE) = vreg; } while (0)
#define F_QK(P0, P1, buf) do { const LAS unsigned char* kb_ = lds + OFF_K + (buf) * KTILE + r32 * KPITCH + hi * 16; { float nb_ = negB; asm volatile("" : "+v"(nb_)); _Pragma("unroll") for (int r = 0; r < 16; ++r) { P0[r] = nb_; P1[r] = nb_; } } \
        _Pragma("unroll") for (int d0 = 0; d0 < 6; ++d0) { const bf16x8 a0_ = *(const LAS bf16x8*)(kb_ + d0 * 32), a1_ = *(const LAS bf16x8*)(kb_ + 32 * KPITCH + d0 * 32); \
            P0 = __builtin_amdgcn_mfma_f32_32x32x16_bf16(a0_, qr[d0], P0, 0, 0, 0); P1 = __builtin_amdgcn_mfma_f32_32x32x16_bf16(a1_, qr[d0], P1, 0, 0, 0); } } while (0)
#define F_VF(vb_, d0, ks) ({ const s16x4 lo_ = vtr(vb_ + (d0) * 512 + (ks) * 2048), hi_ = vtr(vb_ + (d0) * 512 + (ks) * 2048 + 1024); (bf16x8){lo_[0], lo_[1], lo_[2], lo_[3], hi_[0], hi_[1], hi_[2], hi_[3]}; })
    const int NT = SEQ / 64;
#define F_SMPV(C0, C1, t) do { \
        float ps_ = 0.f; \
        _Pragma("unroll") for (int r = 0; r < 16; ++r) { C0[r] = __builtin_amdgcn_exp2f(C0[r]); C1[r] = __builtin_amdgcn_exp2f(C1[r]); ps_ += C0[r] + C1[r]; } \
        lsum += ps_; \
        bf16x8 pa0_, pa1_, pa2_, pa3_; ATT_PK4(C0, 0, pa0_); ATT_PK4(C0, 8, pa1_); ATT_PK4(C1, 0, pa2_); ATT_PK4(C1, 8, pa3_); \
        const LAS unsigned char* vb_ = lds + OFF_V + ((t) & 1) * VTILE + v_rd_base(lane); \
        o0 = __builtin_amdgcn_mfma_f32_32x32x16_bf16(pa0_, F_VF(vb_, 0, 0), o0, 0, 0, 0); o1 = __builtin_amdgcn_mfma_f32_32x32x16_bf16(pa0_, F_VF(vb_, 1, 0), o1, 0, 0, 0); \
        o0 = __builtin_amdgcn_mfma_f32_32x32x16_bf16(pa1_, F_VF(vb_, 0, 1), o0, 0, 0, 0); o1 = __builtin_amdgcn_mfma_f32_32x32x16_bf16(pa1_, F_VF(vb_, 1, 1), o1, 0, 0, 0); \
        o0 = __builtin_amdgcn_mfma_f32_32x32x16_bf16(pa2_, F_VF(vb_, 0, 2), o0, 0, 0, 0); o1 = __builtin_amdgcn_mfma_f32_32x32x16_bf16(pa2_, F_VF(vb_, 1, 2), o1, 0, 0, 0); \
        o0 = __builtin_amdgcn_mfma_f32_32x32x16_bf16(pa3_, F_VF(vb_, 0, 3), o0, 0, 0, 0); o1 = __builtin_amdgcn_mfma_f32_32x32x16_bf16(pa3_, F_VF(vb_, 1, 3), o1, 0, 0, 0); \
    } while (0)
#define F_STEP(C0, C1, N0, N1, t, LEAD, WK, WV, LK, LV, DOQK) do { \
        __syncthreads(); \
        if (WK) { F_WRITEK((t) & 1); } if (WV) { F_WRITEV(((t) + 1) & 1); } \
        if (LK) { F_LOADK((t) + 3); } if (LV) { F_LOADV((t) + 2); } \
        __builtin_amdgcn_sched_barrier(0); \
        if (LEAD) { if (DOQK) { F_QK(N0, N1, ((t) + 1) & 1); } __builtin_amdgcn_sched_barrier(0); F_SMPV(C0, C1, t); } \
        else { F_SMPV(C0, C1, t); __builtin_amdgcn_sched_barrier(0); if (DOQK) { F_QK(N0, N1, ((t) + 1) & 1); } } \
        __builtin_amdgcn_sched_barrier(0); \
    } while (0)
#define F_LOOP(LEAD) do { \
        _Pragma("unroll 1") for (int t = 0; t < NT - 4; t += 2) { F_STEP(pA0, pA1, pB0, pB1, t, LEAD, true, true, true, true, true); F_STEP(pB0, pB1, pA0, pA1, t + 1, LEAD, true, true, true, true, true); } \
        F_STEP(pA0, pA1, pB0, pB1, NT - 4, LEAD, true, true, false, true, true); \
        F_STEP(pB0, pB1, pA0, pA1, NT - 3, LEAD, true, true, false, false, true); \
        F_STEP(pA0, pA1, pB0, pB1, NT - 2, LEAD, false, true, false, false, true); \
        F_STEP(pB0, pB1, pA0, pA1, NT - 1, LEAD, false, false, false, false, false); \
    } while (0)
    F_LOADK(0); F_LOADV(0); F_WRITEK(0); F_WRITEV(0); F_LOADK(1); F_WRITEK(1); F_LOADK(2); F_LOADV(1);
    __syncthreads();
    f32x16 pA0, pA1, pB0, pB1;
    F_QK(pA0, pA1, 0);
    if (MLA_STAGGER && wid >= 4) F_LOOP(false); else F_LOOP(true);
    const float l = swap_add(lsum);
    LAS float* wsf = (LAS float*)(lds + OFF_WS) + wid * 64;
    if (hi == 0) wsf[32 + r32] = l;
    bf16_t* op = O + (row0 + qb * 256 + wid * 32) * DM + h * VD + r32;
#pragma unroll
    for (int r = 0; r < 16; ++r) { const float rl = 1.0f / wsf[32 + crow(r, hi)]; const unsigned w = pk2(o0[r] * rl, o1[r] * rl);
        op[(size_t)crow(r, hi) * DM] = (bf16_t)(w & 0xffffu); op[(size_t)crow(r, hi) * DM + 32] = (bf16_t)(w >> 16); }
    __syncthreads();
#undef F_LOADK
#undef F_LOADV
#undef F_WRITEK
#undef F_WRITEV
#undef F_QK
#undef F_VF
#undef F_STEP
#undef F_LOOP
#undef F_SMPV
}
__device__ __forceinline__ float wave_absmax(const float* g, int n, int lane) {
    float v = lane < n ? fabsf(g[lane]) : 0.f; if (lane + 64 < n) v = fmaxf(v, fabsf(g[lane + 64]));
#pragma unroll
    for (int o = 1; o < 64; o <<= 1) v = fmaxf(v, __shfl_xor(v, o));
    return v;
}
}
constexpr int NWAVES = 8;
constexpr int RING_BYTES = 131072;
constexpr int LDSCTL_OFF = RING_BYTES, MISC_OFF = LDSCTL_OFF + 320;
constexpr int LDS_BYTES = 147456;
constexpr int CW_BAR = 4096;
constexpr size_t CTL_ZERO_BYTES = 256 * 1024;
static_assert((CW_BAR + 12 * XCD_BAR_WORDS) * 4 <= (int)CTL_ZERO_BYTES, "barrier words inside the memset region");

template <class E> struct EpiAd {
    static constexpr bool PERM = (E::NV == 8), AFTER_DRAIN = false; E e;
    __device__ __forceinline__ void operator()(const pg8::f32x4 (&acc)[2][2][4][2], const pg8::Unit& u, int wr, int wc, int fr, int fq) const {
#pragma unroll
        for (int ai = 0; ai < 2; ++ai)
#pragma unroll
            for (int m = 0; m < 4; ++m) { const int row = u.pm * 256 + ai * 128 + wr * 64 + m * 16 + fr;
#pragma unroll
                for (int bj = 0; bj < 2; ++bj) {
                    if constexpr (PERM) { const int col = u.pn * 256 + bj * 128 + wc * 32 + 8 * fq;
                        const float v[8] = {acc[ai][bj][m][0][0], acc[ai][bj][m][0][1], acc[ai][bj][m][0][2], acc[ai][bj][m][0][3], acc[ai][bj][m][1][0], acc[ai][bj][m][1][1], acc[ai][bj][m][1][2], acc[ai][bj][m][1][3]};
                        e.store(row, col, v); }
                    else {
#pragma unroll
                        for (int n = 0; n < 2; ++n) { const int col = u.pn * 256 + bj * 128 + wc * 32 + 16 * n + 4 * fq;
                            const float v[4] = {acc[ai][bj][m][n][0], acc[ai][bj][m][n][1], acc[ai][bj][m][n][2], acc[ai][bj][m][n][3]};
                            e.store(row, col, v); } } }
                if (m & 1) asm volatile("" ::: "memory"); }
    }
};
struct EpiDilNorm {
    static constexpr bool PERM = true, AFTER_DRAIN = false;
    bf16_t* C; const float* g_q; const float* g_k; int lgD, pad;
    __device__ __forceinline__ void operator()(const pg8::f32x4 (&acc)[2][2][4][2], const pg8::Unit& u, int wr, int wc, int fr, int fq) const {
        const int t = u.pn >> 2, head = (u.pn & 3) * 4 + wc;
        float gn[2][8];
#pragma unroll
        for (int bj = 0; bj < 2; ++bj)
#pragma unroll
            for (int e = 0; e < 8; ++e) gn[bj][e] = t == 0 ? g_q[32 * bj + 8 * fq + e] * DIL_C2 : (t == 1 ? g_k[32 * bj + 8 * fq + e] : 1.0f);
#pragma unroll
        for (int ai = 0; ai < 2; ++ai)
#pragma unroll
            for (int m = 0; m < 4; ++m) {
                const int row = u.pm * 256 + ai * 128 + wr * 64 + m * 16 + fr;
                const int b = row >> 11, s = row & 2047, uu = ((s & ((1 << lgD) - 1)) << (11 - lgD)) + (s >> lgD);
                float x[2][8]; float ss = 0.f;
#pragma unroll
                for (int bj = 0; bj < 2; ++bj)
#pragma unroll
                    for (int e = 0; e < 8; ++e) { x[bj][e] = acc[ai][bj][m][e >> 2][e & 3]; ss += x[bj][e] * x[bj][e]; }
                ss += __shfl_xor(ss, 16); ss += __shfl_xor(ss, 32);
                const float rs = t == 2 ? 1.0f : __builtin_amdgcn_rsqf(ss * (1.0f / 64) + EPS);
                bf16_t* dst = C + ((size_t)((t * NBATCH + b) * NH + head) * SEQ + uu) * 64 + 8 * fq;
#pragma unroll
                for (int bj = 0; bj < 2; ++bj) { u32x4 w;
                    w.x = pk2(x[bj][0] * rs * gn[bj][0], x[bj][1] * rs * gn[bj][1]); w.y = pk2(x[bj][2] * rs * gn[bj][2], x[bj][3] * rs * gn[bj][3]);
                    w.z = pk2(x[bj][4] * rs * gn[bj][4], x[bj][5] * rs * gn[bj][5]); w.w = pk2(x[bj][6] * rs * gn[bj][6], x[bj][7] * rs * gn[bj][7]);
                    *(u32x4*)(dst + 32 * bj) = w; }
            }
    }
};
template <class E> __device__ __forceinline__ void run_gemm(LAS unsigned char* lds, const void* A, const void* Bt, int N, int K, const E& e) {
    pg8::Gemm g{(const bf16_t*)A, (const bf16_t*)Bt, MTOK, N, K}; pg8::StaticOrder S; S.init(MTOK, N, (int)gridDim.x, (int)blockIdx.x);
    EpiAd<E> ad{e};
    pg8::gemm_phase<EpiAd<E>, pg8::StaticOrder, true, true>(lds, g, S, ad);
}

struct Args { Ptrs P; int ph_lo, ph_hi, li, pad; };
#define GASP __attribute__((address_space(1)))
struct GPtrs {
    const GASP float *x, *c; const GASP int* pos; const GASP float *ada_w, *ada_b, *norm_mix, *norm_mlp, *mlp_w1, *mlp_w2;
    const GASP float *mla_w_in, *mla_g_qa, *mla_w_qb, *mla_g_kva, *mla_w_kvb, *mla_g_q, *mla_g_k, *mla_w_o;
    const GASP float *dil_w_in, *dil_g_q, *dil_g_k, *dil_w_o, *rel_bias;
    GASP float* out; GASP unsigned char* ws;
};
static_assert(sizeof(GPtrs) == sizeof(Ptrs), "GPtrs mirrors Ptrs");
typedef const __attribute__((address_space(4))) GPtrs* kargp_t;
__device__ __forceinline__ kargp_t kargs() { kargp_t p = (kargp_t)__builtin_amdgcn_kernarg_segment_ptr(); asm volatile("" : "+s"(p)); return p; }
__device__ __forceinline__ Ptrs kptrs() { kargp_t g = kargs(); Ptrs P;
    P.x = (const float*)g->x; P.c = (const float*)g->c; P.pos = (const int*)g->pos; P.ada_w = (const float*)g->ada_w; P.ada_b = (const float*)g->ada_b; P.norm_mix = (const float*)g->norm_mix; P.norm_mlp = (const float*)g->norm_mlp;
    P.mlp_w1 = (const float*)g->mlp_w1; P.mlp_w2 = (const float*)g->mlp_w2; P.mla_w_in = (const float*)g->mla_w_in; P.mla_g_qa = (const float*)g->mla_g_qa; P.mla_w_qb = (const float*)g->mla_w_qb; P.mla_g_kva = (const float*)g->mla_g_kva;
    P.mla_w_kvb = (const float*)g->mla_w_kvb; P.mla_g_q = (const float*)g->mla_g_q; P.mla_g_k = (const float*)g->mla_g_k; P.mla_w_o = (const float*)g->mla_w_o; P.dil_w_in = (const float*)g->dil_w_in; P.dil_g_q = (const float*)g->dil_g_q;
    P.dil_g_k = (const float*)g->dil_g_k; P.dil_w_o = (const float*)g->dil_w_o; P.rel_bias = (const float*)g->rel_bias; P.out = (float*)g->out; P.ws = (unsigned char*)g->ws; return P; }
#define KA kptrs()
#define MOD0 ((const float*)(KA.ws + WS_MOD))
#define MOD1 (MOD0 + 8 * MODW)
#define HB ((bf16_t*)(KA.ws + WS_H))
constexpr int NPHASE = 22;
#ifndef HYBRID
#define HYBRID 0
#endif
__global__ void __launch_bounds__(NWAVES * 64, 2) mega_fwd(Args args) {
    extern __shared__ __attribute__((aligned(16))) unsigned char lds_raw[];
    LAS unsigned char* lds = (LAS unsigned char*)lds_raw;
    volatile LAS unsigned* MISC = (volatile LAS unsigned*)(lds + MISC_OFF);
    const int tid = threadIdx.x, lane = tid & 63, wave = __builtin_amdgcn_readfirstlane(tid >> 6);
    const int G = gridDim.x, bx = blockIdx.x, gw = bx * NWAVES + wave, ngw = G * NWAVES;
    const int vcu = (G % 8 == 0) ? (bx % 8) * (G / 8) + bx / 8 : bx;
    for (int u = tid; u < (LDS_BYTES - LDSCTL_OFF) / 4; u += NWAVES * 64) ((LAS unsigned*)(lds + LDSCTL_OFF))[u] = 0u;
    __syncthreads();
    XcdBarrier bar = xcd_barrier_post((unsigned*)(args.P.ws + WS_CTL) + CW_BAR + args.li * XCD_BAR_WORDS, MISC + 8);
    const int lo = args.ph_lo, hi = args.ph_hi;
#ifdef TS_A
    unsigned long long* tsbuf = (unsigned long long*)(args.P.ws + WS_CTL + 512 * 1024);
#endif
#define IN(k) (lo <= (k) && (k) < hi)
#ifdef TS_A
#define STAMP(i) do { if (bx == 0 && tid == 0) tsbuf[i] = __builtin_amdgcn_s_memrealtime(); } while (0)
#else
#define STAMP(i) do { } while (0)
#endif
#define SEAM(k) do { if (IN(k) && IN((k) + 1)) xcd_barrier(bar); STAMP((k) + 1); } while (0)
#ifndef REP_MASK
#define REP_MASK 0u
#endif
#ifndef EXTRA_BARS
#define EXTRA_BARS 0
#endif
#define REPEAT(k) for (int rep_ = 0; rep_ < (((REP_MASK) >> (k)) & 1u ? 2 : 1); ++rep_, (((REP_MASK) >> (k)) & 1u) && rep_ < 2 ? (xcd_barrier(bar), 0) : 0)

    STAMP(0);
    if (IN(0)) REPEAT(0) {
        p0_weights(KA, (LAS float*)lds + wave * (64 * 33), gw, ngw, lane);
        p0_cs(KA, bx * 512 + tid, G * 512);
        __syncthreads();
        p0_mod(KA, (LAS float*)lds, bx, G, tid, NWAVES);
    }
    SEAM(0);
    for (int eb_ = 0; eb_ < EXTRA_BARS; ++eb_) xcd_barrier(bar);
    if (IN(1)) REPEAT(1) lnmod_rows(KA.x, KA.norm_mix, MOD0, 0, 1, HB, gw, ngw, lane);
    SEAM(1);
    if (IN(2)) REPEAT(2) run_gemm(lds, KA.ws + WS_H, KA.ws + WS_WIN0, MLA_INP, DM, EpiF32{(float*)(KA.ws + WS_PROJ), MLA_INP, 0});
    SEAM(2);
    if (IN(3)) REPEAT(3) mla_prep_rows(KA, gw, ngw, lane);
    SEAM(3);
    if (IN(4)) REPEAT(4) {
        run_gemm(lds, KA.ws + WS_QA, KA.ws + WS_WQB, 1536, QLORA, EpiBf16{(bf16_t*)(KA.ws + WS_Q), 1536, 0});
        run_gemm(lds, KA.ws + WS_KVA, KA.ws + WS_WKVB, 2048, KVLORA, EpiBf16{(bf16_t*)(KA.ws + WS_KV), 2048, 0});
    }
    SEAM(4);
    if (IN(5)) REPEAT(5) mla_final_rows(KA, gw, ngw, lane);
    SEAM(5);
    if (IN(6)) REPEAT(6) {
        const float gqm = att::wave_absmax(KA.mla_g_q, QKD, lane), gkm = att::wave_absmax(KA.mla_g_k, QKD, lane);
        const float KN = __builtin_bit_cast(float, __builtin_amdgcn_readfirstlane(__builtin_bit_cast(int, 9.797958971f * gkm * 1.00391f)));
        const bool fast = __builtin_amdgcn_readfirstlane((int)(1.4427f * 9.798f * 1.008f * gqm * gkm <= 40.0f)) != 0;
        if (fast) att::for_units(NBATCH * NH * 8, vcu, G, [&](int u) { att::mla_unit_fast((const bf16_t*)(KA.ws + WS_Q), (const bf16_t*)(KA.ws + WS_KV), (const bf16_t*)(KA.ws + WS_KROPE), HB, lds, u >> 7, (u >> 3) & 15, u & 7, KN); });
        else att::for_units(NBATCH * NH * 8, vcu, G, [&](int u) { att::mla_unit((const bf16_t*)(KA.ws + WS_Q), (const bf16_t*)(KA.ws + WS_KV), (const bf16_t*)(KA.ws + WS_KROPE), HB, lds, u >> 7, (u >> 3) & 15, u & 7); });
    }
    SEAM(6);
    if (IN(7)) REPEAT(7) run_gemm(lds, KA.ws + WS_H, KA.ws + WS_WO0, DM, DM, EpiResGate{KA.x, KA.out, MOD0 + 2 * DM});
    SEAM(7);
    if (IN(8)) REPEAT(8) lnmod_rows(KA.out, KA.norm_mlp, MOD0, 3, 4, HB, gw, ngw, lane);
    SEAM(8);
    if (IN(9)) REPEAT(9) run_gemm(lds, KA.ws + WS_H, KA.ws + WS_W1_0, DFF, DM, EpiSqRelu{(bf16_t*)(KA.ws + WS_U), DFF, 0});
    SEAM(9);
    if (IN(10)) REPEAT(10) run_gemm(lds, KA.ws + WS_U, KA.ws + WS_W2_0, DM, DFF, EpiResGate{KA.out, KA.out, MOD0 + 5 * DM});
    SEAM(10);
    if (IN(11)) REPEAT(11) lnmod_rows(KA.out, KA.norm_mix + DM, MOD1, 0, 1, HB, gw, ngw, lane);
    SEAM(11);
#pragma unroll 1
    for (int g = 0; g < 3; ++g) {
        if (IN(12 + 2 * g)) REPEAT(12 + 2 * g) {
            pg8::Gemm gm{(const bf16_t*)(KA.ws + WS_H), (const bf16_t*)(KA.ws + WS_WIN1 + (size_t)g * GCOLS * DM * 2), MTOK, GCOLS, DM}; pg8::StaticOrder S; S.init(MTOK, GCOLS, G, bx);
            EpiDilNorm E{(bf16_t*)(KA.ws + WS_QKVG), KA.dil_g_q + g * 64, KA.dil_g_k + g * 64, 2 * g, 0};
            pg8::gemm_phase<EpiDilNorm, pg8::StaticOrder, true, true>(lds, gm, S, E);
        }
        SEAM(12 + 2 * g);
        if (IN(13 + 2 * g)) REPEAT(13 + 2 * g) att::dil_phase((const bf16_t*)(KA.ws + WS_QKVG), KA.pos, KA.rel_bias, g, (bf16_t*)(KA.ws + WS_O2), (float*)(KA.ws + WS_LSE), lds, vcu, G);
        SEAM(13 + 2 * g);
    }
    if (IN(18)) REPEAT(18) run_gemm(lds, KA.ws + WS_O2, KA.ws + WS_WO1, DM, DM, EpiResGate{KA.out, KA.out, MOD1 + 2 * DM});
    SEAM(18);
    if (IN(19)) REPEAT(19) lnmod_rows(KA.out, KA.norm_mlp + DM, MOD1, 3, 4, HB, gw, ngw, lane);
    SEAM(19);
    if (IN(20)) REPEAT(20) run_gemm(lds, KA.ws + WS_H, KA.ws + WS_W1_1, DFF, DM, EpiSqRelu{(bf16_t*)(KA.ws + WS_U), DFF, 0});
    SEAM(20);
    if (IN(21)) REPEAT(21) run_gemm(lds, KA.ws + WS_U, KA.ws + WS_W2_1, DM, DFF, EpiResGate{KA.out, KA.out, MOD1 + 5 * DM});
#ifdef TS_A
    xcd_barrier(bar); STAMP(22);
    if (bx == 0 && tid == 0) { __threadfence(); KA.out[0] += (float)(long long)(tsbuf[TS_B] - tsbuf[TS_A]) * 0.01f; }
#endif
#undef IN
#undef SEAM
}

extern "C" void kernel_launch(void* const* d_in, const int* in_sizes, int n_in, void* d_out, int out_size, void* d_ws, size_t ws_size, hipStream_t stream) {
    static int grid = 0;
    if (grid == 0) {
        if (n_in != 22 || ws_size < WS_END || out_size != MTOK * DM) { fprintf(stderr, "kernel_launch: unexpected n_in %d / ws %zu / out %d\n", n_in, ws_size, out_size); grid = -1; return; }
        int dev = 0, cus = 0, per_cu = 0;
        if (hipGetDevice(&dev) != hipSuccess || hipDeviceGetAttribute(&cus, hipDeviceAttributeMultiprocessorCount, dev) != hipSuccess) { grid = -1; return; }
        if (hipFuncSetAttribute((const void*)mega_fwd, hipFuncAttributeMaxDynamicSharedMemorySize, LDS_BYTES) != hipSuccess) { fprintf(stderr, "kernel_launch: hipFuncSetAttribute failed\n"); grid = -1; return; }
        if (hipOccupancyMaxActiveBlocksPerMultiprocessor(&per_cu, (const void*)mega_fwd, NWAVES * 64, LDS_BYTES) != hipSuccess || per_cu < 1) { fprintf(stderr, "kernel_launch: occupancy query says %d blocks per CU\n", per_cu); (void)hipGetLastError(); grid = -1; return; }
        if (per_cu > 1) per_cu = 1;
        grid = cus * per_cu;
    }
    if (grid < 0) return;
    if (hipMemsetAsync((char*)d_ws + WS_CTL, 0, CTL_ZERO_BYTES, stream) != hipSuccess) return;
    Args a{};
    Ptrs& P = a.P;
    P.x = (const float*)d_in[0]; P.c = (const float*)d_in[1]; P.pos = (const int*)d_in[2]; P.ada_w = (const float*)d_in[3]; P.ada_b = (const float*)d_in[4];
    P.norm_mix = (const float*)d_in[5]; P.norm_mlp = (const float*)d_in[6]; P.mlp_w1 = (const float*)d_in[7]; P.mlp_w2 = (const float*)d_in[8];
    P.mla_w_in = (const float*)d_in[9]; P.mla_g_qa = (const float*)d_in[10]; P.mla_w_qb = (const float*)d_in[11]; P.mla_g_kva = (const float*)d_in[12];
    P.mla_w_kvb = (const float*)d_in[13]; P.mla_g_q = (const float*)d_in[14]; P.mla_g_k = (const float*)d_in[15]; P.mla_w_o = (const float*)d_in[16];
    P.dil_w_in = (const float*)d_in[17]; P.dil_g_q = (const float*)d_in[18]; P.dil_g_k = (const float*)d_in[19]; P.dil_w_o = (const float*)d_in[20]; P.rel_bias = (const float*)d_in[21];
    P.out = (float*)d_out; P.ws = (unsigned char*)d_ws;
    unsigned char* ws = P.ws;
    int li = 0;
    auto launch = [&](int lo, int hi) { a.ph_lo = lo; a.ph_hi = hi; a.li = li++; hipLaunchKernelGGL(mega_fwd, dim3(grid), dim3(NWAVES * 64), LDS_BYTES, stream, a); };
    launch(0, NPHASE);

}
```

```cpp
#include <hip/hip_runtime.h>
#include <cstdint>
#include <cstdio>

#define LAS __attribute__((address_space(3)))
typedef unsigned short bf16_t;
typedef float f32x4 __attribute__((ext_vector_type(4)));
typedef float f32x2 __attribute__((ext_vector_type(2)));
typedef unsigned u32x4 __attribute__((ext_vector_type(4)));
typedef unsigned u32x2 __attribute__((ext_vector_type(2)));
typedef __bf16 bf16x2_t __attribute__((ext_vector_type(2)));

constexpr int DM = 1024, NBATCH = 8, SEQ = 2048, MTOK = NBATCH * SEQ;
constexpr int DFF = 4096, MODW = 6 * DM;
constexpr int QLORA = 384, KVLORA = 256, ROPE = 32, MLA_IN = 672, MLA_INP = 768;
constexpr int NH = 16, QKD = 96, NOPE = 64, VD = 64;
constexpr int DIL_IN = 9216, GCOLS = 3072, NBKT = 32;
constexpr float EPS = 1e-6f;
constexpr float LOG2E = 1.4426950408889634f;
constexpr float MLA_C2 = 0.10206207261596575f * LOG2E;
constexpr float DIL_C2 = 0.125f * LOG2E;

constexpr size_t MiB = 1u << 20;
constexpr size_t WS_CTL = 0, WS_MOD = 1 * MiB, WS_CS = 2 * MiB;
constexpr size_t WS_WIN0 = 4 * MiB, WS_WQB = 5 * MiB + 512 * 1024, WS_WKVB = 7 * MiB, WS_WO0 = 8 * MiB, WS_W1_0 = 10 * MiB, WS_W2_0 = 18 * MiB;
constexpr size_t WS_WIN1 = 26 * MiB, WS_WO1 = 44 * MiB, WS_W1_1 = 46 * MiB, WS_W2_1 = 54 * MiB;
constexpr size_t WS_H = 64 * MiB;
constexpr size_t WS_R = 96 * MiB;
constexpr size_t WS_QH = WS_R;
constexpr size_t WS_KH = WS_R + 48 * MiB;
constexpr size_t WS_VH = WS_R + 96 * MiB;
constexpr size_t WS_QA = WS_R + 128 * MiB;
constexpr size_t WS_KVA = WS_R + 140 * MiB;
constexpr size_t WS_KR = WS_R + 148 * MiB;
constexpr size_t WS_SSQ = 256 * 1024, WS_SSKV = 320 * 1024, WS_SSKR = 384 * 1024;
constexpr size_t WS_U = WS_R;
constexpr size_t WS_QKVG = WS_R;
constexpr size_t WS_O2 = WS_R + 96 * MiB;
constexpr size_t WS_LSE = WS_R + 128 * MiB;
constexpr size_t WS_END = 256 * MiB;

__device__ __forceinline__ float bf2f(unsigned h) { return __uint_as_float(h << 16); }
__device__ __forceinline__ unsigned pk2(float lo, float hi) { f32x2 v = {lo, hi}; bf16x2_t b = __builtin_convertvector(v, bf16x2_t); return __builtin_bit_cast(unsigned, b); }
__device__ __forceinline__ float wave_sum(float v) {
#pragma unroll
    for (int o = 1; o < 64; o <<= 1) v += __shfl_xor(v, o);
    return v;
}
__device__ __forceinline__ void unpack8(u32x4 w, float (&f)[8]) {
    f[0] = bf2f(w.x & 0xffffu); f[1] = bf2f(w.x >> 16); f[2] = bf2f(w.y & 0xffffu); f[3] = bf2f(w.y >> 16);
    f[4] = bf2f(w.z & 0xffffu); f[5] = bf2f(w.z >> 16); f[6] = bf2f(w.w & 0xffffu); f[7] = bf2f(w.w >> 16);
}
__device__ __forceinline__ u32x4 pack8(const float (&f)[8]) { u32x4 w; w.x = pk2(f[0], f[1]); w.y = pk2(f[2], f[3]); w.z = pk2(f[4], f[5]); w.w = pk2(f[6], f[7]); return w; }
#define LDS_WAIT() asm volatile("s_waitcnt lgkmcnt(0)" ::: "memory")
__device__ __forceinline__ int wave_tid(int wave) { unsigned z = 0u; asm volatile("" : "+v"(z));
    return (wave << 6) | (int)__builtin_amdgcn_mbcnt_hi(~0u, __builtin_amdgcn_mbcnt_lo(~0u, z)); }

__device__ __forceinline__ int t5_bucket(int rel) {
    const int n = rel < 0 ? -rel : rel;
    int b = n;
    if (n >= 8) b = 8 + (n >= 15) + (n >= 27) + (n >= 50) + (n >= 91) + (n >= 166) + (n >= 305) + (n >= 559);
    return b + (rel > 0 ? 16 : 0);
}

template <int VPERM = 0> __device__ __forceinline__ void transpose_item(const float* W, int K, int ldn, int N, bf16_t* WT, int row_off, LAS float* scr, int item, int lane, const float* kgain = nullptr) {
    const int nblk = N / 32, kb = item / nblk, nb = item % nblk, k0 = 64 * kb, n0 = 32 * nb;
    const int kr = lane >> 3, c4 = (lane & 7) * 4;
    f32x4 v[8];
#pragma unroll
    for (int i = 0; i < 8; ++i) v[i] = *(const f32x4*)(W + (size_t)(k0 + 8 * i + kr) * ldn + n0 + c4);
#pragma unroll
    for (int i = 0; i < 8; ++i) { LAS float* d = scr + (8 * i + kr) * 33 + c4; d[0] = v[i].x; d[1] = v[i].y; d[2] = v[i].z; d[3] = v[i].w; }
    LDS_WAIT();
    const int c = lane & 7;
    float kg[8];
#pragma unroll
    for (int t = 0; t < 8; ++t) kg[t] = kgain ? kgain[k0 + 8 * c + t] : 1.0f;
#pragma unroll
    for (int j = 0; j < 4; ++j) { const int n = (lane >> 3) + 8 * j; const LAS float* s = scr + (8 * c) * 33 + n;
        u32x4 o; o.x = pk2(s[0 * 33] * kg[0], s[1 * 33] * kg[1]); o.y = pk2(s[2 * 33] * kg[2], s[3 * 33] * kg[3]); o.z = pk2(s[4 * 33] * kg[4], s[5 * 33] * kg[5]); o.w = pk2(s[6 * 33] * kg[6], s[7 * 33] * kg[7]);
        int nn = n0 + n;
        if (VPERM == 1) {
            int pos_ = nn & 63; const int hh_ = (nn >> 6) & 3;
            if ((nn % 3072) >= 2048) pos_ = (pos_ & 1) ? 32 + (pos_ >> 1) : (pos_ >> 1);
            nn = (nn & ~255) + 128 * (pos_ >> 5) + 32 * hh_ + (pos_ & 31); }
        if (VPERM == 2) {
            int pos_ = nn & 63; const int wv_ = (nn >> 6) & 3;
            if (wv_ & 1) pos_ = (pos_ & 1) ? 32 + (pos_ >> 1) : (pos_ >> 1);
            nn = (nn & ~255) + 128 * (pos_ >> 5) + 32 * wv_ + (pos_ & 31); }
        *(u32x4*)(WT + (size_t)(row_off + nn) * K + k0 + 8 * c) = o; }
    LDS_WAIT();
}

struct Ptrs {
    const float *x, *c; const int* pos; const float *ada_w, *ada_b, *norm_mix, *norm_mlp, *mlp_w1, *mlp_w2;
    const float *mla_w_in, *mla_g_qa, *mla_w_qb, *mla_g_kva, *mla_w_kvb, *mla_g_q, *mla_g_k, *mla_w_o;
    const float *dil_w_in, *dil_g_q, *dil_g_k, *dil_w_o, *rel_bias;
    float* out; unsigned char* ws;
};

__device__ __forceinline__ void p0_weights(const Ptrs& P, LAS float* scr, int gw, int ngw, int lane) {
    unsigned char* ws = P.ws;
    constexpr int I_IN0 = (DM / 64) * (MLA_IN / 32), I_QB = (QLORA / 64) * (1536 / 32), I_KVB = (KVLORA / 64) * (2048 / 32), I_O = (DM / 64) * (DM / 32);
    constexpr int I_1 = (DM / 64) * (DFF / 32), I_2 = (DFF / 64) * (DM / 32), I_IN1 = (DM / 64) * (DIL_IN / 32);
    constexpr int NITEMS = I_IN0 + I_QB + I_KVB + I_O + 2 * I_1 + 2 * I_2 + I_IN1 + I_O;
    for (int it = gw; it < NITEMS; it += ngw) {
        int r = it;
        if (r < I_IN0) { transpose_item(P.mla_w_in, DM, MLA_IN, MLA_IN, (bf16_t*)(ws + WS_WIN0), 0, scr, r, lane); continue; } r -= I_IN0;
        if (r < I_QB) { transpose_item(P.mla_w_qb, QLORA, 1536, 1536, (bf16_t*)(ws + WS_WQB), 0, scr, r, lane, P.mla_g_qa); continue; } r -= I_QB;
        if (r < I_KVB) { transpose_item<2>(P.mla_w_kvb, KVLORA, 2048, 2048, (bf16_t*)(ws + WS_WKVB), 0, scr, r, lane, P.mla_g_kva); continue; } r -= I_KVB;
        if (r < I_O) { transpose_item(P.mla_w_o, DM, DM, DM, (bf16_t*)(ws + WS_WO0), 0, scr, r, lane); continue; } r -= I_O;
        if (r < I_1) { transpose_item(P.mlp_w1, DM, DFF, DFF, (bf16_t*)(ws + WS_W1_0), 0, scr, r, lane); continue; } r -= I_1;
        if (r < I_1) { transpose_item(P.mlp_w1 + (size_t)DM * DFF, DM, DFF, DFF, (bf16_t*)(ws + WS_W1_1), 0, scr, r, lane); continue; } r -= I_1;
        if (r < I_2) { transpose_item(P.mlp_w2, DFF, DM, DM, (bf16_t*)(ws + WS_W2_0), 0, scr, r, lane); continue; } r -= I_2;
        if (r < I_2) { transpose_item(P.mlp_w2 + (size_t)DFF * DM, DFF, DM, DM, (bf16_t*)(ws + WS_W2_1), 0, scr, r, lane); continue; } r -= I_2;
        if (r < I_IN1) { transpose_item<1>(P.dil_w_in, DM, DIL_IN, DIL_IN, (bf16_t*)(ws + WS_WIN1), 0, scr, r, lane); continue; } r -= I_IN1;
        transpose_item(P.dil_w_o, DM, DM, DM, (bf16_t*)(ws + WS_WO1), 0, scr, r, lane);
    }
    u32x4* z = (u32x4*)(ws + WS_WIN0 + (size_t)MLA_IN * DM * 2);
    for (int i = gw * 64 + lane; i < 12288; i += ngw * 64) z[i] = (u32x4){0u, 0u, 0u, 0u};
}
__device__ __forceinline__ void p0_cs(const Ptrs& P, int gtid, int nthr) {
    float* cs = (float*)(P.ws + WS_CS);
    for (int i = gtid; i < MTOK * 16; i += nthr) { const int m = i >> 4, f = i & 15;
        const float inv = 1.0f / powf(10000.0f, (float)f * 0.0625f); const float ang = (float)P.pos[m] * inv;
        cs[m * 32 + f] = cosf(ang); cs[m * 32 + 16 + f] = sinf(ang); }
}
__device__ __forceinline__ void p0_mod(const Ptrs& P, LAS float* lds, int bid, int nblk, int tid, int nwaves) {
    LAS float* cond = lds; LAS float* red = lds + 8 * DM;
    float* mod = (float*)(P.ws + WS_MOD);
    for (int i = tid; i < 8 * DM; i += nwaves * 64) { const float v = P.c[i]; cond[i] = v / (1.0f + expf(-v)); }
    __syncthreads();
    const int w = tid >> 6, lane = tid & 63, ks = lane >> 3, c4 = (lane & 7) * 4, kper = DM / nwaves;
    for (int item = bid; item < 2 * (MODW / 32); item += nblk) {
        const int l = item / (MODW / 32), n0 = (item % (MODW / 32)) * 32;
        f32x4 acc[8];
#pragma unroll
        for (int b = 0; b < 8; ++b) acc[b] = (f32x4){0.f, 0.f, 0.f, 0.f};
        const float* wp = P.ada_w + (size_t)l * DM * MODW + n0 + c4;
#pragma unroll 2
        for (int kk = 0; kk < kper / 8; kk += 8) {
            f32x4 wv[8];
#pragma unroll
            for (int i = 0; i < 8; ++i) wv[i] = *(const f32x4*)(wp + (size_t)(w * kper + 8 * (kk + i) + ks) * MODW);
#pragma unroll
            for (int i = 0; i < 8; ++i) { const int k = w * kper + 8 * (kk + i) + ks;
#pragma unroll
                for (int b = 0; b < 8; ++b) acc[b] += wv[i] * cond[b * DM + k]; } }
#pragma unroll
        for (int b = 0; b < 8; ++b) {
#pragma unroll
            for (int o = 8; o < 64; o <<= 1) { acc[b].x += __shfl_xor(acc[b].x, o); acc[b].y += __shfl_xor(acc[b].y, o); acc[b].z += __shfl_xor(acc[b].z, o); acc[b].w += __shfl_xor(acc[b].w, o); }
            if (lane < 8) *(LAS f32x4*)(red + (w * 8 + b) * 32 + c4) = acc[b]; }
        __syncthreads();
        if (tid < 256) { const int b = tid >> 5, cc = tid & 31; float s = P.ada_b[l * MODW + n0 + cc];
            for (int ww = 0; ww < nwaves; ++ww) s += red[(ww * 8 + b) * 32 + cc];
            mod[(size_t)(l * 8 + b) * MODW + n0 + cc] = s; }
        __syncthreads();
    }
}
__device__ __forceinline__ void lnmod_rows(const float* X, const float* g, const float* modl  , int shift_idx, int scale_idx, bf16_t* H, int gw, int ngw, int lane) {
    for (int m = gw; m < MTOK; m += ngw) {
        const f32x4* xr = (const f32x4*)(X + (size_t)m * DM) + lane;
        f32x4 v[4]; float ss = 0.f;
#pragma unroll
        for (int j = 0; j < 4; ++j) { v[j] = xr[64 * j]; ss += (v[j].x * v[j].x + v[j].y * v[j].y) + (v[j].z * v[j].z + v[j].w * v[j].w); }
        const float rstd = 1.0f / sqrtf(wave_sum(ss) * (1.0f / DM) + EPS);
        const float* mb = modl + (size_t)(m / SEQ) * MODW;
        u32x2* o = (u32x2*)(H + (size_t)m * DM) + lane;
#pragma unroll
        for (int j = 0; j < 4; ++j) { const int col = 4 * (lane + 64 * j);
            const f32x4 gg = *(const f32x4*)(g + col), sc = *(const f32x4*)(mb + scale_idx * DM + col), sh = *(const f32x4*)(mb + shift_idx * DM + col);
            const f32x4 y = v[j] * rstd * gg * (sc + 1.0f) + sh;
            u32x2 w; w.x = pk2(y.x, y.y); w.y = pk2(y.z, y.w); o[64 * j] = w; }
    }
}
struct EpiF32 { static constexpr int NV = 4; float* C; int ldc, pad;
    __device__ __forceinline__ void store(int row, int col, const float* v) const { *(f32x4*)(C + (size_t)row * ldc + col) = (f32x4){v[0], v[1], v[2], v[3]}; } };
struct EpiBf16 { static constexpr int NV = 8; bf16_t* C; int ldc, pad;
    __device__ __forceinline__ void store(int row, int col, const float* v) const { u32x4 w; w.x = pk2(v[0], v[1]); w.y = pk2(v[2], v[3]); w.z = pk2(v[4], v[5]); w.w = pk2(v[6], v[7]);
        *(u32x4*)(C + (size_t)row * ldc + col) = w; } };
struct EpiDilQKV { static constexpr int NV = 8; bf16_t* C; int lgD, pad;
    __device__ __forceinline__ void store(int row, int col, const float* v) const { const int b = row >> 11, s = row & 2047, u = ((s & ((1 << lgD) - 1)) << (11 - lgD)) + (s >> lgD);
        const int t = col >> 10, h = (col >> 6) & 15, d = col & 63;
        u32x4 w; w.x = pk2(v[0], v[1]); w.y = pk2(v[2], v[3]); w.z = pk2(v[4], v[5]); w.w = pk2(v[6], v[7]);
        *(u32x4*)(C + ((size_t)((t * NBATCH + b) * NH + h) * SEQ + u) * 64 + d) = w; } };
struct EpiSqRelu { static constexpr int NV = 8; bf16_t* C; int ldc, pad;
    __device__ __forceinline__ void store(int row, int col, const float* v) const { float r[8];
#pragma unroll
        for (int i = 0; i < 8; ++i) { const float t = fmaxf(v[i], 0.f); r[i] = t * t; }
        u32x4 w; w.x = pk2(r[0], r[1]); w.y = pk2(r[2], r[3]); w.z = pk2(r[4], r[5]); w.w = pk2(r[6], r[7]);
        *(u32x4*)(C + (size_t)row * ldc + col) = w; } };
struct EpiResGate { static constexpr int NV = 4; const float* base; float* out; const float* gate  ;
    __device__ __forceinline__ void store(int row, int col, const float* v) const {
        const f32x4 b = *(const f32x4*)(base + (size_t)row * DM + col), g = *(const f32x4*)(gate + (size_t)(row / SEQ) * MODW + col);
        *(f32x4*)(out + (size_t)row * DM + col) = b + g * (f32x4){v[0], v[1], v[2], v[3]}; } };

namespace pg8 {
#define PG8_LAS __attribute__((address_space(3)))
typedef unsigned short bf16_t;
typedef short bf16x8 __attribute__((ext_vector_type(8)));
typedef float f32x4 __attribute__((ext_vector_type(4)));
typedef unsigned u32x4 __attribute__((ext_vector_type(4)));
constexpr int BM = 256, BK = 64, HALF = 128, HTB = HALF * BK * 2  , STAGE_BYTES = 8 * HTB, NXCD = 8, WGM = 8;

__host__ __device__ __forceinline__ int lds_byte(int r, int c) { const int st = (r >> 4) * 2 + (c >> 5), rr = r & 15, cc = c & 31, ob = rr * 64 + cc * 2; return st * 1024 + (ob ^ (((ob >> 9) & 1) << 5)); }
__host__ __device__ __forceinline__ void stage_rc(int b, int& R, int& C) { const int st = b / 1024, sb = b % 1024, swz = sb ^ (((sb >> 9) & 1) << 5); R = (st >> 1) * 16 + swz / 64; C = (st & 1) * 32 + (swz % 64) / 2; }
__host__ __device__ __forceinline__ int perm32(int rho) { const int n = rho >> 4, i = rho & 15; return 8 * (i >> 2) + 4 * n + (i & 3); }

struct Unit { int pm, pn; };
struct Gemm { const bf16_t* A; const bf16_t* Bt; int M, N, K; };

struct StaticOrder {
    int nM, nN, nwg, G, c;
    __host__ __device__ void init(int M, int N, int G_, int c_) { nM = M / BM; nN = N / BM; nwg = nM * nN; G = G_; c = c_; }
    __host__ __device__ bool next(int i, Unit& u) const {
        const long L = (long)i * G + c; if (L >= nwg) return false;
        int wgid = (int)L; { const int q = nwg / NXCD, r = nwg % NXCD, xcd = wgid % NXCD, off = wgid / NXCD; wgid = (xcd < r ? xcd * (q + 1) : r * (q + 1) + (xcd - r) * q) + off; }
        const int nig = WGM * nN, gid = wgid / nig, fm = gid * WGM, gsz = (nM - fm) < WGM ? (nM - fm) : WGM;
        u.pm = fm + ((wgid % nig) % gsz); u.pn = (wgid % nig) / gsz; return true;
    }
    __device__ __forceinline__ void a_ready(const Unit&) const {}
    __device__ __forceinline__ void done(const Unit&) const {}
};

template <class Epi, class Sched, bool ALIGN_EPI = false, bool SP2 = false>
__device__ __forceinline__ void gemm_phase(PG8_LAS unsigned char* lds, const Gemm g, const Sched& S, const Epi& E, int tid0) {
    int tid_ = tid0; asm volatile("" : "+v"(tid_));
    const int tid = tid_, wid = __builtin_amdgcn_readfirstlane(tid >> 6), lane = tid & 63, wr = wid >> 2, wc = wid & 3, fr = lane & 15, fq = lane >> 4;
    const int K = g.K, nt = K / BK;
    unsigned voffA[2], voffB[2];
#pragma unroll
    for (int i = 0; i < 2; ++i) { int R, C; stage_rc(tid * 16 + i * 8192, R, C); const int Rb = Epi::PERM ? ((R & ~31) + perm32(R & 31)) : R;
        voffA[i] = (unsigned)(R * K + C) * 2u; voffB[i] = (unsigned)(Rb * K + C) * 2u; }
    const size_t kstep = (size_t)(BK * 2);
    const size_t hstep = (size_t)HALF * K * 2;
    const size_t tstep = 2 * hstep;
    const unsigned ldsw = (unsigned)wid * 1024u;
    const int aoff = lds_byte(wr * 64 + fr, fq * 8), boff = lds_byte(wc * 32 + fr, fq * 8);
#define PG8_SA(b, h) (((b) * 2 + (h)) * HTB)
#define PG8_SB(b, h) ((4 + (b) * 2 + (h)) * HTB)
#define PG8_STAGE(bufoff, gbase, voff) do { _Pragma("unroll") for (int _i = 0; _i < 2; ++_i) \
        __builtin_amdgcn_global_load_lds((const unsigned*)((const char*)(gbase) + (voff)[_i]), (PG8_LAS unsigned*)(lds + (bufoff) + ldsw + _i * 8192), 16, 0, 0); } while (0)
#define PG8_LDA(dst, b, h) do { _Pragma("unroll") for (int m = 0; m < 4; ++m) _Pragma("unroll") for (int k = 0; k < 2; ++k) dst[m][k] = *(const PG8_LAS bf16x8*)(lds + PG8_SA(b, h) + aoff + m * 2048 + k * 1024); } while (0)
#define PG8_LDB(dst, b, h) do { _Pragma("unroll") for (int n = 0; n < 2; ++n) _Pragma("unroll") for (int k = 0; k < 2; ++k) dst[n][k] = *(const PG8_LAS bf16x8*)(lds + PG8_SB(b, h) + boff + n * 2048 + k * 1024); } while (0)
#define PG8_MMA(ai, bj, At, Bt) do { __builtin_amdgcn_s_setprio(1); _Pragma("unroll") for (int m = 0; m < 4; ++m) _Pragma("unroll") for (int n = 0; n < 2; ++n) _Pragma("unroll") for (int k = 0; k < 2; ++k) \
        acc[ai][bj][m][n] = __builtin_amdgcn_mfma_f32_16x16x32_bf16(Bt[n][k], At[m][k], acc[ai][bj][m][n], 0, 0, 0); __builtin_amdgcn_s_setprio(0); } while (0)
#define PG8_WAIT_V(n) asm volatile("s_waitcnt vmcnt(" #n ")" ::: "memory")
#define PG8_WAIT_L(n) asm volatile("s_waitcnt lgkmcnt(" #n ")" ::: "memory")
#define PG8_BAR __builtin_amdgcn_s_barrier()
#define PG8_SCHED __builtin_amdgcn_sched_barrier(0)
    Unit cur, nxt; int ui = 0;
    if (!S.next(0, cur)) return;
    f32x4 acc[2][2][4][2];
#pragma unroll
    for (int a = 0; a < 2; ++a)
#pragma unroll
        for (int b = 0; b < 2; ++b)
#pragma unroll
            for (int m = 0; m < 4; ++m)
#pragma unroll
                for (int n = 0; n < 2; ++n) acc[a][b][m][n] = (f32x4){0.f, 0.f, 0.f, 0.f};
    bf16x8 At[4][2], B0[2][2], B1[2][2];
    const char* cA = (const char*)g.A + (size_t)cur.pm * tstep; const char* cB = (const char*)g.Bt + (size_t)cur.pn * tstep;
    S.a_ready(cur);
    if constexpr (SP2) {
        PG8_STAGE(PG8_SB(0, 0), cB, voffB); PG8_STAGE(PG8_SB(0, 1), cB + hstep, voffB); PG8_STAGE(PG8_SA(0, 0), cA, voffA); PG8_STAGE(PG8_SA(0, 1), cA + hstep, voffA);
        if (wr == 1) PG8_BAR;
        PG8_WAIT_V(2); PG8_BAR;
        PG8_STAGE(PG8_SB(1, 0), cB + kstep, voffB); PG8_STAGE(PG8_SA(1, 0), cA + kstep, voffA); PG8_STAGE(PG8_SB(1, 1), cB + hstep + kstep, voffB);
        PG8_WAIT_V(6); PG8_BAR;
    } else {
        PG8_STAGE(PG8_SB(0, 0), cB, voffB); PG8_STAGE(PG8_SA(0, 0), cA, voffA); PG8_STAGE(PG8_SB(0, 1), cB + hstep, voffB); PG8_STAGE(PG8_SA(0, 1), cA + hstep, voffA);
        if (wr == 1) PG8_BAR;
        PG8_WAIT_V(4); PG8_BAR;
        PG8_STAGE(PG8_SB(1, 0), cB + kstep, voffB); PG8_STAGE(PG8_SA(1, 0), cA + kstep, voffA); PG8_STAGE(PG8_SB(1, 1), cB + hstep + kstep, voffB);
        PG8_WAIT_V(6); PG8_BAR;
    }
    for (;;) {
        const bool has_next = S.next(ui + 1, nxt);
        const char* nA = has_next ? (const char*)g.A + (size_t)nxt.pm * tstep : cA; const char* nB = has_next ? (const char*)g.Bt + (size_t)nxt.pn * tstep : cB;
        for (int t = 0; t < nt; t += 2) {
            const bool last = (t == nt - 2);
            const char* a1 = cA + (size_t)(t + 1) * kstep;
            const char* a2 = last ? nA : cA + (size_t)(t + 2) * kstep; const char* b2 = last ? nB : cB + (size_t)(t + 2) * kstep;
            const char* a3 = a2 + kstep; const char* b3 = b2 + kstep;
            if (last && has_next) S.a_ready(nxt);
            if constexpr (SP2) {
            PG8_LDB(B0, 0, 0); PG8_LDB(B1, 0, 1); PG8_SCHED; PG8_LDA(At, 0, 0); PG8_STAGE(PG8_SA(1, 1), a1 + hstep, voffA);
            PG8_WAIT_V(8); PG8_WAIT_L(0); PG8_BAR; PG8_MMA(0, 0, At, B0); PG8_MMA(0, 1, At, B1); PG8_BAR; PG8_SCHED;
            PG8_LDA(At, 0, 1); PG8_STAGE(PG8_SB(0, 0), b2, voffB); PG8_STAGE(PG8_SB(0, 1), b2 + hstep, voffB); PG8_STAGE(PG8_SA(0, 0), a2, voffA);
            PG8_WAIT_V(8); PG8_WAIT_L(0); PG8_BAR; PG8_MMA(1, 0, At, B0); PG8_MMA(1, 1, At, B1); PG8_BAR; PG8_SCHED;
            PG8_LDB(B0, 1, 0); PG8_LDB(B1, 1, 1); PG8_SCHED; PG8_LDA(At, 1, 0); PG8_STAGE(PG8_SA(0, 1), a2 + hstep, voffA);
            PG8_WAIT_V(8); PG8_WAIT_L(0); PG8_BAR; PG8_MMA(0, 0, At, B0); PG8_MMA(0, 1, At, B1); PG8_BAR; PG8_SCHED;
            PG8_LDA(At, 1, 1); PG8_STAGE(PG8_SB(1, 0), b3, voffB); PG8_STAGE(PG8_SB(1, 1), b3 + hstep, voffB); PG8_STAGE(PG8_SA(1, 0), a3, voffA);
            PG8_WAIT_V(8); PG8_WAIT_L(0); PG8_BAR; PG8_MMA(1, 0, At, B0); PG8_MMA(1, 1, At, B1); PG8_BAR; PG8_SCHED;
            } else {
            PG8_LDB(B0, 0, 0); PG8_SCHED; PG8_LDA(At, 0, 0); PG8_STAGE(PG8_SA(1, 1), a1 + hstep, voffA);
            PG8_WAIT_L(8); PG8_BAR; PG8_WAIT_L(0); PG8_MMA(0, 0, At, B0); PG8_BAR; PG8_SCHED;
            PG8_LDB(B1, 0, 1); PG8_STAGE(PG8_SB(0, 0), b2, voffB);
            PG8_BAR; PG8_WAIT_L(0); PG8_MMA(0, 1, At, B1); PG8_BAR;
            PG8_LDA(At, 0, 1); PG8_STAGE(PG8_SA(0, 0), a2, voffA);
            PG8_BAR; PG8_WAIT_L(0); PG8_MMA(1, 0, At, B0); PG8_BAR; PG8_SCHED;
            PG8_STAGE(PG8_SB(0, 1), b2 + hstep, voffB);
            PG8_WAIT_V(6); PG8_BAR; PG8_MMA(1, 1, At, B1); PG8_BAR;
            PG8_LDB(B0, 1, 0); PG8_SCHED; PG8_LDA(At, 1, 0); PG8_STAGE(PG8_SA(0, 1), a2 + hstep, voffA);
            PG8_WAIT_L(8); PG8_BAR; PG8_WAIT_L(0); PG8_MMA(0, 0, At, B0); PG8_BAR; PG8_SCHED;
            PG8_LDB(B1, 1, 1); PG8_STAGE(PG8_SB(1, 0), b3, voffB);
            PG8_BAR; PG8_WAIT_L(0); PG8_MMA(0, 1, At, B1); PG8_BAR;
            PG8_LDA(At, 1, 1); PG8_STAGE(PG8_SA(1, 0), a3, voffA);
            PG8_BAR; PG8_WAIT_L(0); PG8_MMA(1, 0, At, B0); PG8_BAR; PG8_SCHED;
            PG8_STAGE(PG8_SB(1, 1), b3 + hstep, voffB);
            PG8_WAIT_V(6); PG8_BAR; PG8_MMA(1, 1, At, B1); PG8_BAR;
            }
        }
        if constexpr (ALIGN_EPI) { if (wr == 0) PG8_BAR; }
        if constexpr (!Epi::AFTER_DRAIN) { E(acc, cur, wr, wc, fr, fq); S.done(cur); }
        if (!has_next) break;
#pragma unroll
        for (int a = 0; a < 2; ++a)
#pragma unroll
            for (int b = 0; b < 2; ++b)
#pragma unroll
                for (int m = 0; m < 4; ++m)
#pragma unroll
                    for (int n = 0; n < 2; ++n) acc[a][b][m][n] = (f32x4){0.f, 0.f, 0.f, 0.f};
        cur = nxt; cA = nA; cB = nB; ++ui;
        if constexpr (ALIGN_EPI) { if (wr == 1) PG8_BAR; }
    }
    PG8_WAIT_V(0);
    if constexpr (!ALIGN_EPI) { if (wr == 0) PG8_BAR; }
    PG8_BAR;
    if constexpr (Epi::AFTER_DRAIN) { E.fused(acc, cur, wr, wc, fr, fq, lds, wid, lane); S.done(cur); }
#undef PG8_SA
#undef PG8_SB
#undef PG8_STAGE
#undef PG8_LDA
#undef PG8_LDB
#undef PG8_MMA
#undef PG8_WAIT_V
#undef PG8_WAIT_L
#undef PG8_BAR
#undef PG8_SCHED
}
}
#define XB_TID0 (wave_tid(__builtin_amdgcn_readfirstlane(b.wave)) == 0)
#define XB_TMO      128
#define XB_XCNT(j)  (256  + 64 * (j))
#define XB_XSUB(j)  (1280 + 64 * (j))
#define XB_XGEN(j)  (2304 + 64 * (j))
#define XB_TOP      3328
#define XB_TOPGEN   3392
#define XCD_BAR_WORDS 3456
#define XB_SPIN_CAP (1u << 18)

__device__ __forceinline__ unsigned xb_ld(unsigned* p)              { return __hip_atomic_load(p, __ATOMIC_RELAXED, __HIP_MEMORY_SCOPE_AGENT); }
__device__ __forceinline__ unsigned xb_add(unsigned* p, unsigned v) { return __hip_atomic_fetch_add(p, v, __ATOMIC_RELAXED, __HIP_MEMORY_SCOPE_AGENT); }
__device__ __forceinline__ unsigned xb_xcc_id() { return (unsigned)__builtin_amdgcn_s_getreg((3 << 11) | 20) & 0xFu; }
#define XB_SPIN(cond, bar) do { unsigned _sp = 0; while (cond) { __builtin_amdgcn_s_sleep(1); \
    if ((++_sp & 255u) == 0u) { if (xb_ld(&(bar)[XB_TMO])) break; if (_sp > XB_SPIN_CAP) { atomicAdd(&(bar)[XB_TMO], 1u); break; } } } } while (0)

struct XcdBarrier {
    unsigned* bar; unsigned x; int wave;
    volatile LAS unsigned* st;
};

__device__ __forceinline__ XcdBarrier xcd_barrier_post(unsigned* bar, volatile LAS unsigned* st, int wave) {
    XcdBarrier b; b.bar = bar; b.x = xb_xcc_id(); b.st = st; b.wave = wave;
    if (XB_TID0) (void)xb_add(&bar[XB_XCNT(b.x)], 1u);
    return b;
}
__device__ __forceinline__ void xcd_barrier_complete(unsigned* bar, unsigned x, unsigned& nloc, unsigned& nx) {
    const unsigned G = gridDim.x * gridDim.y * gridDim.z;
    unsigned sum, cnt, mine, sp = 0u;
    for (;;) {
        sum = 0u; cnt = 0u; mine = 0u;
#pragma unroll
        for (unsigned j = 0; j < 16; ++j) { const unsigned c = xb_ld(&bar[XB_XCNT(j)]); sum += c; cnt += (c > 0u) ? 1u : 0u; mine = (j == x) ? c : mine; }
        if (sum == G) break;
        __builtin_amdgcn_s_sleep(1);
        if ((++sp & 255u) == 0u) { if (xb_ld(&bar[XB_TMO])) break; if (sp > XB_SPIN_CAP) { atomicAdd(&bar[XB_TMO], 1u); break; } }
    }
    nloc = mine > 0u ? mine : 1u; nx = cnt > 0u ? cnt : 1u;
}

__device__ __forceinline__ void xcd_barrier(const XcdBarrier& b) {
    asm volatile("s_waitcnt vmcnt(0)" ::: "memory");
    __syncthreads();
    if (XB_TID0) {
        unsigned* bar = b.bar;
        __builtin_amdgcn_s_waitcnt(0);
        unsigned nloc = b.st[0], nx = b.st[1];
        if (nloc == 0u) { xcd_barrier_complete(bar, b.x, nloc, nx); b.st[0] = nloc; b.st[1] = nx; }
        const unsigned old = xb_add(&bar[XB_XSUB(b.x)], 1u);
        const unsigned gen = old / nloc;
        if (old + 1u == (gen + 1u) * nloc) {
            __builtin_amdgcn_fence(__ATOMIC_RELEASE, "agent");
            asm volatile("s_waitcnt vmcnt(0)" ::: "memory");
            const unsigned og = xb_add(&bar[XB_TOP], 1u);
            const unsigned tg = og / nx;
            if (og + 1u == (tg + 1u) * nx) xb_add(&bar[XB_TOPGEN], 1u);
            else XB_SPIN(xb_ld(&bar[XB_TOPGEN]) == tg, bar);
            __builtin_amdgcn_fence(__ATOMIC_ACQUIRE, "agent");
            xb_add(&bar[XB_XGEN(b.x)], 1u);
            asm volatile("s_waitcnt vmcnt(0)" ::: "memory");
        } else {
            XB_SPIN(xb_ld(&bar[XB_XGEN(b.x)]) == gen, bar);
            __builtin_amdgcn_fence(__ATOMIC_ACQUIRE, "agent");
            asm volatile("s_waitcnt vmcnt(0)" ::: "memory");
        }
    }
    __syncthreads();
}
namespace att {
typedef short bf16x8 __attribute__((ext_vector_type(8)));
typedef short s16x4 __attribute__((ext_vector_type(4)));
typedef float f32x16 __attribute__((ext_vector_type(16)));
__device__ __forceinline__ int crow(int r, int hi) { return (r & 3) + 8 * (r >> 2) + 4 * hi; }
template <int NCB> __device__ __forceinline__ int v_st(int k, int c) { const int kk = (k & ~0xC) | ((k & 4) << 1) | ((k & 8) >> 1); return ((kk >> 3) * NCB + (c >> 5)) * 512 + ((kk & 7) * 32 + (c & 31)) * 2; }
__device__ __forceinline__ int v_rd_base(int lane) { return ((lane & 3) << 3) | (((lane >> 2) & 3) << 6) | (((lane >> 4) & 1) << 5) | (((lane >> 5) & 1) << 8); }
__device__ __forceinline__ s16x4 vtr(const LAS unsigned char* p) { typedef short v4i16_t __attribute__((ext_vector_type(4)));
    return __builtin_bit_cast(s16x4, __builtin_amdgcn_ds_read_tr16_b64_v4i16((LAS v4i16_t*)p)); }
__device__ __forceinline__ float swap_max(float v) { auto rr = __builtin_amdgcn_permlane32_swap(__float_as_uint(v), __float_as_uint(v), false, false); return fmaxf(__uint_as_float(rr[0]), __uint_as_float(rr[1])); }
__device__ __forceinline__ float swap_add(float v) { auto rr = __builtin_amdgcn_permlane32_swap(__float_as_uint(v), __float_as_uint(v), false, false); return __uint_as_float(rr[0]) + __uint_as_float(rr[1]); }
#define ATT_PK4(P, BASE, OUT) do { const unsigned a0_ = pk2(P[BASE + 0], P[BASE + 1]), a1_ = pk2(P[BASE + 2], P[BASE + 3]); \
    const unsigned b0_ = pk2(P[BASE + 4], P[BASE + 5]), b1_ = pk2(P[BASE + 6], P[BASE + 7]); \
    auto r0_ = __builtin_amdgcn_permlane32_swap(a0_, b0_, false, false); auto r1_ = __builtin_amdgcn_permlane32_swap(a1_, b1_, false, false); \
    u32x4 w_ = {r0_[0], r1_[0], r0_[1], r1_[1]}; OUT = __builtin_bit_cast(bf16x8, w_); } while (0)
template <class F> __device__ __forceinline__ void for_units(int nunits, int vcu, int G, F f) {
    if (nunits % G == 0) { const int per = nunits / G; for (int i = 0; i < per; ++i) f(vcu * per + i); }
    else for (int u = vcu; u < nunits; u += G) f(u);
}
__device__ __forceinline__ float wave_absmax(const float* g, int n, int lane) {
    float v = lane < n ? fabsf(g[lane]) : 0.f; if (lane + 64 < n) v = fmaxf(v, fabsf(g[lane + 64]));
#pragma unroll
    for (int o = 1; o < 64; o <<= 1) v = fmaxf(v, __shfl_xor(v, o));
    return v;
}
}
namespace att {
constexpr int DK_PITCH = 144, DROWS = 384;
constexpr int DOFF_K = 0, DOFF_V = DROWS * DK_PITCH  , DOFF_POS = DOFF_V + (DROWS / 16) * 2048  , DOFF_LUT = DOFF_POS + DROWS * 4  , DOFF_WS = DOFF_LUT + 4864  , DIL_LDS = DOFF_WS + 8 * 96 * 4;
static_assert(DIL_LDS <= 131072 && (DOFF_V % 16) == 0 && (DOFF_WS % 16) == 0, "dilated attention LDS map");
constexpr int LUT_R = 600;

struct DilRegs { u32x4 kw[6], vw[6]; int pk; };
__device__ __forceinline__ void dil_prefetch(DilRegs& R, const bf16_t* QKVG, const int* pos, int g, int b, int h, int j, int tid) {
    const int lgD = 2 * g, lgL = 11 - lgD, Lm1 = (1 << lgL) - 1; const size_t row0 = (size_t)b * SEQ; const int u0 = 256 * j, ch = tid & 7;
    const bf16_t* kbase = QKVG + ((size_t)((NBATCH + b) * NH + h) * SEQ) * 64 + ch * 8;
#pragma unroll
    for (int k = 0; k < 6; ++k) { const int i = (tid >> 3) + 64 * k, u = u0 - 64 + i; const bool ok = (u >= 0) && (u < SEQ);
        const bf16_t* src = kbase + (size_t)(ok ? u : 0) * 64;
        R.kw[k] = *(const u32x4*)src; R.vw[k] = *(const u32x4*)(src + (size_t)NBATCH * NH * SEQ * 64); }
    { const int u = u0 - 64 + (tid < DROWS ? tid : 0); const bool ok = (u >= 0) && (u < SEQ); const int s = ((u & Lm1) << lgD) + (u >> lgL); R.pk = pos[row0 + (ok ? s : 0)]; }
}
__device__ __forceinline__ void dil_unit(DilRegs& R, int un, const bf16_t* QKVG, const int* pos, int g, bf16_t* O2, float* LSE, LAS unsigned char* lds, int b, int h, int j, int tid) {
    const int lane = tid & 63, r32 = lane & 31, hi = lane >> 5, wid = __builtin_amdgcn_readfirstlane(tid >> 6);
    const int lgD = 2 * g, lgL = 11 - lgD, Lm1 = (1 << lgL) - 1;
    const size_t row0 = (size_t)b * SEQ; const int u0 = 256 * j;
    LAS float* lut = (LAS float*)(lds + DOFF_LUT); LAS int* posk = (LAS int*)(lds + DOFF_POS);
    if (tid < DROWS) posk[tid] = R.pk;
    const int ch = tid & 7;
#pragma unroll
    for (int k = 0; k < 6; ++k) {
        const int i = (tid >> 3) + 64 * k; const int u = u0 - 64 + i; const bool ok = (u >= 0) && (u < SEQ);
        u32x4 kw = R.kw[k], vw = R.vw[k];
        if (!ok) { kw = (u32x4){0u, 0u, 0u, 0u}; vw = kw; }
        *(LAS u32x4*)(lds + DOFF_K + i * DK_PITCH + ch * 16) = kw;
        *(LAS u32x4*)(lds + DOFF_V + (i >> 6) * 8192 + v_st<2>(i & 63, ch * 8)) = vw;
    }
    if (un >= 0) dil_prefetch(R, QKVG, pos, g, un >> 7, (un >> 3) & 15, un & 7, tid);
    const int uq = u0 + 32 * wid + r32; const int sq = ((uq & Lm1) << lgD) + (uq >> lgL); const size_t grow = row0 + sq;
    const int posq = pos[grow];
    bf16x8 qr[4];
#pragma unroll
    for (int d0 = 0; d0 < 4; ++d0) qr[d0] = *(const bf16x8*)(QKVG + ((size_t)(b * NH + h) * SEQ + uq) * 64 + 16 * d0 + 8 * hi);
    __syncthreads();
    const int seq0 = ((u0 + 32 * wid) >> lgL) << lgL;
    const int klo = seq0 - u0 + 64, khi = klo + (1 << lgL);
    const int a_lo = max(klo, 32 * wid + r32), a_hi = min(khi - 1, 32 * wid + r32 + 128);
    const unsigned a_span = (unsigned)(a_hi - a_lo);
    f32x16 p[5];
#pragma unroll
    for (int ht = 0; ht < 5; ++ht) {
        const int i0 = 32 * (wid + ht);
#pragma unroll
        for (int r = 0; r < 16; ++r) p[ht][r] = 0.f;
        const LAS unsigned char* kb = lds + DOFF_K + (i0 + r32) * DK_PITCH + hi * 16;
#pragma unroll
        for (int d0 = 0; d0 < 4; ++d0) p[ht] = __builtin_amdgcn_mfma_f32_32x32x16_bf16(*(const LAS bf16x8*)(kb + d0 * 32), qr[d0], p[ht], 0, 0, 0);
        float bias[16];
#pragma unroll
        for (int r = 0; r < 16; ++r) { int rel = posk[i0 + crow(r, hi)] - posq; rel = min(max(rel, -LUT_R), LUT_R); bias[r] = lut[rel + LUT_R]; }
#pragma unroll
        for (int r = 0; r < 16; ++r) { const bool valid = (unsigned)(i0 + crow(r, hi) - a_lo) <= a_span; const float sb = p[ht][r] + bias[r]; p[ht][r] = valid ? sb : -INFINITY; }
    }
    float mx = p[0][0];
#pragma unroll
    for (int ht = 0; ht < 5; ++ht)
#pragma unroll
        for (int r = 0; r < 16; ++r) mx = fmaxf(mx, p[ht][r]);
    mx = swap_max(mx);
    float l = 0.f;
#pragma unroll
    for (int ht = 0; ht < 5; ++ht)
#pragma unroll
        for (int r = 0; r < 16; ++r) { p[ht][r] = __builtin_amdgcn_exp2f(p[ht][r] - mx); l += p[ht][r]; }
    l = swap_add(l);
    f32x16 o0, o1;
#pragma unroll
    for (int r = 0; r < 16; ++r) { o0[r] = 0.f; o1[r] = 0.f; }
    const LAS unsigned char* vb = lds + DOFF_V + v_rd_base(lane);
#pragma unroll
    for (int ht = 0; ht < 5; ++ht) {
        bf16x8 pa0, pa1; ATT_PK4(p[ht], 0, pa0); ATT_PK4(p[ht], 8, pa1);
        const LAS unsigned char* vk = vb + 2 * (wid + ht) * 2048;
#define DIL_VF(d0, ks) ({ const s16x4 lo_ = vtr(vk + (d0) * 512 + (ks) * 2048), hi_ = vtr(vk + (d0) * 512 + (ks) * 2048 + 1024); (bf16x8){lo_[0], lo_[1], lo_[2], lo_[3], hi_[0], hi_[1], hi_[2], hi_[3]}; })
        o0 = __builtin_amdgcn_mfma_f32_32x32x16_bf16(pa0, DIL_VF(0, 0), o0, 0, 0, 0); o1 = __builtin_amdgcn_mfma_f32_32x32x16_bf16(pa0, DIL_VF(1, 0), o1, 0, 0, 0);
        o0 = __builtin_amdgcn_mfma_f32_32x32x16_bf16(pa1, DIL_VF(0, 1), o0, 0, 0, 0); o1 = __builtin_amdgcn_mfma_f32_32x32x16_bf16(pa1, DIL_VF(1, 1), o1, 0, 0, 0);
#undef DIL_VF
    }
    float lse = mx + log2f(l), wn = 1.0f / l, wo = 0.f;
    if (g > 0) { const float lo = LSE[grow * 16 + h]; const float mm = fmaxf(lo, lse); const float nl = mm + log2f(__builtin_amdgcn_exp2f(lo - mm) + __builtin_amdgcn_exp2f(lse - mm));
        wo = __builtin_amdgcn_exp2f(lo - nl); wn = __builtin_amdgcn_exp2f(lse - nl) / l; lse = nl; }
    LAS float* wsf = (LAS float*)(lds + DOFF_WS) + wid * 96;
    if (hi == 0) { LSE[grow * 16 + h] = lse; wsf[r32] = wn; wsf[32 + r32] = wo; ((LAS int*)wsf)[64 + r32] = (int)grow; }
    unsigned oldw[16];
    if (g > 0) {
#pragma unroll
        for (int r = 0; r < 16; ++r) { const int gr = ((LAS int*)wsf)[64 + crow(r, hi)]; oldw[r] = *(const unsigned*)(O2 + (size_t)gr * DM + h * 64 + 2 * r32); } }
#pragma unroll
    for (int r = 0; r < 16; ++r) { const int c = crow(r, hi); const float a = wsf[c], bo = wsf[32 + c]; const int gr = ((LAS int*)wsf)[64 + c];
        float v0 = o0[r] * a, v1 = o1[r] * a;
        if (g > 0) { v0 += bf2f(oldw[r] & 0xffffu) * bo; v1 += bf2f(oldw[r] >> 16) * bo; }
        *(unsigned*)(O2 + (size_t)gr * DM + h * 64 + 2 * r32) = pk2(v0, v1); }
    __syncthreads();
}
__device__ __forceinline__ void dil_phase(const bf16_t* QKVG, const int* pos, const float* rel_bias, int g, bf16_t* O2, float* LSE, LAS unsigned char* lds, int vcu, int G, int tid0) {
    int tid_ = tid0; asm volatile("" : "+v"(tid_));
    const int tid = tid_;
    const int NU = NBATCH * NH * 8;
    const bool blocked = (NU % G) == 0; const int per = blocked ? NU / G : (NU - vcu + G - 1) / G;
    LAS float* lut = (LAS float*)(lds + DOFF_LUT);
    int hl = -1;
    DilRegs R;
    if (per > 0) { const int u = blocked ? vcu * per : vcu; dil_prefetch(R, QKVG, pos, g, u >> 7, (u >> 3) & 15, u & 7, tid); }
#pragma unroll 1
    for (int i = 0; i < per; ++i) {
        const int u = blocked ? vcu * per + i : vcu + i * G; const int b = u >> 7, h = (u >> 3) & 15, j = u & 7;
        if (h != hl) { for (int idx = tid; idx <= 2 * LUT_R; idx += 512) lut[idx] = rel_bias[t5_bucket(idx - LUT_R) * 48 + g * 16 + h] * LOG2E; hl = h; }
        const int un = (i + 1 < per) ? (blocked ? u + 1 : u + G) : -1;
        dil_unit(R, un, QKVG, pos, g, O2, LSE, lds, b, h, j, tid);
    }
}
}
namespace att {
constexpr int KPITCH = 208, KTILE = 64 * KPITCH, VTILE = 64 * 64 * 2;
constexpr int OFF_K = 0, OFF_V = 2 * KTILE, OFF_WS = OFF_V + 2 * VTILE, MLA_LDS = OFF_WS + 8 * 64 * 4;
static_assert(MLA_LDS <= 131072 && (OFF_V % 16) == 0 && (KTILE % 16) == 0, "MLA attention LDS map");

template <bool FAST> __device__ __forceinline__ void mla_unit(const bf16_t* QH, const bf16_t* KH, const bf16_t* VH, const float* cs, const float* g_q, bf16_t* O, LAS unsigned char* lds, int b, int h, int qb, float KN, int tid0) {
    int tid_ = tid0; asm volatile("" : "+v"(tid_));
    const int tid = tid_, lane = tid & 63, r32 = lane & 31, hi = lane >> 5, wid = __builtin_amdgcn_readfirstlane(tid >> 6);
    const size_t hrow0 = (size_t)(b * NH + h) * SEQ;
    const int c1 = tid, c2 = 512 + (tid & 255);
    const char* kbase = (const char*)(KH + hrow0 * QKD); const char* vbase = (const char*)(VH + hrow0 * VD);
    const unsigned koff1 = c1 * 16u, koff2 = c2 * 16u, voff = tid * 16u;
    const int kdst1 = OFF_K + (c1 / 12) * KPITCH + (c1 % 12) * 16, kdst2 = OFF_K + (c2 / 12) * KPITCH + (c2 % 12) * 16;
    const int vdst = OFF_V + v_st<2>(tid >> 3, (tid & 7) * 8);
    const int qrow = qb * 256 + wid * 32 + r32;
    bf16x8 qr[6]; float qn2 = 0.f;
    {   float qf[6][8]; const bf16_t* qp = QH + (hrow0 + qrow) * QKD + hi * 8;
#pragma unroll
        for (int d0 = 0; d0 < 6; ++d0) unpack8(*(const u32x4*)(qp + 16 * d0), qf[d0]);
        const float* csr = cs + ((size_t)b * SEQ + qrow) * 32 + 8 * hi;
#pragma unroll
        for (int j = 0; j < 8; ++j) { const float c = csr[j], sn = csr[16 + j]; const float x1 = qf[4][j], x2 = qf[5][j]; qf[4][j] = x1 * c - x2 * sn; qf[5][j] = x2 * c + x1 * sn; }
        float ss = 0.f;
#pragma unroll
        for (int d0 = 0; d0 < 6; ++d0)
#pragma unroll
            for (int j = 0; j < 8; ++j) ss += qf[d0][j] * qf[d0][j];
        ss = swap_add(ss);
        const float rs = MLA_C2 * __builtin_amdgcn_rsqf(ss * (1.0f / QKD) + EPS);
#pragma unroll
        for (int d0 = 0; d0 < 6; ++d0) {
#pragma unroll
            for (int j = 0; j < 8; ++j) { qf[d0][j] *= rs * g_q[16 * d0 + 8 * hi + j]; qn2 += qf[d0][j] * qf[d0][j]; }
            qr[d0] = __builtin_bit_cast(bf16x8, pack8(qf[d0])); }
        qn2 = swap_add(qn2);
    }
    const float negB = FAST ? -(sqrtf(qn2) * KN) : 0.f;
    f32x16 o0, o1;
#pragma unroll
    for (int r = 0; r < 16; ++r) { o0[r] = 0.f; o1[r] = 0.f; }
    float lsum = 0.f, mrun = -1e30f;
    LAS float* wsf = (LAS float*)(lds + OFF_WS) + wid * 64;
    u32x4 kreg1, kreg2, vreg;
#define F_LOADK(t) do { const char* kt_ = kbase + (size_t)(t) * (64 * QKD * 2); kreg1 = *(const u32x4*)(kt_ + koff1); kreg2 = *(const u32x4*)(kt_ + koff2); } while (0)
#define F_LOADV(t) do { vreg = *(const u32x4*)(vbase + (size_t)(t) * (64 * VD * 2) + voff); } while (0)
#define F_WRITEK(buf) do { *(LAS u32x4*)(lds + kdst1 + (buf) * KTILE) = kreg1; *(LAS u32x4*)(lds + kdst2 + (buf) * KTILE) = kreg2; } while (0)
#define F_WRITEV(buf) do { *(LAS u32x4*)(lds + vdst + (buf) * VTILE) = vreg; } while (0)
#define F_QK(P0, P1, buf) do { const LAS unsigned char* kb_ = lds + OFF_K + (buf) * KTILE + r32 * KPITCH + hi * 16; \
        { float nb_ = negB; asm volatile("" : "+v"(nb_)); _Pragma("unroll") for (int r = 0; r < 16; ++r) { P0[r] = nb_; P1[r] = nb_; } } \
        _Pragma("unroll") for (int d0 = 0; d0 < 6; ++d0) { const bf16x8 a0_ = *(const LAS bf16x8*)(kb_ + d0 * 32), a1_ = *(const LAS bf16x8*)(kb_ + 32 * KPITCH + d0 * 32); \
            P0 = __builtin_amdgcn_mfma_f32_32x32x16_bf16(a0_, qr[d0], P0, 0, 0, 0); P1 = __builtin_amdgcn_mfma_f32_32x32x16_bf16(a1_, qr[d0], P1, 0, 0, 0); } } while (0)
#define F_VF(vb_, d0, ks) ({ const s16x4 lo_ = vtr(vb_ + (d0) * 512 + (ks) * 2048), hi_ = vtr(vb_ + (d0) * 512 + (ks) * 2048 + 1024); (bf16x8){lo_[0], lo_[1], lo_[2], lo_[3], hi_[0], hi_[1], hi_[2], hi_[3]}; })
    const int NT = SEQ / 64;
#define F_SMPV(C0, C1, t) do { \
        if (!FAST) { float pm_ = fmaxf(C0[0], C1[0]); _Pragma("unroll") for (int r = 1; r < 16; ++r) pm_ = fmaxf(pm_, fmaxf(C0[r], C1[r])); pm_ = swap_max(pm_); \
            const float mn_ = fmaxf(mrun, pm_), al_ = __builtin_amdgcn_exp2f(mrun - mn_); mrun = mn_; lsum *= al_; \
            _Pragma("unroll") for (int r = 0; r < 16; ++r) { C0[r] -= mn_; C1[r] -= mn_; } \
            if (hi == 0) wsf[r32] = al_; \
            _Pragma("unroll") for (int r = 0; r < 16; ++r) { const float a_ = wsf[crow(r, hi)]; o0[r] *= a_; o1[r] *= a_; } } \
        float ps_ = 0.f; \
        _Pragma("unroll") for (int r = 0; r < 16; ++r) { C0[r] = __builtin_amdgcn_exp2f(C0[r]); C1[r] = __builtin_amdgcn_exp2f(C1[r]); ps_ += C0[r] + C1[r]; } \
        lsum += ps_; \
        bf16x8 pa0_, pa1_, pa2_, pa3_; ATT_PK4(C0, 0, pa0_); ATT_PK4(C0, 8, pa1_); ATT_PK4(C1, 0, pa2_); ATT_PK4(C1, 8, pa3_); \
        const LAS unsigned char* vb_ = lds + OFF_V + ((t) & 1) * VTILE + v_rd_base(lane); \
        o0 = __builtin_amdgcn_mfma_f32_32x32x16_bf16(pa0_, F_VF(vb_, 0, 0), o0, 0, 0, 0); o1 = __builtin_amdgcn_mfma_f32_32x32x16_bf16(pa0_, F_VF(vb_, 1, 0), o1, 0, 0, 0); \
        o0 = __builtin_amdgcn_mfma_f32_32x32x16_bf16(pa1_, F_VF(vb_, 0, 1), o0, 0, 0, 0); o1 = __builtin_amdgcn_mfma_f32_32x32x16_bf16(pa1_, F_VF(vb_, 1, 1), o1, 0, 0, 0); \
        o0 = __builtin_amdgcn_mfma_f32_32x32x16_bf16(pa2_, F_VF(vb_, 0, 2), o0, 0, 0, 0); o1 = __builtin_amdgcn_mfma_f32_32x32x16_bf16(pa2_, F_VF(vb_, 1, 2), o1, 0, 0, 0); \
        o0 = __builtin_amdgcn_mfma_f32_32x32x16_bf16(pa3_, F_VF(vb_, 0, 3), o0, 0, 0, 0); o1 = __builtin_amdgcn_mfma_f32_32x32x16_bf16(pa3_, F_VF(vb_, 1, 3), o1, 0, 0, 0); \
    } while (0)
#define F_STEP(C0, C1, N0, N1, t, WK, WV, LK, LV, DOQK) do { \
        __syncthreads(); \
        if (WK) { F_WRITEK((t) & 1); } if (WV) { F_WRITEV(((t) + 1) & 1); } \
        if (LK) { F_LOADK((t) + 3); } if (LV) { F_LOADV((t) + 2); } \
        if (DOQK) { F_QK(N0, N1, ((t) + 1) & 1); } \
        F_SMPV(C0, C1, t); \
    } while (0)
    F_LOADK(0); F_LOADV(0); F_WRITEK(0); F_WRITEV(0); F_LOADK(1); F_WRITEK(1); F_LOADK(2); F_LOADV(1);
    __syncthreads();
    f32x16 pA0, pA1, pB0, pB1;
    F_QK(pA0, pA1, 0);
#pragma unroll 1
    for (int t = 0; t < NT - 4; t += 2) { F_STEP(pA0, pA1, pB0, pB1, t, true, true, true, true, true); F_STEP(pB0, pB1, pA0, pA1, t + 1, true, true, true, true, true); }
    F_STEP(pA0, pA1, pB0, pB1, NT - 4, true, true, false, true, true);
    F_STEP(pB0, pB1, pA0, pA1, NT - 3, true, true, false, false, true);
    F_STEP(pA0, pA1, pB0, pB1, NT - 2, false, true, false, false, true);
    F_STEP(pB0, pB1, pA0, pA1, NT - 1, false, false, false, false, false);
    const float l = swap_add(lsum);
    if (hi == 0) wsf[32 + r32] = l;
    bf16_t* op = O + ((size_t)b * SEQ + qb * 256 + wid * 32) * DM + h * VD + 2 * r32;
#pragma unroll
    for (int r = 0; r < 16; ++r) { const float rl = 1.0f / wsf[32 + crow(r, hi)]; *(unsigned*)(op + (size_t)crow(r, hi) * DM) = pk2(o0[r] * rl, o1[r] * rl); }
    __syncthreads();
#undef F_LOADK
#undef F_LOADV
#undef F_WRITEK
#undef F_WRITEV
#undef F_QK
#undef F_VF
#undef F_STEP
#undef F_SMPV
}
}
constexpr int NWAVES = 8;
constexpr int RING_BYTES = 131072;
constexpr int LDSCTL_OFF = RING_BYTES, MISC_OFF = LDSCTL_OFF + 320;
constexpr int LDS_BYTES = 147456;
constexpr int CW_BAR = 4096;
constexpr size_t CTL_ZERO_BYTES = 384 * 1024;
static_assert((CW_BAR + 12 * XCD_BAR_WORDS) * 4 <= (int)CTL_ZERO_BYTES, "barrier words inside the memset region");

template <class E> struct EpiAd {
    static constexpr bool PERM = (E::NV == 8), AFTER_DRAIN = false; E e;
    __device__ __forceinline__ void operator()(const pg8::f32x4 (&acc)[2][2][4][2], const pg8::Unit& u, int wr, int wc, int fr_, int fq_) const {
        (void)fr_; (void)fq_; const int ln_ = wave_tid(0); const int fr = ln_ & 15, fq = ln_ >> 4;
#pragma unroll
        for (int ai = 0; ai < 2; ++ai)
#pragma unroll
            for (int m = 0; m < 4; ++m) { const int row = u.pm * 256 + ai * 128 + wr * 64 + m * 16 + fr;
#pragma unroll
                for (int bj = 0; bj < 2; ++bj) {
                    if constexpr (PERM) { const int col = u.pn * 256 + bj * 128 + wc * 32 + 8 * fq;
                        const float v[8] = {acc[ai][bj][m][0][0], acc[ai][bj][m][0][1], acc[ai][bj][m][0][2], acc[ai][bj][m][0][3], acc[ai][bj][m][1][0], acc[ai][bj][m][1][1], acc[ai][bj][m][1][2], acc[ai][bj][m][1][3]};
                        e.store(row, col, v); }
                    else {
#pragma unroll
                        for (int n = 0; n < 2; ++n) { const int col = u.pn * 256 + bj * 128 + wc * 32 + 16 * n + 4 * fq;
                            const float v[4] = {acc[ai][bj][m][n][0], acc[ai][bj][m][n][1], acc[ai][bj][m][n][2], acc[ai][bj][m][n][3]};
                            e.store(row, col, v); } } }
                if (m & 1) asm volatile("" ::: "memory"); }
    }
};
struct EpiDilNorm {
    static constexpr bool PERM = true, AFTER_DRAIN = false;
    bf16_t* C; const float* g_q; const float* g_k; int lgD, pad;
    __device__ __forceinline__ void operator()(const pg8::f32x4 (&acc)[2][2][4][2], const pg8::Unit& u, int wr, int wc, int fr_, int fq_) const {
        (void)fr_; (void)fq_; const int ln_ = wave_tid(0); const int fr = ln_ & 15, fq = ln_ >> 4;
        const int t = u.pn >> 2, head = (u.pn & 3) * 4 + wc;
        const float* gp = t == 0 ? g_q : g_k; asm volatile("" : "+s"(gp));
        const float gsc = t == 0 ? DIL_C2 : 1.0f;
        float gn[2][8];
#pragma unroll
        for (int bj = 0; bj < 2; ++bj)
#pragma unroll
            for (int e = 0; e < 8; ++e) gn[bj][e] = t == 2 ? 1.0f : gp[32 * bj + 8 * fq + e] * gsc;
#pragma unroll
        for (int ai = 0; ai < 2; ++ai)
#pragma unroll
            for (int m = 0; m < 4; ++m) {
                const int row = u.pm * 256 + ai * 128 + wr * 64 + m * 16 + fr;
                const int b = row >> 11, s = row & 2047, uu = ((s & ((1 << lgD) - 1)) << (11 - lgD)) + (s >> lgD);
                float x[2][8]; float ss = 0.f;
#pragma unroll
                for (int bj = 0; bj < 2; ++bj)
#pragma unroll
                    for (int e = 0; e < 8; ++e) { x[bj][e] = acc[ai][bj][m][e >> 2][e & 3]; ss += x[bj][e] * x[bj][e]; }
                ss += __shfl_xor(ss, 16); ss += __shfl_xor(ss, 32);
                const float rs = t == 2 ? 1.0f : __builtin_amdgcn_rsqf(ss * (1.0f / 64) + EPS);
                bf16_t* dst = C + ((size_t)((t * NBATCH + b) * NH + head) * SEQ + uu) * 64 + 8 * fq;
#pragma unroll
                for (int bj = 0; bj < 2; ++bj) { u32x4 w;
                    w.x = pk2(x[bj][0] * rs * gn[bj][0], x[bj][1] * rs * gn[bj][1]); w.y = pk2(x[bj][2] * rs * gn[bj][2], x[bj][3] * rs * gn[bj][3]);
                    w.z = pk2(x[bj][4] * rs * gn[bj][4], x[bj][5] * rs * gn[bj][5]); w.w = pk2(x[bj][6] * rs * gn[bj][6], x[bj][7] * rs * gn[bj][7]);
                    *(u32x4*)(dst + 32 * bj) = w; }
            }
    }
};
struct EpiProj {
    static constexpr bool PERM = true, AFTER_DRAIN = false;
    bf16_t* QA; bf16_t* KVA; float* KR; float* SSQ; float* SSKV; float* SSKR; const float* cs;
    __device__ __forceinline__ void operator()(const pg8::f32x4 (&acc)[2][2][4][2], const pg8::Unit& u, int wr, int wc, int fr_, int fq_) const {
        (void)fr_; (void)fq_; const int ln_ = wave_tid(0); const int fr = ln_ & 15, fq = ln_ >> 4;
#pragma unroll
        for (int ai = 0; ai < 2; ++ai)
#pragma unroll
            for (int m = 0; m < 4; ++m) { const int row = u.pm * 256 + ai * 128 + wr * 64 + m * 16 + fr;
#pragma unroll
                for (int bj = 0; bj < 2; ++bj) {
                    const int cw = u.pn * 256 + bj * 128 + wc * 32;
                    if (cw >= MLA_IN) continue;
                    float x[8]; float ss = 0.f;
#pragma unroll
                    for (int e = 0; e < 8; ++e) { x[e] = acc[ai][bj][m][e >> 2][e & 3]; ss += x[e] * x[e]; }
                    if (cw < QLORA + KVLORA) {
                        ss += __shfl_xor(ss, 16); ss += __shfl_xor(ss, 32);
                        u32x4 w; w.x = pk2(x[0], x[1]); w.y = pk2(x[2], x[3]); w.z = pk2(x[4], x[5]); w.w = pk2(x[6], x[7]);
                        if (cw < QLORA) { *(u32x4*)(QA + (size_t)row * QLORA + cw + 8 * fq) = w; if (fq == 0) atomicAdd(SSQ + row, ss); }
                        else { *(u32x4*)(KVA + (size_t)row * KVLORA + (cw - QLORA) + 8 * fq) = w; if (fq == 0) atomicAdd(SSKV + row, ss); }
                    } else {
                        const int i0 = 8 * (fq & 1); const bool lo = fq < 2; float y[8]; float s2 = 0.f;
#pragma unroll
                        for (int e = 0; e < 8; ++e) { const float o = __shfl_xor(x[e], 32); const float c = cs[row * 32 + i0 + e], sn = cs[row * 32 + 16 + i0 + e];
                            y[e] = lo ? x[e] * c - o * sn : x[e] * c + o * sn; s2 += y[e] * y[e]; }
                        s2 += __shfl_xor(s2, 16); s2 += __shfl_xor(s2, 32);
                        *(f32x4*)(KR + (size_t)row * 32 + 8 * fq) = (f32x4){y[0], y[1], y[2], y[3]}; *(f32x4*)(KR + (size_t)row * 32 + 8 * fq + 4) = (f32x4){y[4], y[5], y[6], y[7]};
                        if (fq == 0) SSKR[row] = s2;
                    } } }
    }
};
struct EpiQHead { static constexpr int NV = 8; bf16_t* C; const float* SSQ;
    __device__ __forceinline__ void store(int row, int col, const float* v) const { const float rs = __builtin_amdgcn_rsqf(SSQ[row] * (1.0f / QLORA) + EPS);
        const int h = col / QKD, d = col - h * QKD, b = row >> 11, s = row & 2047;
        u32x4 w; w.x = pk2(v[0] * rs, v[1] * rs); w.y = pk2(v[2] * rs, v[3] * rs); w.z = pk2(v[4] * rs, v[5] * rs); w.w = pk2(v[6] * rs, v[7] * rs);
        *(u32x4*)(C + ((size_t)(b * NH + h) * SEQ + s) * QKD + d) = w; } };
struct EpiKV {
    static constexpr bool PERM = true, AFTER_DRAIN = false;
    bf16_t* KH; bf16_t* VH; const float* KR; const float* SSKV; const float* SSKR; const float* g_k;
    __device__ __forceinline__ void operator()(const pg8::f32x4 (&acc)[2][2][4][2], const pg8::Unit& u, int wr, int wc, int fr_, int fq_) const {
        (void)fr_; (void)fq_; const int ln_ = wave_tid(0); const int fr = ln_ & 15, fq = ln_ >> 4;
        const int head = 2 * u.pn + (wc >> 1);
        if ((wc & 1) == 0) {
            const float* gkp = g_k; asm volatile("" : "+s"(gkp));
#pragma unroll
            for (int ai = 0; ai < 2; ++ai)
#pragma unroll
                for (int m = 0; m < 4; ++m) { const int row = u.pm * 256 + ai * 128 + wr * 64 + m * 16 + fr; const int b = row >> 11, s = row & 2047;
                    const float rkv = __builtin_amdgcn_rsqf(SSKV[row] * (1.0f / KVLORA) + EPS);
                    float ss = 0.f;
#pragma unroll
                    for (int bj = 0; bj < 2; ++bj)
#pragma unroll
                        for (int e = 0; e < 8; ++e) { const float a = acc[ai][bj][m][e >> 2][e & 3]; ss += a * a; }
                    ss += __shfl_xor(ss, 16); ss += __shfl_xor(ss, 32);
                    const float rk = __builtin_amdgcn_rsqf((ss * rkv * rkv + SSKR[row]) * (1.0f / QKD) + EPS), rr = rk * rkv;
                    bf16_t* dst = KH + ((size_t)(b * NH + head) * SEQ + s) * QKD + 8 * fq;
#pragma unroll
                    for (int bj = 0; bj < 2; ++bj) { const pg8::f32x4 a0 = acc[ai][bj][m][0] * rr, a1 = acc[ai][bj][m][1] * rr;
                        const f32x4 g0 = *(const f32x4*)(gkp + 32 * bj + 8 * fq), g1 = *(const f32x4*)(gkp + 32 * bj + 8 * fq + 4); u32x4 w;
                        w.x = pk2(a0[0] * g0.x, a0[1] * g0.y); w.y = pk2(a0[2] * g0.z, a0[3] * g0.w); w.z = pk2(a1[0] * g1.x, a1[1] * g1.y); w.w = pk2(a1[2] * g1.z, a1[3] * g1.w);
                        *(u32x4*)(dst + 32 * bj) = w; }
                    const f32x4 k0 = *(const f32x4*)(KR + (size_t)row * 32 + 8 * fq) * rk, k1 = *(const f32x4*)(KR + (size_t)row * 32 + 8 * fq + 4) * rk;
                    const f32x4 g0 = *(const f32x4*)(gkp + NOPE + 8 * fq), g1 = *(const f32x4*)(gkp + NOPE + 8 * fq + 4);
                    u32x4 w; w.x = pk2(k0.x * g0.x, k0.y * g0.y); w.y = pk2(k0.z * g0.z, k0.w * g0.w); w.z = pk2(k1.x * g1.x, k1.y * g1.y); w.w = pk2(k1.z * g1.z, k1.w * g1.w);
                    *(u32x4*)(dst + NOPE) = w;
                    asm volatile("" ::: "memory"); }
        } else {
#pragma unroll
            for (int ai = 0; ai < 2; ++ai)
#pragma unroll
                for (int m = 0; m < 4; ++m) { const int row = u.pm * 256 + ai * 128 + wr * 64 + m * 16 + fr; const int b = row >> 11, s = row & 2047;
                    const float rkv = __builtin_amdgcn_rsqf(SSKV[row] * (1.0f / KVLORA) + EPS);
                    bf16_t* dst = VH + ((size_t)(b * NH + head) * SEQ + s) * VD + 8 * fq;
#pragma unroll
                    for (int bj = 0; bj < 2; ++bj) { const pg8::f32x4 a0 = acc[ai][bj][m][0] * rkv, a1 = acc[ai][bj][m][1] * rkv; u32x4 w;
                        w.x = pk2(a0[0], a0[1]); w.y = pk2(a0[2], a0[3]); w.z = pk2(a1[0], a1[1]); w.w = pk2(a1[2], a1[3]);
                        *(u32x4*)(dst + 32 * bj) = w; }
                    if (m & 1) asm volatile("" ::: "memory"); }
        }
    }
};
template <class E> __device__ __forceinline__ void run_gemm(LAS unsigned char* lds, int tid0, const void* A, const void* Bt, int N, int K, const E& e) {
    pg8::Gemm g{(const bf16_t*)A, (const bf16_t*)Bt, MTOK, N, K}; pg8::StaticOrder S; S.init(MTOK, N, (int)gridDim.x, (int)blockIdx.x);
    EpiAd<E> ad{e};
    pg8::gemm_phase<EpiAd<E>, pg8::StaticOrder, true, true>(lds, g, S, ad, tid0);
}

struct Args { Ptrs P; int ph_lo, ph_hi, li, pad; };
#define GASP __attribute__((address_space(1)))
struct GPtrs {
    const GASP float *x, *c; const GASP int* pos; const GASP float *ada_w, *ada_b, *norm_mix, *norm_mlp, *mlp_w1, *mlp_w2;
    const GASP float *mla_w_in, *mla_g_qa, *mla_w_qb, *mla_g_kva, *mla_w_kvb, *mla_g_q, *mla_g_k, *mla_w_o;
    const GASP float *dil_w_in, *dil_g_q, *dil_g_k, *dil_w_o, *rel_bias;
    GASP float* out; GASP unsigned char* ws;
};
static_assert(sizeof(GPtrs) == sizeof(Ptrs), "GPtrs mirrors Ptrs");
typedef const __attribute__((address_space(4))) GPtrs* kargp_t;
__device__ __forceinline__ kargp_t kargs() { kargp_t p = (kargp_t)__builtin_amdgcn_kernarg_segment_ptr(); asm volatile("" : "+s"(p)); return p; }
__device__ __forceinline__ Ptrs kptrs() { kargp_t g = kargs(); Ptrs P;
    P.x = (const float*)g->x; P.c = (const float*)g->c; P.pos = (const int*)g->pos; P.ada_w = (const float*)g->ada_w; P.ada_b = (const float*)g->ada_b; P.norm_mix = (const float*)g->norm_mix; P.norm_mlp = (const float*)g->norm_mlp;
    P.mlp_w1 = (const float*)g->mlp_w1; P.mlp_w2 = (const float*)g->mlp_w2; P.mla_w_in = (const float*)g->mla_w_in; P.mla_g_qa = (const float*)g->mla_g_qa; P.mla_w_qb = (const float*)g->mla_w_qb; P.mla_g_kva = (const float*)g->mla_g_kva;
    P.mla_w_kvb = (const float*)g->mla_w_kvb; P.mla_g_q = (const float*)g->mla_g_q; P.mla_g_k = (const float*)g->mla_g_k; P.mla_w_o = (const float*)g->mla_w_o; P.dil_w_in = (const float*)g->dil_w_in; P.dil_g_q = (const float*)g->dil_g_q;
    P.dil_g_k = (const float*)g->dil_g_k; P.dil_w_o = (const float*)g->dil_w_o; P.rel_bias = (const float*)g->rel_bias; P.out = (float*)g->out; P.ws = (unsigned char*)g->ws; return P; }
#define KA kptrs()
#define MOD0 ((const float*)(KA.ws + WS_MOD))
#define MOD1 (MOD0 + 8 * MODW)
#define HB ((bf16_t*)(KA.ws + WS_H))
constexpr int NPHASE = 22;
#ifndef HYBRID
#define HYBRID 0
#endif
__global__ void __launch_bounds__(NWAVES * 64, 2) mega_fwd(Args args) {
    extern __shared__ __attribute__((aligned(16))) unsigned char lds_raw[];
    LAS unsigned char* lds = (LAS unsigned char*)lds_raw;
    volatile LAS unsigned* MISC = (volatile LAS unsigned*)(lds + MISC_OFF);
    const int wave = __builtin_amdgcn_readfirstlane((int)threadIdx.x >> 6);
#define TID wave_tid(wave)
#define LANE (wave_tid(wave) & 63)
    const int G = gridDim.x, bx = blockIdx.x, gw = bx * NWAVES + wave, ngw = G * NWAVES;
    const int vcu = (G % 8 == 0) ? (bx % 8) * (G / 8) + bx / 8 : bx;
    for (int u = TID; u < (LDS_BYTES - LDSCTL_OFF) / 4; u += NWAVES * 64) ((LAS unsigned*)(lds + LDSCTL_OFF))[u] = 0u;
    __syncthreads();
    XcdBarrier bar = xcd_barrier_post((unsigned*)(args.P.ws + WS_CTL) + CW_BAR + args.li * XCD_BAR_WORDS, MISC + 8, wave);
    const int lo = args.ph_lo, hi = args.ph_hi;
#ifdef TS_A
    unsigned long long* tsbuf = (unsigned long long*)(args.P.ws + WS_CTL + 512 * 1024);
#endif
#define IN(k) (lo <= (k) && (k) < hi)
#ifdef TS_A
#define STAMP(i) do { if (bx == 0 && TID == 0) tsbuf[i] = __builtin_amdgcn_s_memrealtime(); } while (0)
#else
#define STAMP(i) do { } while (0)
#endif
#define SEAM(k) do { if (IN(k) && IN((k) + 1)) xcd_barrier(bar); STAMP((k) + 1); } while (0)
#ifndef REP_MASK
#define REP_MASK 0u
#endif
#ifndef EXTRA_BARS
#define EXTRA_BARS 0
#endif
#define REPEAT(k) for (int rep_ = 0; rep_ < (((REP_MASK) >> (k)) & 1u ? 2 : 1); ++rep_, (((REP_MASK) >> (k)) & 1u) && rep_ < 2 ? (xcd_barrier(bar), 0) : 0)

    STAMP(0);
    if (IN(0)) REPEAT(0) {
        p0_weights(KA, (LAS float*)lds + wave * (64 * 33), gw, ngw, LANE);
        p0_cs(KA, bx * 512 + TID, G * 512);
        __syncthreads();
        p0_mod(KA, (LAS float*)lds, bx, G, TID, NWAVES);
    }
    SEAM(0);
    for (int eb_ = 0; eb_ < EXTRA_BARS; ++eb_) xcd_barrier(bar);
    if (IN(1)) REPEAT(1) lnmod_rows(KA.x, KA.norm_mix, MOD0, 0, 1, HB, gw, ngw, LANE);
    SEAM(1);
    if (IN(2)) REPEAT(2) {
        pg8::Gemm gm{(const bf16_t*)(KA.ws + WS_H), (const bf16_t*)(KA.ws + WS_WIN0), MTOK, MLA_INP, DM}; pg8::StaticOrder S; S.init(MTOK, MLA_INP, G, bx);
        EpiProj E{(bf16_t*)(KA.ws + WS_QA), (bf16_t*)(KA.ws + WS_KVA), (float*)(KA.ws + WS_KR), (float*)(KA.ws + WS_SSQ), (float*)(KA.ws + WS_SSKV), (float*)(KA.ws + WS_SSKR), (const float*)(KA.ws + WS_CS)};
        pg8::gemm_phase<EpiProj, pg8::StaticOrder, true, true>(lds, gm, S, E, TID);
    }
    SEAM(2);
    if (IN(3)) REPEAT(3) run_gemm(lds, TID, KA.ws + WS_QA, KA.ws + WS_WQB, 1536, QLORA, EpiQHead{(bf16_t*)(KA.ws + WS_QH), (const float*)(KA.ws + WS_SSQ)});
    if (IN(4)) REPEAT(4) {
        pg8::Gemm gm{(const bf16_t*)(KA.ws + WS_KVA), (const bf16_t*)(KA.ws + WS_WKVB), MTOK, 2048, KVLORA}; pg8::StaticOrder S; S.init(MTOK, 2048, G, bx);
        EpiKV E{(bf16_t*)(KA.ws + WS_KH), (bf16_t*)(KA.ws + WS_VH), (const float*)(KA.ws + WS_KR), (const float*)(KA.ws + WS_SSKV), (const float*)(KA.ws + WS_SSKR), KA.mla_g_k};
        pg8::gemm_phase<EpiKV, pg8::StaticOrder, true, true>(lds, gm, S, E, TID);
    }
    SEAM(4);
    if (IN(6)) REPEAT(6) {
        const float gqm = att::wave_absmax(KA.mla_g_q, QKD, LANE), gkm = att::wave_absmax(KA.mla_g_k, QKD, LANE);
        const float KN = __builtin_bit_cast(float, __builtin_amdgcn_readfirstlane(__builtin_bit_cast(int, 9.797958971f * gkm * 1.0079f)));
        const bool fast = __builtin_amdgcn_readfirstlane((int)(1.4427f * 9.798f * 1.008f * gqm * gkm <= 40.0f)) != 0;
        if (fast) att::for_units(NBATCH * NH * 8, vcu, G, [&](int u) { att::mla_unit<true>((const bf16_t*)(KA.ws + WS_QH), (const bf16_t*)(KA.ws + WS_KH), (const bf16_t*)(KA.ws + WS_VH), (const float*)(KA.ws + WS_CS), KA.mla_g_q, HB, lds, u >> 7, (u >> 3) & 15, u & 7, KN, TID); });
        else att::for_units(NBATCH * NH * 8, vcu, G, [&](int u) { att::mla_unit<false>((const bf16_t*)(KA.ws + WS_QH), (const bf16_t*)(KA.ws + WS_KH), (const bf16_t*)(KA.ws + WS_VH), (const float*)(KA.ws + WS_CS), KA.mla_g_q, HB, lds, u >> 7, (u >> 3) & 15, u & 7, KN, TID); });
    }
    SEAM(6);
    if (IN(7)) REPEAT(7) run_gemm(lds, TID, KA.ws + WS_H, KA.ws + WS_WO0, DM, DM, EpiResGate{KA.x, KA.out, MOD0 + 2 * DM});
    SEAM(7);
    if (IN(8)) REPEAT(8) lnmod_rows(KA.out, KA.norm_mlp, MOD0, 3, 4, HB, gw, ngw, LANE);
    SEAM(8);
    if (IN(9)) REPEAT(9) run_gemm(lds, TID, KA.ws + WS_H, KA.ws + WS_W1_0, DFF, DM, EpiSqRelu{(bf16_t*)(KA.ws + WS_U), DFF, 0});
    SEAM(9);
    if (IN(10)) REPEAT(10) run_gemm(lds, TID, KA.ws + WS_U, KA.ws + WS_W2_0, DM, DFF, EpiResGate{KA.out, KA.out, MOD0 + 5 * DM});
    SEAM(10);
    if (IN(11)) REPEAT(11) lnmod_rows(KA.out, KA.norm_mix + DM, MOD1, 0, 1, HB, gw, ngw, LANE);
    SEAM(11);
#pragma unroll 1
    for (int g = 0; g < 3; ++g) {
        if (IN(12 + 2 * g)) REPEAT(12 + 2 * g) {
            pg8::Gemm gm{(const bf16_t*)(KA.ws + WS_H), (const bf16_t*)(KA.ws + WS_WIN1 + (size_t)g * GCOLS * DM * 2), MTOK, GCOLS, DM}; pg8::StaticOrder S; S.init(MTOK, GCOLS, G, bx);
            EpiDilNorm E{(bf16_t*)(KA.ws + WS_QKVG), KA.dil_g_q + g * 64, KA.dil_g_k + g * 64, 2 * g, 0};
            pg8::gemm_phase<EpiDilNorm, pg8::StaticOrder, true, true>(lds, gm, S, E, TID);
        }
        SEAM(12 + 2 * g);
        if (IN(13 + 2 * g)) REPEAT(13 + 2 * g) att::dil_phase((const bf16_t*)(KA.ws + WS_QKVG), KA.pos, KA.rel_bias, g, (bf16_t*)(KA.ws + WS_O2), (float*)(KA.ws + WS_LSE), lds, vcu, G, TID);
        SEAM(13 + 2 * g);
    }
    if (IN(18)) REPEAT(18) run_gemm(lds, TID, KA.ws + WS_O2, KA.ws + WS_WO1, DM, DM, EpiResGate{KA.out, KA.out, MOD1 + 2 * DM});
    SEAM(18);
    if (IN(19)) REPEAT(19) lnmod_rows(KA.out, KA.norm_mlp + DM, MOD1, 3, 4, HB, gw, ngw, LANE);
    SEAM(19);
    if (IN(20)) REPEAT(20) run_gemm(lds, TID, KA.ws + WS_H, KA.ws + WS_W1_1, DFF, DM, EpiSqRelu{(bf16_t*)(KA.ws + WS_U), DFF, 0});
    SEAM(20);
    if (IN(21)) REPEAT(21) run_gemm(lds, TID, KA.ws + WS_U, KA.ws + WS_W2_1, DM, DFF, EpiResGate{KA.out, KA.out, MOD1 + 5 * DM});
#ifdef TS_A
    xcd_barrier(bar); STAMP(22);
    if (bx == 0 && TID == 0) { __threadfence(); KA.out[0] += (float)(long long)(tsbuf[TS_B] - tsbuf[TS_A]) * 0.01f; }
#endif
#undef IN
#undef SEAM
}

extern "C" void kernel_launch(void* const* d_in, const int* in_sizes, int n_in, void* d_out, int out_size, void* d_ws, size_t ws_size, hipStream_t stream) {
    static int grid = 0;
    if (grid == 0) {
        if (n_in != 22 || ws_size < WS_END || out_size != MTOK * DM) { fprintf(stderr, "kernel_launch: unexpected n_in %d / ws %zu / out %d\n", n_in, ws_size, out_size); grid = -1; return; }
        int dev = 0, cus = 0, per_cu = 0;
        if (hipGetDevice(&dev) != hipSuccess || hipDeviceGetAttribute(&cus, hipDeviceAttributeMultiprocessorCount, dev) != hipSuccess) { grid = -1; return; }
        if (hipFuncSetAttribute((const void*)mega_fwd, hipFuncAttributeMaxDynamicSharedMemorySize, LDS_BYTES) != hipSuccess) { fprintf(stderr, "kernel_launch: hipFuncSetAttribute failed\n"); grid = -1; return; }
        if (hipOccupancyMaxActiveBlocksPerMultiprocessor(&per_cu, (const void*)mega_fwd, NWAVES * 64, LDS_BYTES) != hipSuccess || per_cu < 1) { fprintf(stderr, "kernel_launch: occupancy query says %d blocks per CU\n", per_cu); (void)hipGetLastError(); grid = -1; return; }
        if (per_cu > 1) per_cu = 1;
        grid = cus * per_cu;
    }
    if (grid < 0) return;
    if (hipMemsetAsync((char*)d_ws + WS_CTL, 0, CTL_ZERO_BYTES, stream) != hipSuccess) return;
    Args a{};
    Ptrs& P = a.P;
    P.x = (const float*)d_in[0]; P.c = (const float*)d_in[1]; P.pos = (const int*)d_in[2]; P.ada_w = (const float*)d_in[3]; P.ada_b = (const float*)d_in[4];
    P.norm_mix = (const float*)d_in[5]; P.norm_mlp = (const float*)d_in[6]; P.mlp_w1 = (const float*)d_in[7]; P.mlp_w2 = (const float*)d_in[8];
    P.mla_w_in = (const float*)d_in[9]; P.mla_g_qa = (const float*)d_in[10]; P.mla_w_qb = (const float*)d_in[11]; P.mla_g_kva = (const float*)d_in[12];
    P.mla_w_kvb = (const float*)d_in[13]; P.mla_g_q = (const float*)d_in[14]; P.mla_g_k = (const float*)d_in[15]; P.mla_w_o = (const float*)d_in[16];
    P.dil_w_in = (const float*)d_in[17]; P.dil_g_q = (const float*)d_in[18]; P.dil_g_k = (const float*)d_in[19]; P.dil_w_o = (const float*)d_in[20]; P.rel_bias = (const float*)d_in[21];
    P.out = (float*)d_out; P.ws = (unsigned char*)d_ws;
    unsigned char* ws = P.ws;
    int li = 0;
    auto launch = [&](int lo, int hi) { a.ph_lo = lo; a.ph_hi = hi; a.li = li++; hipLaunchKernelGGL(mega_fwd, dim3(grid), dim3(NWAVES * 64), LDS_BYTES, stream, a); };
    launch(0, NPHASE);

}
```
